# Optimizing an MI355X kernel written in HIP

```python
import math
import jax
import jax.numpy as jnp
from jax import lax
import numpy as np

D_MODEL = 1024
BATCH = 16
SEQ = 4096
DEPTH = 2

GRID_W = 64
CTX_LEN = 256
HEAD_DIM = 64
EPS = 1e-6

F_GROUPS = 4
F_WIDTH = F_GROUPS * HEAD_DIM

ATT_HEADS = 6
ATT_KV_HEADS = 2
ATT_WIDTH = ATT_HEADS * HEAD_DIM
KV_WIDTH = ATT_KV_HEADS * HEAD_DIM
WINDOW = 128
BLOCK = 128
ROPE_THETA = 10000.0

SSD_HEADS = 6
SSD_WIDTH = SSD_HEADS * HEAD_DIM
SSD_GROUPS = 2
SSD_STATE = 128
SSD_CHUNK = 128
CONV_K = 5
CONV_DIM = SSD_WIDTH + 2 * SSD_GROUPS * SSD_STATE

MIX_WIDTH = F_WIDTH + ATT_WIDTH + SSD_WIDTH
IN_SPLITS = (F_WIDTH, ATT_WIDTH, KV_WIDTH, KV_WIDTH, SSD_WIDTH, CONV_DIM, 2 * SSD_HEADS)
IN_WIDTH = sum(IN_SPLITS)

N_EXPERTS = 16
EXPERT_FF = 2816
EC_CAPACITY = 2

kernel_name = 'hybrid_diffusion_fourier_swa_ssd_ecmoe'


def rmsnorm(x, g):
    xf = x.astype(jnp.float32)
    y = xf * lax.rsqrt(jnp.mean(xf * xf, axis=-1, keepdims=True) + EPS)
    return (y * g.astype(jnp.float32)).astype(x.dtype)


def modulate(h, shift, scale):
    return h * (1 + scale) + shift


def split_cols(p):
    offs = np.cumsum(IN_SPLITS)[:-1].tolist()
    return jnp.split(p, offs, axis=-1)


def fourier_mix(u):
    bsz, n, _ = u.shape
    uf = u.astype(jnp.float32).reshape(bsz, n, F_GROUPS, HEAD_DIM)
    y = jnp.fft.fft2(uf, axes=(1, 3), norm='ortho').real
    return y.reshape(bsz, n, F_WIDTH).astype(u.dtype)


def axial_rope(x):
    n = x.shape[1]
    rows = n // GRID_W
    row = jnp.broadcast_to(jnp.arange(rows, dtype=jnp.float32)[:, None], (rows, GRID_W)).reshape(n)
    col = jnp.broadcast_to(jnp.arange(GRID_W, dtype=jnp.float32)[None, :], (rows, GRID_W)).reshape(n)
    half = HEAD_DIM // 2
    quarter = half // 2
    inv = ROPE_THETA ** (-jnp.arange(quarter, dtype=jnp.float32) / quarter)

    def rot(v, pos):
        ang = pos[:, None] * inv
        cos = jnp.cos(ang)[None, :, None, :]
        sin = jnp.sin(ang)[None, :, None, :]
        v1, v2 = v[..., :quarter], v[..., quarter:]
        return jnp.concatenate([v1 * cos - v2 * sin, v1 * sin + v2 * cos], axis=-1)

    xf = x.astype(jnp.float32)
    return jnp.concatenate([rot(xf[..., :half], row), rot(xf[..., half:], col)], axis=-1).astype(x.dtype)


def window_mask(n):
    nb = n // BLOCK
    blk = jnp.arange(nb)[:, None, None]
    qpos = blk * BLOCK + jnp.arange(BLOCK)[None, :, None]
    kpos = (blk - 1) * BLOCK + jnp.arange(3 * BLOCK)[None, None, :]
    return (jnp.abs(qpos - kpos) <= WINDOW) & (kpos >= 0) & (kpos < n)


def window_attention(q, k, v, kc, vc, sink):
    bsz, n = q.shape[:2]
    nb = n // BLOCK
    r = ATT_HEADS // ATT_KV_HEADS
    scale = HEAD_DIM ** -0.5
    qb = q.reshape(bsz, nb, BLOCK, ATT_KV_HEADS, r, HEAD_DIM)

    def band(t):
        tp = jnp.pad(t, ((0, 0), (BLOCK, BLOCK), (0, 0), (0, 0)))
        tp = tp.reshape(bsz, nb + 2, BLOCK, ATT_KV_HEADS, HEAD_DIM)
        return jnp.concatenate([tp[:, :-2], tp[:, 1:-1], tp[:, 2:]], axis=2)

    kb, vb = band(k), band(v)
    s_loc = jnp.einsum('bnqgrd,bnkgd->bngrqk', qb, kb).astype(jnp.float32) * scale
    s_loc = jnp.where(window_mask(n)[None, :, None, None], s_loc, -jnp.inf)
    s_ctx = jnp.einsum('bnqgrd,blgd->bngrql', qb, kc).astype(jnp.float32) * scale
    s_snk = jnp.broadcast_to(sink.astype(jnp.float32).reshape(1, 1, ATT_KV_HEADS, r, 1, 1), s_loc.shape[:-1] + (1,))
    p = jax.nn.softmax(jnp.concatenate([s_loc, s_ctx, s_snk], axis=-1), axis=-1).astype(v.dtype)
    o = (jnp.einsum('bngrqk,bnkgd->bnqgrd', p[..., :3 * BLOCK], vb)
         + jnp.einsum('bngrql,blgd->bnqgrd', p[..., 3 * BLOCK:-1], vc))
    return o.reshape(bsz, n, ATT_WIDTH)


def context_attention(q, k, v, sink):
    bsz, n = q.shape[:2]
    r = ATT_HEADS // ATT_KV_HEADS
    qg = q.reshape(bsz, n, ATT_KV_HEADS, r, HEAD_DIM)
    s = jnp.einsum('bqgrd,bkgd->bgrqk', qg, k).astype(jnp.float32) * HEAD_DIM ** -0.5
    snk = jnp.broadcast_to(sink.astype(jnp.float32).reshape(1, ATT_KV_HEADS, r, 1, 1), s.shape[:-1] + (1,))
    p = jax.nn.softmax(jnp.concatenate([s, snk], axis=-1), axis=-1)[..., :-1].astype(v.dtype)
    o = jnp.einsum('bgrqk,bkgd->bqgrd', p, v)
    return o.reshape(bsz, n, ATT_WIDTH)


def dwconv_silu(t, w, b):
    y = lax.conv_general_dilated(t, w[:, None, :].astype(t.dtype), window_strides=(1,),
                                 padding=[(CONV_K // 2, CONV_K // 2)],
                                 dimension_numbers=('NWC', 'WIO', 'NWC'),
                                 feature_group_count=t.shape[-1])
    return jax.nn.silu(y + b.astype(t.dtype))


def ssd_scan(x, dt, a, bm, cm, h0, with_output):
    bsz, n = x.shape[:2]
    nc = n // SSD_CHUNK
    r = SSD_HEADS // SSD_GROUPS
    xc = x.astype(jnp.float32).reshape(bsz, nc, SSD_CHUNK, SSD_GROUPS, r, HEAD_DIM)
    dtc = dt.reshape(bsz, nc, SSD_CHUNK, SSD_GROUPS, r)
    bc = bm.astype(jnp.float32).reshape(bsz, nc, SSD_CHUNK, SSD_GROUPS, SSD_STATE)
    cc = cm.astype(jnp.float32).reshape(bsz, nc, SSD_CHUNK, SSD_GROUPS, SSD_STATE)
    a_cs = jnp.cumsum(dtc * a.reshape(SSD_GROUPS, r), axis=2)
    xd = xc * dtc[..., None]
    decay_to_end = jnp.exp(a_cs[:, :, -1:] - a_cs)
    states = jnp.einsum('bcjgn,bcjgr,bcjgrp->bcgrpn', bc, decay_to_end, xd)
    chunk_decay = jnp.exp(a_cs[:, :, -1])

    def step(h, inp):
        s_c, d_c = inp
        return h * d_c[..., None, None] + s_c, h

    h_final, h_start = lax.scan(step, h0, (jnp.moveaxis(states, 1, 0), jnp.moveaxis(chunk_decay, 1, 0)))
    if not with_output:
        return None, h_final
    h_start = jnp.moveaxis(h_start, 0, 1)
    seg = a_cs[:, :, :, None] - a_cs[:, :, None, :]
    lower = jnp.tril(jnp.ones((SSD_CHUNK, SSD_CHUNK), dtype=bool))[:, :, None, None]
    decay_in = jnp.exp(jnp.where(lower, seg, -jnp.inf))
    cb = jnp.einsum('bcign,bcjgn->bcgij', cc, bc)
    y_diag = jnp.einsum('bcgij,bcijgr,bcjgrp->bcigrp', cb, decay_in, xd)
    y_off = jnp.einsum('bcign,bcgrpn,bcigr->bcigrp', cc, h_start, jnp.exp(a_cs))
    return (y_diag + y_off).reshape(bsz, n, SSD_HEADS, HEAD_DIM), h_final


def ssd_mixer(z, xbc, dt_raw, conv_w, conv_b, dt_bias, a_log, d_skip, g_ssd, h0_f, h0_b, with_output):
    bsz, n, _ = xbc.shape
    xbc = dwconv_silu(xbc, conv_w, conv_b)
    xs, bm, cm = jnp.split(xbc, [SSD_WIDTH, SSD_WIDTH + SSD_GROUPS * SSD_STATE], axis=-1)
    xs = xs.reshape(bsz, n, SSD_HEADS, HEAD_DIM)
    bm = bm.reshape(bsz, n, SSD_GROUPS, SSD_STATE)
    cm = cm.reshape(bsz, n, SSD_GROUPS, SSD_STATE)
    dt = jax.nn.softplus(dt_raw.astype(jnp.float32).reshape(bsz, n, 2, SSD_HEADS) + dt_bias.astype(jnp.float32))
    a = -jnp.exp(a_log.astype(jnp.float32))

    def rev(t):
        return jnp.flip(t, axis=1)

    y_f, h_f = ssd_scan(xs, dt[:, :, 0], a[0], bm, cm, h0_f, with_output)
    y_b, h_b = ssd_scan(rev(xs), rev(dt[:, :, 1]), a[1], rev(bm), rev(cm), h0_b, with_output)
    if not with_output:
        return None, h_f, h_b
    y = y_f + rev(y_b) + d_skip.astype(jnp.float32)[:, None] * xs.astype(jnp.float32)
    y = y.reshape(bsz, n, SSD_WIDTH).astype(z.dtype) * jax.nn.silu(z)
    return rmsnorm(y, g_ssd), h_f, h_b


def hybrid_mixer(u_ctx, u_lat, w_in, conv_w, conv_b, dt_bias, a_log, d_skip, g_ssd, attn_sink, w_out, ctx_out):
    bsz, n_ctx, _ = u_ctx.shape
    n_lat = u_lat.shape[1]
    f_c, q_c, k_c, v_c, z_c, xbc_c, dt_c = split_cols(u_ctx @ w_in)
    f_l, q_l, k_l, v_l, z_l, xbc_l, dt_l = split_cols(u_lat @ w_in)

    def heads(t, n, h):
        return t.reshape(bsz, n, h, HEAD_DIM)

    k_c = heads(k_c, n_ctx, ATT_KV_HEADS)
    v_c = heads(v_c, n_ctx, ATT_KV_HEADS)
    q_l = axial_rope(heads(q_l, n_lat, ATT_HEADS))
    k_l = axial_rope(heads(k_l, n_lat, ATT_KV_HEADS))
    v_l = heads(v_l, n_lat, ATT_KV_HEADS)
    a_lat = window_attention(q_l, k_l, v_l, k_c, v_c, attn_sink)

    h0 = jnp.zeros((bsz, SSD_GROUPS, SSD_HEADS // SSD_GROUPS, HEAD_DIM, SSD_STATE), jnp.float32)
    s_ctx, hf_c, hb_c = ssd_mixer(z_c, xbc_c, dt_c, conv_w, conv_b, dt_bias, a_log, d_skip, g_ssd, h0, h0, ctx_out)
    s_lat, _, _ = ssd_mixer(z_l, xbc_l, dt_l, conv_w, conv_b, dt_bias, a_log, d_skip, g_ssd, hf_c, hb_c, True)

    out_lat = jnp.concatenate([fourier_mix(f_l), a_lat, s_lat], axis=-1) @ w_out
    if not ctx_out:
        return out_lat, None
    a_ctx = context_attention(heads(q_c, n_ctx, ATT_HEADS), k_c, v_c, attn_sink)
    out_ctx = jnp.concatenate([fourier_mix(f_c), a_ctx, s_ctx], axis=-1) @ w_out
    return out_lat, out_ctx


def expert_choice_ffn(u, w_router, w_gate, w_up, w_down):
    bsz, n, d = u.shape
    cap = EC_CAPACITY * n // N_EXPERTS
    aff = jax.nn.softmax((u @ w_router).astype(jnp.float32), axis=-1)
    gate, idx = lax.top_k(jnp.transpose(aff, (2, 0, 1)), cap)
    bidx = jnp.arange(bsz)[:, None]

    def expert(args):
        ie, ge, wg, wu, wd = args
        xe = u[bidx, ie]
        he = jax.nn.silu(xe @ wg) * (xe @ wu)
        return (he @ wd) * ge[..., None].astype(u.dtype)

    y = lax.map(expert, (idx, gate, w_gate, w_up, w_down))
    return jnp.zeros_like(u).at[bidx[None], idx].add(y)


def setup_inputs(seed: int = 0) -> dict:
    key = jax.random.key(seed)
    ks = jax.random.split(key, 24)
    f32 = jnp.float32
    L, D = DEPTH, D_MODEL

    def nrm(k, shape, s):
        return s * jax.random.normal(k, shape, f32)

    dt0 = jnp.exp(jax.random.uniform(ks[13], (L, 2, SSD_HEADS), f32, math.log(1e-3), math.log(1e-1)))
    return {
        'x': nrm(ks[0], (BATCH, SEQ, D), 1.0),
        'c': nrm(ks[1], (BATCH, D), 1.0),
        'ctx': nrm(ks[2], (BATCH, CTX_LEN, D), 1.0),
        'c_ctx': nrm(ks[3], (D,), 1.0),
        'w_ada': nrm(ks[4], (L, D, 6 * D), 0.5 * D ** -0.5),
        'b_ada': nrm(ks[5], (L, 6 * D), 0.01),
        'g_mix_pre': 1.0 + nrm(ks[6], (L, D), 0.05),
        'g_mix_post': 1.0 + nrm(ks[7], (L, D), 0.05),
        'g_ffn_pre': 1.0 + nrm(ks[8], (L, D), 0.05),
        'g_ffn_post': 1.0 + nrm(ks[9], (L, D), 0.05),
        'w_in': nrm(ks[10], (L, D, IN_WIDTH), D ** -0.5),
        'conv_w': nrm(ks[11], (L, CONV_K, CONV_DIM), CONV_K ** -0.5),
        'conv_b': nrm(ks[12], (L, CONV_DIM), 0.01),
        'dt_bias': dt0 + jnp.log(-jnp.expm1(-dt0)),
        'a_log': jnp.log(jax.random.uniform(ks[14], (L, 2, SSD_HEADS), f32, 1.0, 16.0)),
        'd_skip': 1.0 + nrm(ks[15], (L, SSD_HEADS), 0.1),
        'g_ssd': 1.0 + nrm(ks[16], (L, SSD_WIDTH), 0.05),
        'attn_sink': nrm(ks[17], (L, ATT_HEADS), 0.5),
        'w_out': nrm(ks[18], (L, MIX_WIDTH, D), MIX_WIDTH ** -0.5),
        'w_router': nrm(ks[19], (L, D, N_EXPERTS), D ** -0.5),
        'w_gate': nrm(ks[20], (L, N_EXPERTS, D, EXPERT_FF), D ** -0.5),
        'w_up': nrm(ks[21], (L, N_EXPERTS, D, EXPERT_FF), D ** -0.5),
        'w_down': nrm(ks[22], (L, N_EXPERTS, EXPERT_FF, D), EXPERT_FF ** -0.5),
    }


def reference(x, c, ctx, c_ctx, w_ada, b_ada, g_mix_pre, g_mix_post, g_ffn_pre, g_ffn_post,
              w_in, conv_w, conv_b, dt_bias, a_log, d_skip, g_ssd, attn_sink, w_out,
              w_router, w_gate, w_up, w_down):
    h_lat, h_ctx = x, ctx
    silu_c = jax.nn.silu(c)
    silu_cc = jax.nn.silu(c_ctx)
    for l in range(DEPTH):
        last = l == DEPTH - 1
        mod_lat = silu_c @ w_ada[l] + b_ada[l]
        mod_ctx = silu_cc @ w_ada[l] + b_ada[l]
        sh1, sc1, gt1, sh2, sc2, gt2 = jnp.split(mod_lat[:, None, :], 6, axis=-1)
        sh1c, sc1c, gt1c, sh2c, sc2c, gt2c = jnp.split(mod_ctx, 6, axis=-1)

        u_lat = modulate(rmsnorm(h_lat, g_mix_pre[l]), sh1, sc1)
        u_ctx = modulate(rmsnorm(h_ctx, g_mix_pre[l]), sh1c, sc1c)
        m_lat, m_ctx = hybrid_mixer(u_ctx, u_lat, w_in[l], conv_w[l], conv_b[l], dt_bias[l], a_log[l],
                                    d_skip[l], g_ssd[l], attn_sink[l], w_out[l], not last)
        h_lat = h_lat + gt1 * rmsnorm(m_lat, g_mix_post[l])
        f_lat = expert_choice_ffn(modulate(rmsnorm(h_lat, g_ffn_pre[l]), sh2, sc2),
                                  w_router[l], w_gate[l], w_up[l], w_down[l])
        h_lat = h_lat + gt2 * rmsnorm(f_lat, g_ffn_post[l])

        if not last:
            h_ctx = h_ctx + gt1c * rmsnorm(m_ctx, g_mix_post[l])
            f_ctx = expert_choice_ffn(modulate(rmsnorm(h_ctx, g_ffn_pre[l]), sh2c, sc2c),
                                      w_router[l], w_gate[l], w_up[l], w_down[l])
            h_ctx = h_ctx + gt2c * rmsnorm(f_ctx, g_ffn_post[l])
    return h_lat
```

```cpp
#include <hip/hip_runtime.h>
#include <cstdio>
#include <cstdint>

#define LAS __attribute__((address_space(3)))
typedef unsigned short bf16_t;
typedef short bf16x8 __attribute__((ext_vector_type(8)));
typedef short bf16x4 __attribute__((ext_vector_type(4)));
typedef float f32x4 __attribute__((ext_vector_type(4)));
typedef float f32x2 __attribute__((ext_vector_type(2)));
typedef unsigned u32x4 __attribute__((ext_vector_type(4)));
typedef unsigned u32x2 __attribute__((ext_vector_type(2)));
typedef __bf16 bf16v2_t __attribute__((ext_vector_type(2)));

constexpr int D = 1024, NB = 16, SEQ = 4096, CTX = 256, NLAT = NB * SEQ, NCTX = NB * CTX, NT = NLAT + NCTX;
constexpr int PW = 2304;
constexpr int PF = 0, PQ = 256, PK = 640, PV = 768, PZ = 896, PX = 1280, PDT = 2176, INW = 2188;
constexpr int FF = 2816, NE = 16, EROWS = 8704;
constexpr int NCH = 34;
constexpr float EPS = 1e-6f;
constexpr int NWAVES = 8, NTHR = 512;

constexpr size_t al4k(size_t x) { return (x + 4095) & ~(size_t)4095; }
constexpr size_t WS_CTL = 0;
constexpr size_t WS_MOD = al4k(WS_CTL + 65536);
constexpr size_t WS_ROPE = al4k(WS_MOD + (size_t)2 * 17 * 6144 * 4);
constexpr size_t WS_HCTX = al4k(WS_ROPE + 64 * 16 * 2 * 4);
constexpr size_t WS_WIN = al4k(WS_HCTX + (size_t)NCTX * D * 4);
constexpr size_t WS_WOUT = al4k(WS_WIN + (size_t)2 * PW * D * 2);
constexpr size_t WS_WGU = al4k(WS_WOUT + (size_t)2 * D * D * 2);
constexpr size_t WS_WD = al4k(WS_WGU + (size_t)NE * 2 * FF * D * 2);
constexpr size_t WS_AFF = al4k(WS_WD + (size_t)NE * D * FF * 2);
constexpr size_t WS_ROWIDX = al4k(WS_AFF + (size_t)NT * 16 * 4);
constexpr size_t WS_GATE = al4k(WS_ROWIDX + (size_t)NE * EROWS * 4);
constexpr size_t WS_SLOT = al4k(WS_GATE + (size_t)NE * EROWS * 4);
constexpr size_t WS_DECAY = al4k(WS_SLOT + (size_t)NT * 16 * 2);
constexpr size_t WS_BUFA = al4k(WS_DECAY + (size_t)NB * NCH * 12 * 4);
constexpr size_t WS_BUFB = al4k(WS_BUFA + (size_t)NT * D * 2);
constexpr size_t WS_BUFC = al4k(WS_BUFB + (size_t)8 * EROWS * FF * 2);
constexpr size_t BC_XC = 0;
constexpr size_t BC_ST = al4k(BC_XC + (size_t)NT * 896 * 2);
constexpr size_t BC_FA = al4k(BC_ST + (size_t)NB * NCH * 12 * 8192 * 2);
constexpr size_t BC_END = al4k(BC_FA + (size_t)NB * 4 * 64 * 64 * 128 * 2);
static_assert(BC_END >= (size_t)NE * EROWS * D * 2, "y must fit the mixer-temporary region");
constexpr size_t WS_END = WS_BUFC + BC_END;

constexpr int LDS_BYTES = 155648;
constexpr int MISC_OFF = 151552;

struct Params { const float* in[23]; float* out; unsigned char* ws; };

__device__ __forceinline__ float bf2f(bf16_t v) { return __uint_as_float((unsigned)v << 16); }
__device__ __forceinline__ unsigned pk2(float lo, float hi) { f32x2 v = {lo, hi}; bf16v2_t b = __builtin_convertvector(v, bf16v2_t); return __builtin_bit_cast(unsigned, b); }
__device__ __forceinline__ float lo2f(unsigned w) { return __uint_as_float(w << 16); }
__device__ __forceinline__ float hi2f(unsigned w) { return __uint_as_float(w & 0xffff0000u); }
__device__ __forceinline__ float wave_sum(float v) {
#pragma unroll
    for (int o = 1; o < 64; o <<= 1) v += __shfl_xor(v, o);
    return v;
}
__device__ __forceinline__ float siluf(float x) { return x / (1.f + __expf(-x)); }
__device__ __forceinline__ float softplusf(float x) { return fmaxf(x, 0.f) + log1pf(__expf(-fabsf(x))); }
__device__ __forceinline__ f32x4 mfma16(bf16x8 a, bf16x8 b, f32x4 c) { return __builtin_amdgcn_mfma_f32_16x16x32_bf16(a, b, c, 0, 0, 0); }
__device__ __forceinline__ bf16x8 frag_lds(const LAS bf16_t* base, int stride, int r0, int k0, int li, int gq) {
    return *(const LAS bf16x8*)(base + (r0 + li) * stride + k0 + 8 * gq);
}
__device__ __forceinline__ bf16x8 frag_glb(const bf16_t* base, size_t stride, int r0, int k0, int li, int gq) {
    return *(const bf16x8*)(base + (size_t)(r0 + li) * stride + k0 + 8 * gq);
}
__device__ __forceinline__ bf16x8 frag_tr(const LAS bf16_t* S, int stride, int k0, int n0, int li, int gq) {
    const LAS bf16_t* p = S + (k0 + 8 * gq + (li >> 2)) * stride + n0 + 4 * (li & 3);
    bf16x4 a = __builtin_amdgcn_ds_read_tr16_b64_v4i16((LAS bf16x4*)p);
    bf16x4 b = __builtin_amdgcn_ds_read_tr16_b64_v4i16((LAS bf16x4*)(p + 4 * stride));
    return (bf16x8){a[0], a[1], a[2], a[3], b[0], b[1], b[2], b[3]};
}
__device__ __forceinline__ bf16x8 frag_tr_split(const LAS bf16_t* S, int stride, int k0, int n0, int li, int gq) {
    const LAS bf16_t* p = S + (k0 + 4 * gq + (li >> 2)) * stride + n0 + 4 * (li & 3);
    bf16x4 a = __builtin_amdgcn_ds_read_tr16_b64_v4i16((LAS bf16x4*)p);
    bf16x4 b = __builtin_amdgcn_ds_read_tr16_b64_v4i16((LAS bf16x4*)(p + 16 * stride));
    return (bf16x8){a[0], a[1], a[2], a[3], b[0], b[1], b[2], b[3]};
}
__device__ __forceinline__ u32x2 pack4(f32x4 v) { u32x2 r; r.x = pk2(v[0], v[1]); r.y = pk2(v[2], v[3]); return r; }
#define LDS_FENCE() asm volatile("s_waitcnt lgkmcnt(0)" ::: "memory")

#define XB_TMO      128
#define XB_XCNT(j)  (256  + 64 * (j))
#define XB_XSUB(j)  (1280 + 64 * (j))
#define XB_XGEN(j)  (2304 + 64 * (j))
#define XB_TOP      3328
#define XB_TOPGEN   3392
#define XCD_BAR_WORDS 3456
#define XB_SPIN_CAP (1u << 22)
__device__ __forceinline__ unsigned xb_ld(unsigned* p)              { return __hip_atomic_load(p, __ATOMIC_RELAXED, __HIP_MEMORY_SCOPE_AGENT); }
__device__ __forceinline__ unsigned xb_add(unsigned* p, unsigned v) { return __hip_atomic_fetch_add(p, v, __ATOMIC_RELAXED, __HIP_MEMORY_SCOPE_AGENT); }
__device__ __forceinline__ unsigned xb_xcc_id() { return (unsigned)__builtin_amdgcn_s_getreg((3 << 11) | 20) & 0xFu; }
#define XB_SPIN(cond, bar) do { unsigned _sp = 0; while (cond) { __builtin_amdgcn_s_sleep(1); \
    if ((++_sp & 255u) == 0u) { if (xb_ld(&(bar)[XB_TMO])) break; if (_sp > XB_SPIN_CAP) { atomicAdd(&(bar)[XB_TMO], 1u); break; } } } } while (0)
struct XcdBarrier { unsigned* bar; unsigned x; volatile LAS unsigned* st; };
__device__ __forceinline__ XcdBarrier xcd_barrier_post(unsigned* bar, volatile LAS unsigned* st) {
    XcdBarrier b; b.bar = bar; b.x = xb_xcc_id(); b.st = st;
    if (threadIdx.x == 0) (void)xb_add(&bar[XB_XCNT(b.x)], 1u);
    return b;
}
__device__ __forceinline__ void xcd_barrier_complete(unsigned* bar, unsigned x, unsigned& nloc, unsigned& nx) {
    const unsigned G = gridDim.x * gridDim.y * gridDim.z;
    unsigned sum, cnt, mine, sp = 0u;
    for (;;) {
        sum = 0u; cnt = 0u; mine = 0u;
#pragma unroll
        for (unsigned j = 0; j < 16; ++j) { const unsigned c = xb_ld(&bar[XB_XCNT(j)]); sum += c; cnt += (c > 0u) ? 1u : 0u; mine = (j == x) ? c : mine; }
        if (sum == G) break;
        __builtin_amdgcn_s_sleep(1);
        if ((++sp & 255u) == 0u) { if (xb_ld(&bar[XB_TMO])) break; if (sp > XB_SPIN_CAP) { atomicAdd(&bar[XB_TMO], 1u); break; } }
    }
    nloc = mine > 0u ? mine : 1u; nx = cnt > 0u ? cnt : 1u;
}
__device__ __forceinline__ void xcd_barrier(const XcdBarrier& b) {
    asm volatile("s_waitcnt vmcnt(0)" ::: "memory");
    __syncthreads();
    if (threadIdx.x == 0) {
        unsigned* bar = b.bar;
        __builtin_amdgcn_s_waitcnt(0);
        unsigned nloc = b.st[0], nx = b.st[1];
        if (nloc == 0u) { xcd_barrier_complete(bar, b.x, nloc, nx); b.st[0] = nloc; b.st[1] = nx; }
        const unsigned old = xb_add(&bar[XB_XSUB(b.x)], 1u);
        const unsigned gen = old / nloc;
        if (old + 1u == (gen + 1u) * nloc) {
            __builtin_amdgcn_fence(__ATOMIC_RELEASE, "agent");
            asm volatile("s_waitcnt vmcnt(0)" ::: "memory");
            const unsigned og = xb_add(&bar[XB_TOP], 1u);
            const unsigned tg = og / nx;
            if (og + 1u == (tg + 1u) * nx) xb_add(&bar[XB_TOPGEN], 1u);
            else XB_SPIN(xb_ld(&bar[XB_TOPGEN]) == tg, bar);
            __builtin_amdgcn_fence(__ATOMIC_ACQUIRE, "agent");
            xb_add(&bar[XB_XGEN(b.x)], 1u);
            asm volatile("s_waitcnt vmcnt(0)" ::: "memory");
        } else {
            XB_SPIN(xb_ld(&bar[XB_XGEN(b.x)]) == gen, bar);
            __builtin_amdgcn_fence(__ATOMIC_ACQUIRE, "agent");
            asm volatile("s_waitcnt vmcnt(0)" ::: "memory");
        }
    }
    __syncthreads();
}
namespace pg8 {
constexpr int BM = 256, BK = 64, HALF = 128, HTB = HALF * BK * 2, STAGE_BYTES = 8 * HTB, NXCD = 8, WGM = 8;
__host__ __device__ __forceinline__ int lds_byte(int r, int c) { const int st = (r >> 4) * 2 + (c >> 5), rr = r & 15, cc = c & 31, ob = rr * 64 + cc * 2; return st * 1024 + (ob ^ (((ob >> 9) & 1) << 5)); }
__host__ __device__ __forceinline__ void stage_rc(int b, int& R, int& C) { const int st = b / 1024, sb = b % 1024, swz = sb ^ (((sb >> 9) & 1) << 5); R = (st >> 1) * 16 + swz / 64; C = (st & 1) * 32 + (swz % 64) / 2; }
__host__ __device__ __forceinline__ int perm32(int rho) { const int n = rho >> 4, i = rho & 15; return 8 * (i >> 2) + 4 * n + (i & 3); }

struct Unit { int pm, pn; };
struct GridOrder {
    int nM, nN, nwg, G, c;
    __device__ __forceinline__ void init(int nM_, int nN_, int G_, int c_) { nM = nM_; nN = nN_; nwg = nM * nN; G = G_; c = c_; }
    __device__ __forceinline__ bool next(int i, Unit& u) const {
        const long L = (long)i * G + c; if (L >= nwg) return false;
        int wgid = (int)L; { const int q = nwg / NXCD, r = nwg % NXCD, xcd = wgid % NXCD, off = wgid / NXCD; wgid = (xcd < r ? xcd * (q + 1) : r * (q + 1) + (xcd - r) * q) + off; }
        const int nig = WGM * nN, gid = wgid / nig, fm = gid * WGM, gsz = (nM - fm) < WGM ? (nM - fm) : WGM;
        u.pm = fm + ((wgid % nig) % gsz); u.pn = (wgid % nig) / gsz; return true;
    }
};

template <class Prob, class Epi>
__device__ __forceinline__ void gemm_phase(LAS unsigned char* lds, const int tid, const Prob& Pb, const GridOrder& S, const Epi& E) {
    const int wid = __builtin_amdgcn_readfirstlane(tid >> 6), lane = tid & 63, wr = wid >> 2, wc = wid & 3, fr = lane & 15, fq = lane >> 4;
    const int K = Pb.K, nt = K / BK;
    int Rr[2], Cc[2];
    unsigned voffB[2];
#pragma unroll
    for (int i = 0; i < 2; ++i) { int R, C; stage_rc(tid * 16 + i * 8192, R, C); Rr[i] = R; Cc[i] = C; const int Rb = Epi::PERM ? ((R & ~31) + perm32(R & 31)) : R;
        voffB[i] = (unsigned)(Rb * K + C) * 2u; }
    const size_t kstep = (size_t)(BK * 2);
    const size_t hstep = (size_t)HALF * K * 2;
    const unsigned ldsw = (unsigned)wid * 1024u;
    const int aoff = lds_byte(wr * 64 + fr, fq * 8), boff = lds_byte(wc * 32 + fr, fq * 8);
#define PG8_SA(b, h) (((b) * 2 + (h)) * HTB)
#define PG8_SB(b, h) ((4 + (b) * 2 + (h)) * HTB)
#define PG8_STAGE(bufoff, gbase, voff) do { _Pragma("unroll") for (int _i = 0; _i < 2; ++_i) \
        __builtin_amdgcn_global_load_lds((const unsigned*)((const char*)(gbase) + (voff)[_i]), (LAS unsigned*)(lds + (bufoff) + ldsw + _i * 8192), 16, 0, 0); } while (0)
#define PG8_LDA(dst, b, h) do { _Pragma("unroll") for (int m = 0; m < 4; ++m) _Pragma("unroll") for (int k = 0; k < 2; ++k) dst[m][k] = *(const LAS bf16x8*)(lds + PG8_SA(b, h) + aoff + m * 2048 + k * 1024); } while (0)
#define PG8_LDB(dst, b, h) do { _Pragma("unroll") for (int n = 0; n < 2; ++n) _Pragma("unroll") for (int k = 0; k < 2; ++k) dst[n][k] = *(const LAS bf16x8*)(lds + PG8_SB(b, h) + boff + n * 2048 + k * 1024); } while (0)
#define PG8_MMA(ai, bj, At, Bt) do { __builtin_amdgcn_s_setprio(1); _Pragma("unroll") for (int m = 0; m < 4; ++m) _Pragma("unroll") for (int n = 0; n < 2; ++n) _Pragma("unroll") for (int k = 0; k < 2; ++k) \
        acc[ai][bj][m][n] = __builtin_amdgcn_mfma_f32_16x16x32_bf16(Bt[n][k], At[m][k], acc[ai][bj][m][n], 0, 0, 0); __builtin_amdgcn_s_setprio(0); } while (0)
#define PG8_WAIT_V(n) asm volatile("s_waitcnt vmcnt(" #n ")" ::: "memory")
#define PG8_WAIT_L(n) asm volatile("s_waitcnt lgkmcnt(" #n ")" ::: "memory")
#define PG8_BAR __builtin_amdgcn_s_barrier()
#define PG8_SCHED __builtin_amdgcn_sched_barrier(0)
    Unit cur, nxt; int ui = 0;
    if (!S.next(0, cur)) return;
    f32x4 acc[2][2][4][2];
#pragma unroll
    for (int a = 0; a < 2; ++a)
#pragma unroll
        for (int b = 0; b < 2; ++b)
#pragma unroll
            for (int m = 0; m < 4; ++m)
#pragma unroll
                for (int n = 0; n < 2; ++n) acc[a][b][m][n] = (f32x4){0.f, 0.f, 0.f, 0.f};
    bf16x8 At[4][2], B0[2][2], B1[2][2];
    unsigned vA0[2], vA1[2], nA0[2], nA1[2];
#define PG8_AVOFF(u, d0, d1) do { const int _r0 = Pb.a_row0(u); _Pragma("unroll") for (int _i = 0; _i < 2; ++_i) { \
        if (Prob::GATHER) { const int _g0 = Pb.rowidx[_r0 + Rr[_i]], _g1 = Pb.rowidx[_r0 + HALF + Rr[_i]]; d0[_i] = (unsigned)(_g0 * K + Cc[_i]) * 2u; d1[_i] = (unsigned)(_g1 * K + Cc[_i]) * 2u; } \
        else { d0[_i] = (unsigned)((_r0 + Rr[_i]) * K + Cc[_i]) * 2u; d1[_i] = (unsigned)((_r0 + HALF + Rr[_i]) * K + Cc[_i]) * 2u; } } } while (0)
    PG8_AVOFF(cur, vA0, vA1);
    const char* const Ab = (const char*)Pb.Abase;
    const char* cB = (const char*)Pb.Btbase + (size_t)Pb.b_row0(cur) * K * 2;
    PG8_STAGE(PG8_SB(0, 0), cB, voffB); PG8_STAGE(PG8_SA(0, 0), Ab, vA0); PG8_STAGE(PG8_SB(0, 1), cB + hstep, voffB); PG8_STAGE(PG8_SA(0, 1), Ab, vA1);
    if (wr == 1) PG8_BAR;
    PG8_WAIT_V(4); PG8_BAR;
    PG8_STAGE(PG8_SB(1, 0), cB + kstep, voffB); PG8_STAGE(PG8_SA(1, 0), Ab + kstep, vA0); PG8_STAGE(PG8_SB(1, 1), cB + hstep + kstep, voffB);
    PG8_WAIT_V(6); PG8_BAR;
    for (;;) {
        const bool has_next = S.next(ui + 1, nxt);
        const char* nB = cB;
        if (has_next) { PG8_AVOFF(nxt, nA0, nA1); nB = (const char*)Pb.Btbase + (size_t)Pb.b_row0(nxt) * K * 2; }
        else { nA0[0] = vA0[0]; nA0[1] = vA0[1]; nA1[0] = vA1[0]; nA1[1] = vA1[1]; }
        for (int t = 0; t < nt; t += 2) {
            const bool last = (t == nt - 2);
            const char* a1 = Ab + (size_t)(t + 1) * kstep;
            const char* a2 = last ? Ab : Ab + (size_t)(t + 2) * kstep; const char* b2 = last ? nB : cB + (size_t)(t + 2) * kstep;
            const char* a3 = a2 + kstep; const char* b3 = b2 + kstep;
            unsigned w0[2], w1[2];
            w0[0] = last ? nA0[0] : vA0[0]; w0[1] = last ? nA0[1] : vA0[1]; w1[0] = last ? nA1[0] : vA1[0]; w1[1] = last ? nA1[1] : vA1[1];
            PG8_LDB(B0, 0, 0); PG8_SCHED; PG8_LDA(At, 0, 0); PG8_STAGE(PG8_SA(1, 1), a1, vA1);
            PG8_WAIT_L(8); PG8_BAR; PG8_WAIT_L(0); PG8_MMA(0, 0, At, B0); PG8_BAR; PG8_SCHED;
            PG8_LDB(B1, 0, 1); PG8_STAGE(PG8_SB(0, 0), b2, voffB);
            PG8_BAR; PG8_WAIT_L(0); PG8_MMA(0, 1, At, B1); PG8_BAR;
            PG8_LDA(At, 0, 1); PG8_STAGE(PG8_SA(0, 0), a2, w0);
            PG8_BAR; PG8_WAIT_L(0); PG8_MMA(1, 0, At, B0); PG8_BAR; PG8_SCHED;
            PG8_STAGE(PG8_SB(0, 1), b2 + hstep, voffB);
            PG8_WAIT_V(6); PG8_BAR; PG8_MMA(1, 1, At, B1); PG8_BAR;
            PG8_LDB(B0, 1, 0); PG8_SCHED; PG8_LDA(At, 1, 0); PG8_STAGE(PG8_SA(0, 1), a2, w1);
            PG8_WAIT_L(8); PG8_BAR; PG8_WAIT_L(0); PG8_MMA(0, 0, At, B0); PG8_BAR; PG8_SCHED;
            PG8_LDB(B1, 1, 1); PG8_STAGE(PG8_SB(1, 0), b3, voffB);
            PG8_BAR; PG8_WAIT_L(0); PG8_MMA(0, 1, At, B1); PG8_BAR;
            PG8_LDA(At, 1, 1); PG8_STAGE(PG8_SA(1, 0), a3, w0);
            PG8_BAR; PG8_WAIT_L(0); PG8_MMA(1, 0, At, B0); PG8_BAR; PG8_SCHED;
            PG8_STAGE(PG8_SB(1, 1), b3 + hstep, voffB);
            PG8_WAIT_V(6); PG8_BAR; PG8_MMA(1, 1, At, B1); PG8_BAR;
        }
        E(acc, cur, wr, wc, fr, fq);
        if (!has_next) break;
#pragma unroll
        for (int a = 0; a < 2; ++a)
#pragma unroll
            for (int b = 0; b < 2; ++b)
#pragma unroll
                for (int m = 0; m < 4; ++m)
#pragma unroll
                    for (int n = 0; n < 2; ++n) acc[a][b][m][n] = (f32x4){0.f, 0.f, 0.f, 0.f};
        cur = nxt; cB = nB; vA0[0] = nA0[0]; vA0[1] = nA0[1]; vA1[0] = nA1[0]; vA1[1] = nA1[1]; ++ui;
    }
    PG8_WAIT_V(0);
    if (wr == 0) PG8_BAR;
    PG8_BAR;
#undef PG8_SA
#undef PG8_SB
#undef PG8_STAGE
#undef PG8_LDA
#undef PG8_LDB
#undef PG8_MMA
#undef PG8_WAIT_V
#undef PG8_WAIT_L
#undef PG8_BAR
#undef PG8_SCHED
#undef PG8_AVOFF
}
__device__ __forceinline__ unsigned cvt_pk_bf16(float lo, float hi) { unsigned r; asm volatile("v_cvt_pk_bf16_f32 %0, %1, %2" : "=v"(r) : "v"(lo), "v"(hi)); return r; }

struct DenseProb {
    static constexpr bool GATHER = false;
    const bf16_t* Abase; const bf16_t* Btbase; const int* rowidx; int K;
    __device__ __forceinline__ int a_row0(const Unit& u) const { return u.pm * BM; }
    __device__ __forceinline__ int b_row0(const Unit& u) const { return u.pn * BM; }
};
struct EpiBf16 {
    static constexpr bool PERM = true;
    bf16_t* O; int ldc;
    __device__ __forceinline__ void operator()(const f32x4 (&acc)[2][2][4][2], const Unit& u, int wr, int wc, int fr, int fq) const {
        const int row0 = u.pm * BM + wr * 64 + fr, col0 = u.pn * BM + wc * 32 + 8 * fq;
#pragma unroll
        for (int ai = 0; ai < 2; ++ai)
#pragma unroll
            for (int m = 0; m < 4; ++m) { bf16_t* rowp = O + (size_t)(row0 + ai * HALF + m * 16) * ldc + col0;
#pragma unroll
                for (int bj = 0; bj < 2; ++bj) { const f32x4 v0 = acc[ai][bj][m][0], v1 = acc[ai][bj][m][1];
                    u32x4 w; w.x = cvt_pk_bf16(v0[0], v0[1]); w.y = cvt_pk_bf16(v0[2], v0[3]); w.z = cvt_pk_bf16(v1[0], v1[1]); w.w = cvt_pk_bf16(v1[2], v1[3]);
                    *(u32x4*)(rowp + bj * HALF) = w; } }
    }
};
struct MoeMap { int EG, e0;
    __device__ __forceinline__ void split(int pm, int& el, int& mt) const { if (pm < EG * 32) { el = pm >> 5; mt = pm & 31; } else { const int q = pm - EG * 32; el = q >> 1; mt = 32 + (q & 1); } }
};
struct GuProb {
    static constexpr bool GATHER = true;
    const bf16_t* Abase; const bf16_t* Btbase; const int* rowidx; int K; MoeMap mp;
    __device__ __forceinline__ int a_row0(const Unit& u) const { int el, mt; mp.split(u.pm, el, mt); return (mp.e0 + el) * EROWS + mt * BM; }
    __device__ __forceinline__ int b_row0(const Unit& u) const { int el, mt; mp.split(u.pm, el, mt); return (mp.e0 + el) * (2 * FF) + u.pn * BM; }
};
struct EpiGU {
    static constexpr bool PERM = true;
    bf16_t* he; MoeMap mp;
    __device__ __forceinline__ void operator()(const f32x4 (&acc)[2][2][4][2], const Unit& u, int wr, int wc, int fr, int fq) const {
        int el, mt; mp.split(u.pm, el, mt);
        const int row0 = el * EROWS + mt * BM + wr * 64 + fr, col0 = u.pn * HALF + wc * 32 + 8 * fq;
#pragma unroll
        for (int ai = 0; ai < 2; ++ai)
#pragma unroll
            for (int m = 0; m < 4; ++m) { bf16_t* rowp = he + (size_t)(row0 + ai * HALF + m * 16) * FF + col0;
                float o[8];
#pragma unroll
                for (int n = 0; n < 2; ++n)
#pragma unroll
                    for (int j = 0; j < 4; ++j) { const float g = acc[ai][0][m][n][j], up = acc[ai][1][m][n][j]; o[n * 4 + j] = g / (1.f + __expf(-g)) * up; }
                u32x4 w; w.x = cvt_pk_bf16(o[0], o[1]); w.y = cvt_pk_bf16(o[2], o[3]); w.z = cvt_pk_bf16(o[4], o[5]); w.w = cvt_pk_bf16(o[6], o[7]);
                *(u32x4*)rowp = w; }
    }
};
struct DownProb {
    static constexpr bool GATHER = false;
    const bf16_t* Abase; const bf16_t* Btbase; const int* rowidx; int K; MoeMap mp;
    __device__ __forceinline__ int a_row0(const Unit& u) const { int el, mt; mp.split(u.pm, el, mt); return el * EROWS + mt * BM; }
    __device__ __forceinline__ int b_row0(const Unit& u) const { int el, mt; mp.split(u.pm, el, mt); return (mp.e0 + el) * D + u.pn * BM; }
};
struct EpiDown {
    static constexpr bool PERM = true;
    bf16_t* y; const float* gate; MoeMap mp;
    __device__ __forceinline__ void operator()(const f32x4 (&acc)[2][2][4][2], const Unit& u, int wr, int wc, int fr, int fq) const {
        int el, mt; mp.split(u.pm, el, mt);
        const int row0 = (mp.e0 + el) * EROWS + mt * BM + wr * 64 + fr, col0 = u.pn * BM + wc * 32 + 8 * fq;
#pragma unroll
        for (int ai = 0; ai < 2; ++ai)
#pragma unroll
            for (int m = 0; m < 4; ++m) { const int row = row0 + ai * HALF + m * 16; const float g = gate[row]; bf16_t* rowp = y + (size_t)row * D + col0;
#pragma unroll
                for (int bj = 0; bj < 2; ++bj) { const f32x4 v0 = acc[ai][bj][m][0] * g, v1 = acc[ai][bj][m][1] * g;
                    u32x4 w; w.x = cvt_pk_bf16(v0[0], v0[1]); w.y = cvt_pk_bf16(v0[2], v0[3]); w.z = cvt_pk_bf16(v1[0], v1[1]); w.w = cvt_pk_bf16(v1[2], v1[3]);
                    *(u32x4*)(rowp + bj * HALF) = w; } }
    }
};
}
struct Frame {
    LAS unsigned char* lds;
    int tid, lane, wave, G, bid;
    float* out; unsigned char* ws;
};
__device__ __forceinline__ const float* INP(int i) {
    const __attribute__((address_space(4))) char* k = (const __attribute__((address_space(4))) char*)__builtin_amdgcn_kernarg_segment_ptr();
    asm volatile("" : "+s"(k));
    return *(const float* const __attribute__((address_space(4)))*)(k + 8 * i);
}
#define IN_X 0
#define IN_C 1
#define IN_CTX 2
#define IN_CCTX 3
#define IN_WADA 4
#define IN_BADA 5
#define IN_GMIXPRE 6
#define IN_GMIXPOST 7
#define IN_GFFNPRE 8
#define IN_GFFNPOST 9
#define IN_WIN 10
#define IN_CONVW 11
#define IN_CONVB 12
#define IN_DTBIAS 13
#define IN_ALOG 14
#define IN_DSKIP 15
#define IN_GSSD 16
#define IN_SINK 17
#define IN_WOUT 18
#define IN_WROUTER 19
#define IN_WGATE 20
#define IN_WUP 21
#define IN_WDOWN 22

__device__ __forceinline__ const float* mod_ptr(const Frame& F, int l, int row  , int part  ) {
    return (const float*)(F.ws + WS_MOD) + ((size_t)(l * 17 + row) * 6144 + part * 1024);
}
__device__ __forceinline__ int tok_modrow(int row) { return row < NLAT ? (row >> 12) : 16; }

template <class RowMap>
__device__ __forceinline__ void transpose_item(const float* W, int K, int N, bf16_t* WT, RowMap rm, LAS float* scr, int kb, int nb, int lane) {
    const int k0 = 64 * kb, n0 = 32 * nb;
    const int nn = n0 + (lane & 31);
#pragma unroll 8
    for (int i = 0; i < 32; ++i) { const int kk = 2 * i + (lane >> 5); scr[kk * 33 + (lane & 31)] = (nn < N) ? W[(size_t)(k0 + kk) * N + nn] : 0.f; }
    LDS_FENCE();
    const int c = lane & 7;
#pragma unroll
    for (int j = 0; j < 4; ++j) { const int n = (lane >> 3) + 8 * j; const LAS float* s = scr + (8 * c) * 33 + n;
        u32x4 o; o.x = pk2(s[0 * 33], s[1 * 33]); o.y = pk2(s[2 * 33], s[3 * 33]); o.z = pk2(s[4 * 33], s[5 * 33]); o.w = pk2(s[6 * 33], s[7 * 33]);
        *(u32x4*)(WT + (size_t)rm(n0 + n) * K + k0 + 8 * c) = o; }
    LDS_FENCE();
}
struct RmId { __device__ __forceinline__ int operator()(int n) const { return n; } };
struct RmGU { int s; __device__ __forceinline__ int operator()(int n) const { return 256 * (n >> 7) + 128 * s + (n & 127); } };

__device__ __forceinline__ void convert_experts(const Frame& F, int l) {
    LAS float* scr = (LAS float*)(F.lds + F.wave * 16384);
    const int gw = F.bid * NWAVES + F.wave, NGW = F.G * NWAVES;
    constexpr int I_G = 16 * 88, I_D = 44 * 32;
    constexpr int PER_E = 2 * I_G + I_D;
    bf16_t* Wgu = (bf16_t*)(F.ws + WS_WGU); bf16_t* Wd = (bf16_t*)(F.ws + WS_WD);
    for (int it = gw; it < NE * PER_E; it += NGW) {
        const int e = it / PER_E; int r = it % PER_E;
        if (r < I_G) { transpose_item(INP(IN_WGATE) + (size_t)(l * NE + e) * D * FF, D, FF, Wgu + (size_t)e * 2 * FF * D, RmGU{0}, scr, r / 88, r % 88, F.lane); continue; } r -= I_G;
        if (r < I_G) { transpose_item(INP(IN_WUP) + (size_t)(l * NE + e) * D * FF, D, FF, Wgu + (size_t)e * 2 * FF * D, RmGU{1}, scr, r / 88, r % 88, F.lane); continue; } r -= I_G;
        transpose_item(INP(IN_WDOWN) + (size_t)(l * NE + e) * FF * D, FF, D, Wd + (size_t)e * D * FF, RmId{}, scr, r / 32, r % 32, F.lane);
    }
}

__device__ __forceinline__ void p0_prologue(const Frame& F) {
    if (F.bid < 192) {
        LAS float* sc = (LAS float*)F.lds;
        LAS float* red = (LAS float*)(F.lds + 17 * 1024 * 4);
        for (int i = F.tid; i < 17 * 1024; i += NTHR) { const int r = i >> 10, k = i & 1023; const float v = r < 16 ? INP(IN_C)[r * 1024 + k] : INP(IN_CCTX)[k]; sc[i] = siluf(v); }
        __syncthreads();
        const int l = F.bid / 96, n0 = (F.bid % 96) * 64;
        const float* W = INP(IN_WADA) + (size_t)l * D * 6144 + n0 + F.lane;
        float acc[17];
#pragma unroll
        for (int r = 0; r < 17; ++r) acc[r] = 0.f;
        for (int k = F.wave; k < 1024; k += 8) { const float w = W[(size_t)k * 6144];
#pragma unroll
            for (int r = 0; r < 17; ++r) acc[r] += sc[r * 1024 + k] * w; }
#pragma unroll
        for (int r = 0; r < 17; ++r) red[(F.wave * 17 + r) * 64 + F.lane] = acc[r];
        __syncthreads();
        for (int i = F.tid; i < 17 * 64; i += NTHR) { const int r = i >> 6, c = i & 63; float s = 0.f;
#pragma unroll
            for (int w = 0; w < 8; ++w) s += red[(w * 17 + r) * 64 + c];
            ((float*)(F.ws + WS_MOD))[(size_t)(l * 17 + r) * 6144 + n0 + c] = s + INP(IN_BADA)[l * 6144 + n0 + c]; }
        __syncthreads();
    }
    if (F.bid == 255) {
        for (int i = F.tid; i < 1024; i += NTHR) { const int pos = i >> 4, f = i & 15; const float inv = powf(10000.f, -(float)f / 16.f); const float ang = (float)pos * inv;
            ((float*)(F.ws + WS_ROPE))[2 * i] = cosf(ang); ((float*)(F.ws + WS_ROPE))[2 * i + 1] = sinf(ang); }
    }
    {
        LAS float* scr = (LAS float*)(F.lds + F.wave * 16384);
        const int gw = F.bid * NWAVES + F.wave, NGW = F.G * NWAVES;
        constexpr int I_IN = 16 * 72, I_OUT = 16 * 32;
        for (int it = gw; it < 2 * (I_IN + I_OUT); it += NGW) {
            const int l = it / (I_IN + I_OUT); int r = it % (I_IN + I_OUT);
            if (r < I_IN) { transpose_item(INP(IN_WIN) + (size_t)l * D * INW, D, INW, (bf16_t*)(F.ws + WS_WIN) + (size_t)l * PW * D, RmId{}, scr, r / 72, r % 72, F.lane); continue; } r -= I_IN;
            transpose_item(INP(IN_WOUT) + (size_t)l * D * D, D, D, (bf16_t*)(F.ws + WS_WOUT) + (size_t)l * D * D, RmId{}, scr, r / 32, r % 32, F.lane);
        }
    }
    convert_experts(F, 0);
}

struct Row16 { f32x4 v[4]; };
__device__ __forceinline__ Row16 ld_row_f32(const float* p, int lane) { Row16 r; const f32x4* q = (const f32x4*)p + lane;
#pragma unroll
    for (int j = 0; j < 4; ++j) r.v[j] = q[64 * j];
    return r; }
__device__ __forceinline__ void st_row_f32(float* p, int lane, const Row16& r) { f32x4* q = (f32x4*)p + lane;
#pragma unroll
    for (int j = 0; j < 4; ++j) q[64 * j] = r.v[j]; }
__device__ __forceinline__ Row16 ld_row_bf16(const bf16_t* p, int lane) { Row16 r; const u32x2* q = (const u32x2*)p + lane;
#pragma unroll
    for (int j = 0; j < 4; ++j) { const u32x2 w = q[64 * j]; r.v[j] = (f32x4){lo2f(w.x), hi2f(w.x), lo2f(w.y), hi2f(w.y)}; }
    return r; }
__device__ __forceinline__ void st_row_bf16(bf16_t* p, int lane, const Row16& r) { u32x2* q = (u32x2*)p + lane;
#pragma unroll
    for (int j = 0; j < 4; ++j) { u32x2 w; w.x = pk2(r.v[j][0], r.v[j][1]); w.y = pk2(r.v[j][2], r.v[j][3]); q[64 * j] = w; } }
__device__ __forceinline__ float row_rstd(const Row16& r) { float s = 0.f;
#pragma unroll
    for (int j = 0; j < 4; ++j) s += (r.v[j][0] * r.v[j][0] + r.v[j][1] * r.v[j][1]) + (r.v[j][2] * r.v[j][2] + r.v[j][3] * r.v[j][3]);
    return rsqrtf(wave_sum(s) * (1.f / D) + EPS); }
__device__ __forceinline__ Row16 norm_mod(const Row16& h, const float* g, const float* sh, const float* sc, int lane) {
    const float rstd = row_rstd(h); const Row16 G = ld_row_f32(g, lane), SH = ld_row_f32(sh, lane), SC = ld_row_f32(sc, lane); Row16 u;
#pragma unroll
    for (int j = 0; j < 4; ++j) u.v[j] = (h.v[j] * rstd * G.v[j]) * (SC.v[j] + 1.f) + SH.v[j];
    return u; }

__device__ __forceinline__ void e1_phase(const Frame& F) {
    const int gw = F.bid * NWAVES + F.wave, NGW = F.G * NWAVES;
    bf16_t* U = (bf16_t*)(F.ws + WS_BUFA);
    for (int row = gw; row < NT; row += NGW) {
        const float* src = row < NLAT ? INP(IN_X) + (size_t)row * D : INP(IN_CTX) + (size_t)(row - NLAT) * D;
        const int mr = tok_modrow(row);
        const Row16 h = ld_row_f32(src, F.lane);
        const Row16 u = norm_mod(h, INP(IN_GMIXPRE), mod_ptr(F, 0, mr, 0), mod_ptr(F, 0, mr, 1), F.lane);
        st_row_bf16(U + (size_t)row * D, F.lane, u);
    }
}

__device__ __forceinline__ void e3_phase(const Frame& F, int l) {
    const int nrows = (l == 0) ? NT : NLAT;
    LAS float* wr = (LAS float*)F.lds;
    for (int i = F.tid; i < 1024 * 16 / 4; i += NTHR) ((LAS f32x4*)wr)[i] = ((const f32x4*)(INP(IN_WROUTER) + (size_t)l * D * 16))[i];
    __syncthreads();
    const int gw = F.bid * NWAVES + F.wave, NGW = F.G * NWAVES;
    const bf16_t* M = (const bf16_t*)(F.ws + WS_BUFB); bf16_t* U2 = (bf16_t*)(F.ws + WS_BUFA); float* AFF = (float*)(F.ws + WS_AFF);
    for (int row = gw; row < nrows; row += NGW) {
        const float* hsrc; float* hdst;
        if (row < NLAT) { hsrc = (l == 0) ? INP(IN_X) + (size_t)row * D : F.out + (size_t)row * D; hdst = F.out + (size_t)row * D; }
        else { hsrc = INP(IN_CTX) + (size_t)(row - NLAT) * D; hdst = (float*)(F.ws + WS_HCTX) + (size_t)(row - NLAT) * D; }
        const int mr = tok_modrow(row);
        const Row16 m = ld_row_bf16(M + (size_t)row * D, F.lane);
        Row16 h = ld_row_f32(hsrc, F.lane);
        { const float rstd = row_rstd(m); const Row16 G = ld_row_f32(INP(IN_GMIXPOST) + l * D, F.lane), GT = ld_row_f32(mod_ptr(F, l, mr, 2), F.lane);
#pragma unroll
          for (int j = 0; j < 4; ++j) h.v[j] = h.v[j] + GT.v[j] * (m.v[j] * rstd * G.v[j]); }
        st_row_f32(hdst, F.lane, h);
        const Row16 u = norm_mod(h, INP(IN_GFFNPRE) + l * D, mod_ptr(F, l, mr, 3), mod_ptr(F, l, mr, 4), F.lane);
        st_row_bf16(U2 + (size_t)row * D, F.lane, u);
        float lg[16];
#pragma unroll
        for (int e = 0; e < 16; ++e) lg[e] = 0.f;
#pragma unroll
        for (int j = 0; j < 4; ++j)
#pragma unroll
            for (int q = 0; q < 4; ++q) { const int col = 4 * F.lane + 256 * j + q; const float x = u.v[j][q];
                asm volatile("" ::: "memory");
#pragma unroll
                for (int e4 = 0; e4 < 4; ++e4) { const f32x4 w = *(const LAS f32x4*)(wr + col * 16 + e4 * 4);
                    lg[e4 * 4 + 0] += x * w[0]; lg[e4 * 4 + 1] += x * w[1]; lg[e4 * 4 + 2] += x * w[2]; lg[e4 * 4 + 3] += x * w[3]; } }
        float mx = -1e30f;
#pragma unroll
        for (int e = 0; e < 16; ++e) { lg[e] = wave_sum(lg[e]); mx = fmaxf(mx, lg[e]); }
        float s = 0.f;
#pragma unroll
        for (int e = 0; e < 16; ++e) { lg[e] = __expf(lg[e] - mx); s += lg[e]; }
        const float inv = 1.f / s;
        float mine = 0.f;
#pragma unroll
        for (int e = 0; e < 16; ++e) mine = (F.lane == e) ? lg[e] * inv : mine;
        if (F.lane < 16) AFF[(size_t)row * 16 + F.lane] = mine;
    }
}

__device__ __forceinline__ void e5_phase(const Frame& F, int l) {
    const int nrows = (l == 0) ? NT : NLAT;
    const int gw = F.bid * NWAVES + F.wave, NGW = F.G * NWAVES;
    const bf16_t* Y = (const bf16_t*)(F.ws + WS_BUFC); const short* SL = (const short*)(F.ws + WS_SLOT); bf16_t* U = (bf16_t*)(F.ws + WS_BUFA);
    for (int row = gw; row < nrows; row += NGW) {
        float* hp = row < NLAT ? F.out + (size_t)row * D : (float*)(F.ws + WS_HCTX) + (size_t)(row - NLAT) * D;
        const int mr = tok_modrow(row);
        const int myslot = (F.lane < 16) ? (int)SL[(size_t)row * 16 + F.lane] : -1;
        Row16 f;
#pragma unroll
        for (int j = 0; j < 4; ++j) f.v[j] = (f32x4){0.f, 0.f, 0.f, 0.f};
        for (int e = 0; e < 16; ++e) { const int sl = __shfl(myslot, e);
            if (sl >= 0) { const Row16 y = ld_row_bf16(Y + ((size_t)e * EROWS + sl) * D, F.lane);
#pragma unroll
                for (int j = 0; j < 4; ++j) f.v[j] += y.v[j]; } }
        Row16 h = ld_row_f32(hp, F.lane);
        { const float rstd = row_rstd(f); const Row16 G = ld_row_f32(INP(IN_GFFNPOST) + l * D, F.lane), GT = ld_row_f32(mod_ptr(F, l, mr, 5), F.lane);
#pragma unroll
          for (int j = 0; j < 4; ++j) h.v[j] = h.v[j] + GT.v[j] * (f.v[j] * rstd * G.v[j]); }
        st_row_f32(hp, F.lane, h);
        if (l == 0) { const Row16 u = norm_mod(h, INP(IN_GMIXPRE) + D, mod_ptr(F, 1, mr, 0), mod_ptr(F, 1, mr, 1), F.lane); st_row_bf16(U + (size_t)row * D, F.lane, u); }
    }
}

__device__ __forceinline__ void topk_unit(const Frame& F, int kind, int e, int b) {
    const int T = kind ? CTX : SEQ, cap = kind ? 32 : 512;
    const int row0 = kind ? NLAT + b * CTX : b * SEQ, base = kind ? 8192 + b * 32 : b * 512;
    LAS unsigned long long* key = (LAS unsigned long long*)F.lds;
    const float* AFF = (const float*)(F.ws + WS_AFF);
    for (int t = F.tid; t < T; t += NTHR) { const float a = AFF[(size_t)(row0 + t) * 16 + e]; key[t] = ((unsigned long long)__float_as_uint(a) << 32) | (unsigned)(0xFFFFFFFFu - (unsigned)t); }
    __syncthreads();
    for (int k = 2; k <= T; k <<= 1)
        for (int j = k >> 1; j > 0; j >>= 1) {
            for (int i = F.tid; i < T; i += NTHR) { const int x = i ^ j;
                if (x > i) { const unsigned long long a = key[i], c = key[x]; const bool desc = ((i & k) == 0);
                    if (desc ? (a < c) : (a > c)) { key[i] = c; key[x] = a; } } }
            __syncthreads();
        }
    int* RI = (int*)(F.ws + WS_ROWIDX); float* GT = (float*)(F.ws + WS_GATE); short* SL = (short*)(F.ws + WS_SLOT);
    for (int s = F.tid; s < T; s += NTHR) { const unsigned long long kk = key[s]; const int t = (int)(0xFFFFFFFFu - (unsigned)kk);
        if (s < cap) { RI[e * EROWS + base + s] = row0 + t; GT[e * EROWS + base + s] = __uint_as_float((unsigned)(kk >> 32)); SL[(size_t)(row0 + t) * 16 + e] = (short)(base + s); }
        else SL[(size_t)(row0 + t) * 16 + e] = (short)-1; }
    __syncthreads();
}
__device__ __forceinline__ void topk_phase(const Frame& F, int l) {
    const int nunits = (l == 0) ? 512 : 256;
    for (int u = F.bid; u < nunits; u += F.G) { const int kind = u >> 8, e = (u & 255) >> 4, b = u & 15; topk_unit(F, kind, e, b); }
}
__device__ __forceinline__ void chunk_geom(int b, int c, int& rbase, int& t0, int& Tseg) {
    if (c < 2) { rbase = NLAT + b * CTX; t0 = c * 128; Tseg = CTX; } else { rbase = b * SEQ; t0 = (c - 2) * 128; Tseg = SEQ; }
}
__device__ __forceinline__ size_t st_index(int b, int c, int dir, int h) { return ((((size_t)b * NCH + c) * 2 + dir) * 6 + h) * 8192; }

__device__ __forceinline__ void dt_scan(const Frame& F, int l, const bf16_t* Pp, int row0, int dir, int h, float (&dt)[2], float (&incl)[2], float (&dA)[2], float& total) {
    const float bias = INP(IN_DTBIAS)[(l * 2 + dir) * 6 + h], a = -__expf(INP(IN_ALOG)[(l * 2 + dir) * 6 + h]);
#pragma unroll
    for (int q = 0; q < 2; ++q) { const float raw = bf2f(Pp[(size_t)(row0 + 2 * F.lane + q) * PW + PDT + dir * 6 + h]); dt[q] = softplusf(raw + bias); dA[q] = dt[q] * a; }
    float x = dA[0] + dA[1];
#pragma unroll
    for (int o = 1; o < 64; o <<= 1) { const float v = __shfl_up(x, o); if (F.lane >= o) x += v; }
    incl[1] = x; incl[0] = x - dA[1];
    total = __shfl(x, 63);
}

__device__ __forceinline__ void s1_unit(const Frame& F, int l, int b, int c, int g) {
    int rbase, t0, Tseg; chunk_geom(b, c, rbase, t0, Tseg);
    LAS bf16_t* Xs = (LAS bf16_t*)F.lds;
    LAS bf16_t* Bs = (LAS bf16_t*)(F.lds + 51200);
    LAS float* WF = (LAS float*)(F.lds + 86016);
    LAS float* WB = (LAS float*)(F.lds + 87552);
    const bf16_t* Pp = (const bf16_t*)(F.ws + WS_BUFB);
    bf16_t* XC = (bf16_t*)(F.ws + WS_BUFC + BC_XC);
    __syncthreads();
    if (F.tid < 448) {
        const int cg = F.tid % 56, run = F.tid / 56;
        const int ch = cg < 24 ? g * 192 + cg * 8 : (cg < 40 ? 384 + g * 128 + (cg - 24) * 8 : 640 + g * 128 + (cg - 40) * 8);
        float w[5][8], bias[8];
#pragma unroll
        for (int k = 0; k < 5; ++k) { const f32x4 a = *(const f32x4*)(INP(IN_CONVW) + (size_t)(l * 5 + k) * 896 + ch), bb = *(const f32x4*)(INP(IN_CONVW) + (size_t)(l * 5 + k) * 896 + ch + 4);
#pragma unroll
            for (int q = 0; q < 4; ++q) { w[k][q] = a[q]; w[k][4 + q] = bb[q]; } }
        { const f32x4 a = *(const f32x4*)(INP(IN_CONVB) + l * 896 + ch), bb = *(const f32x4*)(INP(IN_CONVB) + l * 896 + ch + 4);
#pragma unroll
          for (int q = 0; q < 4; ++q) { bias[q] = a[q]; bias[4 + q] = bb[q]; } }
        float win[5][8];
        const int tt0 = 16 * run;
#define S1_LOADROW(dst, t) do { const int _t = (t); if (_t >= 0 && _t < Tseg) { const u32x4 _v = *(const u32x4*)(Pp + (size_t)(rbase + _t) * PW + PX + ch); \
            dst[0] = lo2f(_v.x); dst[1] = hi2f(_v.x); dst[2] = lo2f(_v.y); dst[3] = hi2f(_v.y); dst[4] = lo2f(_v.z); dst[5] = hi2f(_v.z); dst[6] = lo2f(_v.w); dst[7] = hi2f(_v.w); } \
            else { _Pragma("unroll") for (int _q = 0; _q < 8; ++_q) dst[_q] = 0.f; } } while (0)
        S1_LOADROW(win[0], t0 + tt0 - 2); S1_LOADROW(win[1], t0 + tt0 - 1); S1_LOADROW(win[2], t0 + tt0); S1_LOADROW(win[3], t0 + tt0 + 1);
#pragma unroll 1
        for (int i = 0; i < 16; ++i) {
            S1_LOADROW(win[4], t0 + tt0 + i + 2);
            float o[8];
#pragma unroll
            for (int q = 0; q < 8; ++q) { float s = bias[q];
#pragma unroll
                for (int k = 0; k < 5; ++k) s += w[k][q] * win[k][q];
                o[q] = siluf(s); }
            u32x4 pk; pk.x = pk2(o[0], o[1]); pk.y = pk2(o[2], o[3]); pk.z = pk2(o[4], o[5]); pk.w = pk2(o[6], o[7]);
            *(u32x4*)(XC + (size_t)(rbase + t0 + tt0 + i) * 896 + ch) = pk;
            if (cg < 24) *(LAS u32x4*)(Xs + (tt0 + i) * 200 + cg * 8) = pk;
            else if (cg < 40) *(LAS u32x4*)(Bs + (tt0 + i) * 136 + (cg - 24) * 8) = pk;
#pragma unroll
            for (int k = 0; k < 4; ++k)
#pragma unroll
                for (int q = 0; q < 8; ++q) win[k][q] = win[k + 1][q];
        }
#undef S1_LOADROW
    }
    if (F.wave < 6) {
        const int dir = F.wave / 3, r = F.wave % 3, h = g * 3 + r;
        float dt[2], incl[2], dA[2], total;
        dt_scan(F, l, Pp, rbase + t0, dir, h, dt, incl, dA, total);
#pragma unroll
        for (int q = 0; q < 2; ++q) {
            const float wgt = dir == 0 ? dt[q] * __expf(total - incl[q]) : dt[q] * __expf(incl[q] - dA[q]);
            (dir == 0 ? WF : WB)[r * 128 + 2 * F.lane + q] = wgt; }
        if (F.lane == 0) ((float*)(F.ws + WS_DECAY))[((b * NCH + c) * 2 + dir) * 6 + h] = __expf(total);
    }
    __syncthreads();
    {
        const int li = F.lane & 15, gq = F.lane >> 4, pt = F.wave & 3, nh = F.wave >> 2;
        bf16x8 fn[4][4];
#pragma unroll
        for (int ks = 0; ks < 4; ++ks)
#pragma unroll
            for (int nt = 0; nt < 4; ++nt) fn[ks][nt] = frag_tr(Bs, 136, 32 * ks, 16 * (4 * nh + nt), li, gq);
        bf16_t* ST = (bf16_t*)(F.ws + WS_BUFC + BC_ST);
#pragma unroll 1
        for (int combo = 0; combo < 6; ++combo) {
            const int dir = combo / 3, r = combo % 3, h = g * 3 + r;
            const LAS float* W = (dir == 0 ? WF : WB) + r * 128;
            f32x4 acc[4];
#pragma unroll
            for (int nt = 0; nt < 4; ++nt) acc[nt] = (f32x4){0.f, 0.f, 0.f, 0.f};
#pragma unroll
            for (int ks = 0; ks < 4; ++ks) {
                const bf16x8 xr = frag_tr(Xs, 200, 32 * ks, r * 64 + 16 * pt, li, gq);
                const f32x4 w0 = *(const LAS f32x4*)(W + 32 * ks + 8 * gq), w1 = *(const LAS f32x4*)(W + 32 * ks + 8 * gq + 4);
                u32x4 pw;
                pw.x = pk2(bf2f((bf16_t)xr[0]) * w0[0], bf2f((bf16_t)xr[1]) * w0[1]); pw.y = pk2(bf2f((bf16_t)xr[2]) * w0[2], bf2f((bf16_t)xr[3]) * w0[3]);
                pw.z = pk2(bf2f((bf16_t)xr[4]) * w1[0], bf2f((bf16_t)xr[5]) * w1[1]); pw.w = pk2(bf2f((bf16_t)xr[6]) * w1[2], bf2f((bf16_t)xr[7]) * w1[3]);
                const bf16x8 xw = __builtin_bit_cast(bf16x8, pw);
#pragma unroll
                for (int nt = 0; nt < 4; ++nt) acc[nt] = mfma16(fn[ks][nt], xw, acc[nt]);
            }
            bf16_t* dst = ST + st_index(b, c, dir, h) + (size_t)(16 * pt + li) * 128;
#pragma unroll
            for (int nt = 0; nt < 4; ++nt) *(u32x2*)(dst + 16 * (4 * nh + nt) + 4 * gq) = pack4(acc[nt]);
        }
    }
}

__device__ __forceinline__ void s2_phase(const Frame& F) {
    bf16_t* ST = (bf16_t*)(F.ws + WS_BUFC + BC_ST); const float* DEC = (const float*)(F.ws + WS_DECAY);
    for (int it = F.bid * NTHR + F.tid; it < NB * 2 * 6 * 64 * 16; it += F.G * NTHR) {
        const int n8 = it & 15, p = (it >> 4) & 63, hh = (it >> 10) % 6, dir = ((it >> 10) / 6) & 1, b = (it >> 10) / 12;
        float hst[8];
#pragma unroll
        for (int q = 0; q < 8; ++q) hst[q] = 0.f;
#pragma unroll 2
        for (int s = 0; s < NCH; ++s) {
            const int c = dir == 0 ? s : (s < 2 ? 1 - s : NCH + 1 - s);
            bf16_t* ptr = ST + st_index(b, c, dir, hh) + p * 128 + n8 * 8;
            const u32x4 v = *(const u32x4*)ptr;
            const float d = DEC[((b * NCH + c) * 2 + dir) * 6 + hh];
            u32x4 o; o.x = pk2(hst[0], hst[1]); o.y = pk2(hst[2], hst[3]); o.z = pk2(hst[4], hst[5]); o.w = pk2(hst[6], hst[7]);
            *(u32x4*)ptr = o;
            hst[0] = hst[0] * d + lo2f(v.x); hst[1] = hst[1] * d + hi2f(v.x); hst[2] = hst[2] * d + lo2f(v.y); hst[3] = hst[3] * d + hi2f(v.y);
            hst[4] = hst[4] * d + lo2f(v.z); hst[5] = hst[5] * d + hi2f(v.z); hst[6] = hst[6] * d + lo2f(v.w); hst[7] = hst[7] * d + hi2f(v.w);
        }
    }
}

__device__ __forceinline__ void s3_unit(const Frame& F, int l, int b, int c) {
    int rbase, t0, Tseg; chunk_geom(b, c, rbase, t0, Tseg);
    LAS bf16_t* Bs = (LAS bf16_t*)F.lds;
    LAS bf16_t* Xs = (LAS bf16_t*)(F.lds + 34816);
    LAS bf16_t* SCR = (LAS bf16_t*)(F.lds + 86016 + F.wave * 4352);
    LAS float* DTF = (LAS float*)(F.lds + 120832);
    LAS float* DTB = DTF + 384; LAS float* ACF = DTF + 768; LAS float* ACB = DTF + 1152;
    const bf16_t* Pp = (const bf16_t*)(F.ws + WS_BUFB);
    const bf16_t* XC = (const bf16_t*)(F.ws + WS_BUFC + BC_XC);
    const bf16_t* ST = (const bf16_t*)(F.ws + WS_BUFC + BC_ST);
    bf16_t* MIX = (bf16_t*)(F.ws + WS_BUFA);
    const int li = F.lane & 15, gq = F.lane >> 4, w = F.wave;
    const int itok = 16 * w + li;
    const size_t grow = (size_t)(rbase + t0 + itok);
    float ss = 0.f;
#pragma unroll 1
    for (int g = 0; g < 2; ++g) {
        __syncthreads();
        for (int i = F.tid; i < 128 * 40; i += NTHR) { const int t = i / 40, cc = i % 40; const size_t rr = (size_t)(rbase + t0 + t) * 896;
            if (cc < 24) *(LAS u32x4*)(Xs + t * 200 + cc * 8) = *(const u32x4*)(XC + rr + g * 192 + cc * 8);
            else *(LAS u32x4*)(Bs + t * 136 + (cc - 24) * 8) = *(const u32x4*)(XC + rr + 384 + g * 128 + (cc - 24) * 8); }
        if (w < 6) {
            const int dir = w / 3, r = w % 3, h = g * 3 + r;
            float dt[2], incl[2], dA[2], total;
            dt_scan(F, l, Pp, rbase + t0, dir, h, dt, incl, dA, total);
#pragma unroll
            for (int q = 0; q < 2; ++q) { const int tt = 2 * F.lane + q;
                if (dir == 0) { DTF[r * 128 + tt] = dt[q]; ACF[r * 128 + tt] = incl[q]; }
                else { DTB[r * 128 + tt] = dt[q]; ACB[r * 128 + tt] = total - (incl[q] - dA[q]); } }
        }
        bf16x8 cf[4];
#pragma unroll
        for (int ks = 0; ks < 4; ++ks) cf[ks] = *(const bf16x8*)(XC + grow * 896 + 640 + g * 128 + 32 * ks + 8 * gq);
        __syncthreads();
        f32x4 cb[8];
#pragma unroll
        for (int jt = 0; jt < 8; ++jt) { cb[jt] = (f32x4){0.f, 0.f, 0.f, 0.f};
#pragma unroll
            for (int ks = 0; ks < 4; ++ks) cb[jt] = mfma16(frag_lds(Bs, 136, 16 * jt, 32 * ks, li, gq), cf[ks], cb[jt]); }
#pragma unroll 1
        for (int r = 0; r < 3; ++r) {
            const int h = g * 3 + r;
            int itk = itok; asm volatile("" : "+v"(itk));
            const float af_i = ACF[r * 128 + itok], ab_i = ACB[r * 128 + itok];
#pragma unroll
            for (int jt = 0; jt < 8; ++jt) { const int jv = 16 * jt + 4 * gq;
                const f32x4 acf = *(const LAS f32x4*)(ACF + r * 128 + jv), dtf = *(const LAS f32x4*)(DTF + r * 128 + jv), acb = *(const LAS f32x4*)(ACB + r * 128 + jv), dtb = *(const LAS f32x4*)(DTB + r * 128 + jv);
                f32x4 mv;
#pragma unroll
                for (int q = 0; q < 4; ++q) { const int j = jv + q;
                    const float mfw = (float)(((itk - j) >> 31) + 1), mbw = (float)(((j - itk) >> 31) + 1);
                    const float ef = mfw * __expf(fminf(af_i - acf[q], 0.f)) * dtf[q];
                    const float eb = mbw * __expf(fminf(ab_i - acb[q], 0.f)) * dtb[q];
                    mv[q] = cb[jt][q] * (ef + eb); }
                *(LAS u32x2*)(SCR + li * 136 + jv) = pack4(mv); }
            LDS_FENCE();
            bf16x8 mf[4];
#pragma unroll
            for (int ks = 0; ks < 4; ++ks) mf[ks] = frag_lds(SCR, 136, 0, 32 * ks, li, gq);
            const float ef_i = __expf(af_i), eb_i = __expf(ab_i), dsk = INP(IN_DSKIP)[l * 6 + h];
            const bf16_t* Hf = ST + st_index(b, c, 0, h); const bf16_t* Hb = ST + st_index(b, c, 1, h);
#pragma unroll
            for (int pt = 0; pt < 4; ++pt) {
                f32x4 ya = (f32x4){0.f, 0.f, 0.f, 0.f}, gf = ya, gb = ya;
#pragma unroll
                for (int ks = 0; ks < 4; ++ks) {
                    ya = mfma16(frag_tr(Xs, 200, 32 * ks, r * 64 + 16 * pt, li, gq), mf[ks], ya);
                    gf = mfma16(frag_glb(Hf, 128, 16 * pt, 32 * ks, li, gq), cf[ks], gf);
                    gb = mfma16(frag_glb(Hb, 128, 16 * pt, 32 * ks, li, gq), cf[ks], gb); }
                const u32x2 xw = *(const LAS u32x2*)(Xs + itok * 200 + r * 64 + 16 * pt + 4 * gq);
                const u32x2 zw = *(const u32x2*)(Pp + grow * PW + PZ + h * 64 + 16 * pt + 4 * gq);
                const float xs_[4] = {lo2f(xw.x), hi2f(xw.x), lo2f(xw.y), hi2f(xw.y)}, zs_[4] = {lo2f(zw.x), hi2f(zw.x), lo2f(zw.y), hi2f(zw.y)};
                f32x4 o;
#pragma unroll
                for (int q = 0; q < 4; ++q) { const float y = ya[q] + ef_i * gf[q] + eb_i * gb[q] + dsk * xs_[q]; o[q] = y * siluf(zs_[q]); ss += o[q] * o[q]; }
                *(u32x2*)(MIX + grow * D + 640 + h * 64 + 16 * pt + 4 * gq) = pack4(o);
            }
            LDS_FENCE();
        }
    }
    ss += __shfl_xor(ss, 16); ss += __shfl_xor(ss, 32);
    const float rstd = rsqrtf(ss * (1.f / 384.f) + EPS);
    asm volatile("s_waitcnt vmcnt(0)" ::: "memory");
#pragma unroll 2
    for (int hp = 0; hp < 24; ++hp) { const int col = (hp >> 2) * 64 + 16 * (hp & 3) + 4 * gq; const f32x4 gs = *(const f32x4*)(INP(IN_GSSD) + l * 384 + col);
        const u32x2 yw = *(const u32x2*)(MIX + grow * D + 640 + col);
#if defined(DBG_ZERO_S)
        const f32x4 o = (f32x4){0.f, 0.f, 0.f, 0.f} * (rstd * gs + lo2f(yw.x));
#else
        const f32x4 o = (f32x4){lo2f(yw.x), hi2f(yw.x), lo2f(yw.y), hi2f(yw.y)} * rstd * gs;
#endif
        *(u32x2*)(MIX + grow * D + 640 + col) = pack4(o); }
}

__device__ __forceinline__ void attn_unit(const Frame& F, int l, int b, int nb, int kvh, bool ctxq) {
    LAS float* ROPE = (LAS float*)F.lds;
    LAS bf16_t* Kt = (LAS bf16_t*)(F.lds + 8192);
    LAS bf16_t* Vt = (LAS bf16_t*)(F.lds + 26624);
    const bf16_t* Pp = (const bf16_t*)(F.ws + WS_BUFB);
    bf16_t* MIX = (bf16_t*)(F.ws + WS_BUFA);
    const int li = F.lane & 15, gq = F.lane >> 4, w = F.wave;
    __syncthreads();
    for (int i = F.tid; i < 2048; i += NTHR) ROPE[i] = ((const float*)(F.ws + WS_ROPE))[i];
    __syncthreads();
    const int qrow_base = ctxq ? NLAT + b * CTX + nb * 128 : b * SEQ + nb * 128;
    bf16x8 qf[3][2]; float m[3], lsum[3];
    f32x4 o[4][3];
#pragma unroll
    for (int qt = 0; qt < 3; ++qt) {
        const int R = 48 * w + 16 * qt, r = R >> 7, qi = (R & 127) + li, h = kvh * 3 + r;
        const bf16_t* qp = Pp + (size_t)(qrow_base + qi) * PW + PQ + h * 64;
        const int tq = nb * 128 + qi;
#pragma unroll
        for (int ks = 0; ks < 2; ++ks) {
            const int d0 = 32 * ks + 8 * gq;
            const u32x4 own = *(const u32x4*)(qp + d0);
            float ov[8] = {lo2f(own.x), hi2f(own.x), lo2f(own.y), hi2f(own.y), lo2f(own.z), hi2f(own.z), lo2f(own.w), hi2f(own.w)};
            if (!ctxq) {
                const u32x4 par = *(const u32x4*)(qp + (d0 ^ 16));
                const float pv[8] = {lo2f(par.x), hi2f(par.x), lo2f(par.y), hi2f(par.y), lo2f(par.z), hi2f(par.z), lo2f(par.w), hi2f(par.w)};
                const int pos = ks == 0 ? (tq >> 6) : (tq & 63), f0 = (8 * gq) & 15;
#pragma unroll
                for (int j = 0; j < 8; ++j) { const float cs = ROPE[(pos * 16 + f0 + j) * 2], sn = ROPE[(pos * 16 + f0 + j) * 2 + 1];
                    ov[j] = (gq < 2) ? (ov[j] * cs - pv[j] * sn) : (pv[j] * sn + ov[j] * cs); }
            }
            u32x4 pq; pq.x = pk2(ov[0] * 0.125f, ov[1] * 0.125f); pq.y = pk2(ov[2] * 0.125f, ov[3] * 0.125f); pq.z = pk2(ov[4] * 0.125f, ov[5] * 0.125f); pq.w = pk2(ov[6] * 0.125f, ov[7] * 0.125f);
            qf[qt][ks] = __builtin_bit_cast(bf16x8, pq);
        }
        m[qt] = INP(IN_SINK)[l * 6 + h]; lsum[qt] = (gq == 0) ? 1.f : 0.f;
#pragma unroll
        for (int dt = 0; dt < 4; ++dt) o[dt][qt] = (f32x4){0.f, 0.f, 0.f, 0.f};
    }
    const int ntile = ctxq ? 2 : 5;
#pragma unroll 1
    for (int ti = 0; ti < ntile; ++ti) {
        const bool local = (!ctxq) && ti < 3;
        const int kb = nb - 1 + ti;
        if (local && (kb < 0 || kb >= 32)) continue;
        const int ct = ctxq ? ti : ti - 3;
        const int krow0 = local ? b * SEQ + kb * 128 : NLAT + b * CTX + ct * 128;
        __syncthreads();
        {
            const int key = F.tid >> 2, part = F.tid & 3, c1 = part < 2 ? part : part + 2, c2 = c1 + 2;
            const bf16_t* kp = Pp + (size_t)(krow0 + key) * PW + PK + kvh * 64;
            const u32x4 a = *(const u32x4*)(kp + 8 * c1), bq = *(const u32x4*)(kp + 8 * c2);
            u32x4 oa = a, ob = bq;
            if (local) {
                const float v1[8] = {lo2f(a.x), hi2f(a.x), lo2f(a.y), hi2f(a.y), lo2f(a.z), hi2f(a.z), lo2f(a.w), hi2f(a.w)};
                const float v2[8] = {lo2f(bq.x), hi2f(bq.x), lo2f(bq.y), hi2f(bq.y), lo2f(bq.z), hi2f(bq.z), lo2f(bq.w), hi2f(bq.w)};
                const int tk = kb * 128 + key, pos = c1 < 4 ? (tk >> 6) : (tk & 63), f0 = (8 * c1) & 15;
                float r1[8], r2[8];
#pragma unroll
                for (int j = 0; j < 8; ++j) { const float cs = ROPE[(pos * 16 + f0 + j) * 2], sn = ROPE[(pos * 16 + f0 + j) * 2 + 1]; r1[j] = v1[j] * cs - v2[j] * sn; r2[j] = v1[j] * sn + v2[j] * cs; }
                oa.x = pk2(r1[0], r1[1]); oa.y = pk2(r1[2], r1[3]); oa.z = pk2(r1[4], r1[5]); oa.w = pk2(r1[6], r1[7]);
                ob.x = pk2(r2[0], r2[1]); ob.y = pk2(r2[2], r2[3]); ob.z = pk2(r2[4], r2[5]); ob.w = pk2(r2[6], r2[7]);
            }
            *(LAS u32x4*)(Kt + key * 72 + 8 * c1) = oa; *(LAS u32x4*)(Kt + key * 72 + 8 * c2) = ob;
#pragma unroll
            for (int q = 0; q < 2; ++q) { const int idx = F.tid + 512 * q, k2 = idx >> 3, chv = idx & 7;
                *(LAS u32x4*)(Vt + k2 * 72 + 8 * chv) = *(const u32x4*)(Pp + (size_t)(krow0 + k2) * PW + PV + kvh * 64 + 8 * chv); }
        }
        __syncthreads();
        const bool masked = local && (kb != nb);
#pragma unroll
        for (int qt = 0; qt < 3; ++qt) {
            __builtin_amdgcn_sched_barrier(0);
            const int qpos = nb * 128 + (((48 * w + 16 * qt) & 127) + li);
#pragma unroll 1
            for (int hf = 0; hf < 2; ++hf) {
                f32x4 s[4];
#pragma unroll
                for (int kt = 0; kt < 4; ++kt) { s[kt] = (f32x4){0.f, 0.f, 0.f, 0.f};
#pragma unroll
                    for (int ks = 0; ks < 2; ++ks) s[kt] = mfma16(frag_lds(Kt, 72, 64 * hf + 16 * kt, 32 * ks, li, gq), qf[qt][ks], s[kt]); }
                float tmax = -1e30f;
#pragma unroll
                for (int kt = 0; kt < 4; ++kt)
#pragma unroll
                    for (int q = 0; q < 4; ++q) {
                        if (masked) { const int kpos = kb * 128 + 64 * hf + 16 * kt + 4 * gq + q; const int dd = qpos - kpos; if (dd > 128 || dd < -128) s[kt][q] = -1e30f; }
                        tmax = fmaxf(tmax, s[kt][q]); }
                tmax = fmaxf(tmax, __shfl_xor(tmax, 16)); tmax = fmaxf(tmax, __shfl_xor(tmax, 32));
                const float mnew = fmaxf(m[qt], tmax), alpha = __expf(m[qt] - mnew);
                float ps = 0.f;
#pragma unroll
                for (int kt = 0; kt < 4; ++kt)
#pragma unroll
                    for (int q = 0; q < 4; ++q) { const float pe = __expf(s[kt][q] - mnew); s[kt][q] = pe; ps += pe; }
                lsum[qt] = lsum[qt] * alpha + ps; m[qt] = mnew;
#pragma unroll
                for (int dt = 0; dt < 4; ++dt) o[dt][qt] = o[dt][qt] * alpha;
#pragma unroll
                for (int k4 = 0; k4 < 2; ++k4) {
                    u32x4 pp; pp.x = pk2(s[2 * k4][0], s[2 * k4][1]); pp.y = pk2(s[2 * k4][2], s[2 * k4][3]); pp.z = pk2(s[2 * k4 + 1][0], s[2 * k4 + 1][1]); pp.w = pk2(s[2 * k4 + 1][2], s[2 * k4 + 1][3]);
                    const bf16x8 pf = __builtin_bit_cast(bf16x8, pp);
#pragma unroll
                    for (int dt = 0; dt < 4; ++dt) o[dt][qt] = mfma16(frag_tr_split(Vt, 72, 64 * hf + 32 * k4, 16 * dt, li, gq), pf, o[dt][qt]);
                }
            }
        }
    }
#pragma unroll
    for (int qt = 0; qt < 3; ++qt) {
        float lt = lsum[qt]; lt += __shfl_xor(lt, 16); lt += __shfl_xor(lt, 32);
        const float inv = 1.f / lt;
        const int R = 48 * w + 16 * qt;
        bf16_t* op = MIX + (size_t)(qrow_base + (R & 127) + li) * D + 256 + (kvh * 3 + (R >> 7)) * 64 + 4 * gq;
#pragma unroll
#if defined(DBG_ZERO_A)
        for (int dt = 0; dt < 4; ++dt) *(u32x2*)(op + 16 * dt) = pack4(o[dt][qt] * 0.f);
#else
        for (int dt = 0; dt < 4; ++dt) *(u32x2*)(op + 16 * dt) = pack4(o[dt][qt] * inv);
#endif
    }
}

#if defined(DBG_ZERO_F)
constexpr float FSCALE512 = 0.f, FSCALE128 = 0.f;
#else
constexpr float FSCALE512 = 1.f / 512.f, FSCALE128 = 1.f / 128.f;
#endif
constexpr int FO_CST = 0, FO_M2 = 18432, FO_Z = 53248, FO_CSB = 90112, FO_FST = 107520, FO_Z2 = 53248, FO_TAB = 126976;
__device__ __forceinline__ void fourier_consts_a(const Frame& F) {
    LAS bf16_t* CSt = (LAS bf16_t*)(F.lds + FO_CST); LAS bf16_t* M2 = (LAS bf16_t*)(F.lds + FO_M2);
    __syncthreads();
    for (int i = F.tid; i < 128 * 64; i += NTHR) { const int cp = i >> 6, c = i & 63; const int ph = (c * (cp & 63)) & 63; const float v = cp < 64 ? cospif(ph / 32.f) : sinpif(ph / 32.f);
        CSt[cp * 72 + c] = (bf16_t)(pk2(v, 0.f) & 0xffff); }
    for (int i = F.tid; i < 128 * 128; i += NTHR) { const int kp = i >> 7, kk = i & 127; const int ph = ((kp & 63) * (kk & 63)) & 63; const float cs = cospif(ph / 32.f), sn = sinpif(ph / 32.f);
        const float v = kp < 64 ? (kk < 64 ? cs : -sn) : (kk < 64 ? -sn : -cs);
        M2[kp * 136 + kk] = (bf16_t)(pk2(v, 0.f) & 0xffff); }
    __syncthreads();
}
__device__ __forceinline__ void fourier_consts_b(const Frame& F) {
    LAS bf16_t* CSb = (LAS bf16_t*)(F.lds + FO_CSB);
    __syncthreads();
    for (int i = F.tid; i < 64 * 128; i += NTHR) { const int k2 = i >> 7, kk = i & 127; const int ph = (k2 * (kk & 63)) & 63; const float v = kk < 64 ? cospif(ph / 32.f) : sinpif(ph / 32.f);
        CSb[k2 * 136 + kk] = (bf16_t)(pk2(v, 0.f) & 0xffff); }
    __syncthreads();
}
__device__ __forceinline__ void fa_unit(const Frame& F, int b, int g, int pr) {
    LAS bf16_t* CSt = (LAS bf16_t*)(F.lds + FO_CST); LAS bf16_t* M2 = (LAS bf16_t*)(F.lds + FO_M2);
    const bf16_t* Pp = (const bf16_t*)(F.ws + WS_BUFB); bf16_t* FA = (bf16_t*)(F.ws + WS_BUFC + BC_FA);
    const int li = F.lane & 15, gq = F.lane >> 4, w = F.wave;
    __syncthreads();
#pragma unroll
    for (int u2 = 0; u2 < 2; ++u2) {
        LAS bf16_t* Z = (LAS bf16_t*)(F.lds + FO_Z + u2 * 18432);
        const int n2 = 2 * pr + u2, n1 = 16 * (w & 3) + li;
        const bf16_t* up = Pp + (size_t)(b * SEQ + 64 * n1 + n2) * PW + PF + g * 64;
        bf16x8 uf[2];
#pragma unroll
        for (int ks = 0; ks < 2; ++ks) uf[ks] = *(const bf16x8*)(up + 32 * ks + 8 * gq);
#pragma unroll
        for (int ctl = 0; ctl < 4; ++ctl) { const int ct = 4 * (w >> 2) + ctl; f32x4 acc = (f32x4){0.f, 0.f, 0.f, 0.f};
#pragma unroll
            for (int ks = 0; ks < 2; ++ks) acc = mfma16(frag_lds(CSt, 72, 16 * ct, 32 * ks, li, gq), uf[ks], acc);
            const int cp = 16 * ct + 4 * gq;
            *(LAS u32x2*)(Z + ((cp < 64 ? 0 : 64) + n1) * 72 + (cp & 63)) = pack4(acc); }
    }
    __syncthreads();
#pragma unroll
    for (int u2 = 0; u2 < 2; ++u2) {
        LAS bf16_t* Z = (LAS bf16_t*)(F.lds + FO_Z + u2 * 18432);
        const int n2 = 2 * pr + u2, kt = w & 3, k1 = 16 * kt + li;
        const int ph = (n2 * k1) & 4095; const float cs = cospif(ph / 2048.f), sn = sinpif(ph / 2048.f);
#pragma unroll
        for (int ctl = 0; ctl < 2; ++ctl) { const int ct = 2 * (w >> 2) + ctl; f32x4 ar = (f32x4){0.f, 0.f, 0.f, 0.f}, ai = ar;
#pragma unroll
            for (int ks = 0; ks < 4; ++ks) { const bf16x8 zf = frag_tr(Z, 72, 32 * ks, 16 * ct, li, gq);
                ar = mfma16(zf, frag_lds(M2, 136, 16 * kt, 32 * ks, li, gq), ar);
                ai = mfma16(zf, frag_lds(M2, 136, 64 + 16 * kt, 32 * ks, li, gq), ai); }
            const f32x4 tr = ar * cs + ai * sn, tim = ai * cs - ar * sn;
            bf16_t* dst = FA + ((((size_t)(b * 4 + g) * 64 + k1) * 64 + n2) * 128) + 16 * ct + 4 * gq;
            *(u32x2*)dst = pack4(tr); *(u32x2*)(dst + 64) = pack4(tim); }
    }
}
__device__ __forceinline__ void fb_unit(const Frame& F, int b, int g, int k1) {
    LAS bf16_t* CSb = (LAS bf16_t*)(F.lds + FO_CSB); LAS bf16_t* Fst = (LAS bf16_t*)(F.lds + FO_FST);
    const bf16_t* FA = (const bf16_t*)(F.ws + WS_BUFC + BC_FA) + (((size_t)(b * 4 + g) * 64 + k1) * 64) * 128;
    bf16_t* MIX = (bf16_t*)(F.ws + WS_BUFA);
    const int li = F.lane & 15, gq = F.lane >> 4, w = F.wave;
    __syncthreads();
#pragma unroll
    for (int q = 0; q < 2; ++q) { const int idx = F.tid + 512 * q, n2 = idx >> 4, ri = (idx >> 3) & 1, cc = idx & 7;
        *(LAS u32x4*)(Fst + (ri * 64 + n2) * 72 + 8 * cc) = *(const u32x4*)(FA + (size_t)idx * 8); }
    __syncthreads();
    const int k2 = 16 * (w & 3) + li;
#pragma unroll
    for (int ctl = 0; ctl < 2; ++ctl) { const int ct = 2 * (w >> 2) + ctl; f32x4 acc = (f32x4){0.f, 0.f, 0.f, 0.f};
#pragma unroll
        for (int ks = 0; ks < 4; ++ks) acc = mfma16(frag_tr(Fst, 72, 32 * ks, 16 * ct, li, gq), frag_lds(CSb, 136, 16 * (w & 3), 32 * ks, li, gq), acc);
        *(u32x2*)(MIX + (size_t)(b * SEQ + 64 * k2 + k1) * D + g * 64 + 16 * ct + 4 * gq) = pack4(acc * FSCALE512); }
}
__device__ __forceinline__ void fctx_unit(const Frame& F, int b, int g) {
    LAS bf16_t* CSt = (LAS bf16_t*)(F.lds + FO_CST); LAS bf16_t* Z2 = (LAS bf16_t*)(F.lds + FO_Z2);
    LAS bf16_t* TAB = (LAS bf16_t*)(F.lds + FO_TAB);
    const bf16_t* Pp = (const bf16_t*)(F.ws + WS_BUFB); bf16_t* MIX = (bf16_t*)(F.ws + WS_BUFA);
    const int li = F.lane & 15, gq = F.lane >> 4, w = F.wave;
    __syncthreads();
    if (F.tid < 256) { TAB[F.tid] = (bf16_t)(pk2(cospif(F.tid / 128.f), 0.f) & 0xffff); TAB[256 + F.tid] = (bf16_t)(pk2(-sinpif(F.tid / 128.f), 0.f) & 0xffff); }
    {
        bf16x8 cfr[2];
#pragma unroll
        for (int ks = 0; ks < 2; ++ks) cfr[ks] = frag_lds(CSt, 72, 16 * w, 32 * ks, li, gq);
#pragma unroll 4
        for (int nt = 0; nt < 16; ++nt) { const int n = 16 * nt + li; const bf16_t* up = Pp + (size_t)(NLAT + b * CTX + n) * PW + PF + g * 64;
            f32x4 acc = (f32x4){0.f, 0.f, 0.f, 0.f};
#pragma unroll
            for (int ks = 0; ks < 2; ++ks) acc = mfma16(cfr[ks], *(const bf16x8*)(up + 32 * ks + 8 * gq), acc);
            const int cp = 16 * w + 4 * gq;
            *(LAS u32x2*)(Z2 + ((cp < 64 ? 0 : 256) + n) * 72 + (cp & 63)) = pack4(acc); }
    }
    __syncthreads();
    f32x4 acc[2][4];
#pragma unroll
    for (int a = 0; a < 2; ++a)
#pragma unroll
        for (int ct = 0; ct < 4; ++ct) acc[a][ct] = (f32x4){0.f, 0.f, 0.f, 0.f};
#pragma unroll 1
    for (int ks = 0; ks < 16; ++ks) {
        bf16x8 zf[4];
#pragma unroll
        for (int ct = 0; ct < 4; ++ct) zf[ct] = frag_tr(Z2, 72, 32 * ks, 16 * ct, li, gq);
#pragma unroll
        for (int a = 0; a < 2; ++a) { const int k = 16 * (2 * w + a) + li; bf16x8 df;
#pragma unroll
            for (int j = 0; j < 8; ++j) { const int kk = 32 * ks + 8 * gq + j; df[j] = (short)TAB[(kk < 256 ? 0 : 256) + ((k * (kk & 255)) & 255)]; }
#pragma unroll
            for (int ct = 0; ct < 4; ++ct) acc[a][ct] = mfma16(zf[ct], df, acc[a][ct]); }
    }
#pragma unroll
    for (int a = 0; a < 2; ++a) { const int k = 16 * (2 * w + a) + li;
#pragma unroll
        for (int ct = 0; ct < 4; ++ct) *(u32x2*)(MIX + (size_t)(NLAT + b * CTX + k) * D + g * 64 + 16 * ct + 4 * gq) = pack4(acc[a][ct] * FSCALE128); }
}
__global__ void __launch_bounds__(NTHR, 2) hybrid_fwd(Params P) {
    extern __shared__ __attribute__((aligned(16))) unsigned char lds_raw[];
    Frame F;
    F.lds = (LAS unsigned char*)lds_raw;
    F.tid = threadIdx.x; F.lane = F.tid & 63; F.wave = __builtin_amdgcn_readfirstlane(F.tid >> 6);
    F.G = gridDim.x; F.bid = blockIdx.x;
    F.out = P.out; F.ws = P.ws;
    volatile LAS unsigned* MISC = (volatile LAS unsigned*)(F.lds + MISC_OFF);
    if (F.tid < 16) MISC[F.tid] = 0u;
    __syncthreads();
    XcdBarrier bar = xcd_barrier_post((unsigned*)(F.ws + WS_CTL), MISC);
#define PHASE_FENCE() do { asm volatile("" : "+v"(F.tid)); F.lane = F.tid & 63; F.wave = __builtin_amdgcn_readfirstlane(F.tid >> 6); \
        asm volatile("" : "+s"(F.ws), "+s"(F.out), "+s"(F.bid), "+s"(F.G)); } while (0)
#define GRID_BAR() do { xcd_barrier(bar); PHASE_FENCE(); } while (0)

    p0_prologue(F);
    GRID_BAR();
    e1_phase(F);
    GRID_BAR();

#pragma unroll 1
    for (int l = 0; l < 2; ++l) {
        const bool first = (l == 0);
        PHASE_FENCE();
        {
            pg8::DenseProb pb{(const bf16_t*)(F.ws + WS_BUFA), (const bf16_t*)(F.ws + WS_WIN) + (size_t)l * PW * D, nullptr, D};
            pg8::GridOrder S; S.init(NT / 256, PW / 256, F.G, F.bid);
            pg8::EpiBf16 E{(bf16_t*)(F.ws + WS_BUFB), PW};
            pg8::gemm_phase(F.lds, F.tid, pb, S, E);
        }
        GRID_BAR();
        {
            const int nAttL = NB * 32 * 2, nAttC = first ? NB * 2 * 2 : 0, nS1 = NB * NCH * 2, nFA = NB * 4 * 32;
            const int total = nAttL + nAttC + nS1 + nFA;
            bool fa_ready = false;
            for (int u = F.bid; u < total; u += F.G) {
                PHASE_FENCE();
                int v = u;
                if (v < nAttL) { const int b = v >> 6, nb = (v >> 1) & 31, kvh = v & 1; attn_unit(F, l, b, nb, kvh, false); continue; } v -= nAttL;
                if (v < nAttC) { const int b = v >> 2, nb = (v >> 1) & 1, kvh = v & 1; attn_unit(F, l, b, nb, kvh, true); continue; } v -= nAttC;
                if (v < nS1) { const int g = v & 1, c = (v >> 1) % NCH, b = (v >> 1) / NCH; s1_unit(F, l, b, c, g); continue; } v -= nS1;
                if (!fa_ready) { fourier_consts_a(F); fa_ready = true; }
                { const int pr = v & 31, g = (v >> 5) & 3, b = v >> 7; fa_unit(F, b, g, pr); }
            }
        }
        GRID_BAR();
        s2_phase(F);
        GRID_BAR();
        {
            const int c0 = first ? 0 : 2;
            const int nS3 = NB * (NCH - c0), nFC = first ? NB * 4 : 0, nFB = NB * 4 * 64;
            const int total = nS3 + nFC + nFB;
            bool fa_ready = false, fb_ready = false;
            for (int u = F.bid; u < total; u += F.G) {
                PHASE_FENCE();
                int v = u;
                if (v < nS3) { const int c = c0 + v % (NCH - c0), b = v / (NCH - c0); s3_unit(F, l, b, c); continue; } v -= nS3;
                if (v < nFC) { if (!fa_ready) { fourier_consts_a(F); fa_ready = true; } fctx_unit(F, v >> 2, v & 3); fb_ready = false; continue; } v -= nFC;
                if (!fb_ready) { fourier_consts_b(F); fb_ready = true; }
                { const int k1 = v & 63, g = (v >> 6) & 3, b = v >> 8; fb_unit(F, b, g, k1); }
            }
            __syncthreads();
        }
        GRID_BAR();
        {
            const int rows = first ? NT : NLAT;
            pg8::DenseProb pb{(const bf16_t*)(F.ws + WS_BUFA), (const bf16_t*)(F.ws + WS_WOUT) + (size_t)l * D * D, nullptr, D};
            pg8::GridOrder S; S.init(rows / 256, D / 256, F.G, F.bid);
            pg8::EpiBf16 E{(bf16_t*)(F.ws + WS_BUFB), D};
            pg8::gemm_phase(F.lds, F.tid, pb, S, E);
        }
        GRID_BAR();
        e3_phase(F, l);
        GRID_BAR();
#if defined(DBG_STOP)
        if (DBG_STOP == 1 + 2 * l) return;
#endif
        topk_phase(F, l);
        GRID_BAR();
#pragma unroll 1
        for (int grp = 0; grp < 2; ++grp) {
            pg8::MoeMap mp{8, grp * 8};
            const int nMv = first ? 8 * 34 : 8 * 32;
            {
                pg8::GuProb pb{(const bf16_t*)(F.ws + WS_BUFA), (const bf16_t*)(F.ws + WS_WGU), (const int*)(F.ws + WS_ROWIDX), D, mp};
                pg8::GridOrder S; S.init(nMv, 2 * FF / 256, F.G, F.bid);
                pg8::EpiGU E{(bf16_t*)(F.ws + WS_BUFB), mp};
                pg8::gemm_phase(F.lds, F.tid, pb, S, E);
            }
            GRID_BAR();
            {
                pg8::DownProb pb{(const bf16_t*)(F.ws + WS_BUFB), (const bf16_t*)(F.ws + WS_WD), nullptr, FF, mp};
                pg8::GridOrder S; S.init(nMv, D / 256, F.G, F.bid);
                pg8::EpiDown E{(bf16_t*)(F.ws + WS_BUFC), (const float*)(F.ws + WS_GATE), mp};
                pg8::gemm_phase(F.lds, F.tid, pb, S, E);
            }
            GRID_BAR();
        }
        e5_phase(F, l);
        if (first) { __syncthreads(); convert_experts(F, 1); }
        GRID_BAR();
#if defined(DBG_STOP)
        if (DBG_STOP == 2 + 2 * l) return;
#endif
    }
}

extern "C" void kernel_launch(void* const* d_in, const int* in_sizes, int n_in, void* d_out, int out_size, void* d_ws, size_t ws_size, hipStream_t stream) {
    static int grid = 0;
    if (grid == 0) {
        if (n_in != 23 || out_size != NLAT * D || ws_size < WS_END) { fprintf(stderr, "kernel_launch: unexpected problem (n_in %d out %d ws %zu need %zu)\n", n_in, out_size, ws_size, (size_t)WS_END); grid = -1; return; }
        int dev = 0, cus = 0, per_cu = 0;
        if (hipGetDevice(&dev) != hipSuccess || hipDeviceGetAttribute(&cus, hipDeviceAttributeMultiprocessorCount, dev) != hipSuccess) { grid = -1; return; }
        if (hipFuncSetAttribute((const void*)hybrid_fwd, hipFuncAttributeMaxDynamicSharedMemorySize, LDS_BYTES) != hipSuccess) { fprintf(stderr, "kernel_launch: hipFuncSetAttribute failed\n"); grid = -1; return; }
        if (hipOccupancyMaxActiveBlocksPerMultiprocessor(&per_cu, (const void*)hybrid_fwd, NTHR, LDS_BYTES) != hipSuccess || per_cu < 1) { fprintf(stderr, "kernel_launch: occupancy query says %d\n", per_cu); (void)hipGetLastError(); grid = -1; return; }
        grid = cus;
    }
    if (grid < 0) return;
    (void)in_sizes;
    hipMemsetAsync((char*)d_ws + WS_CTL, 0, 65536, stream);
    Params p{};
    for (int i = 0; i < 23; ++i) p.in[i] = (const float*)d_in[i];
    p.out = (float*)d_out; p.ws = (unsigned char*)d_ws;
    hipLaunchKernelGGL(hybrid_fwd, dim3(grid), dim3(NTHR), LDS_BYTES, stream, p);
}
```

```cpp
#include <hip/hip_runtime.h>
#include <cstdio>
#include <cstdint>

#define LAS __attribute__((address_space(3)))
typedef unsigned short bf16_t;
typedef short bf16x8 __attribute__((ext_vector_type(8)));
typedef short bf16x4 __attribute__((ext_vector_type(4)));
typedef float f32x4 __attribute__((ext_vector_type(4)));
typedef float f32x2 __attribute__((ext_vector_type(2)));
typedef unsigned u32x4 __attribute__((ext_vector_type(4)));
typedef unsigned u32x2 __attribute__((ext_vector_type(2)));
typedef __bf16 bf16v2_t __attribute__((ext_vector_type(2)));

constexpr int D = 1024, NB = 16, SEQ = 4096, CTX = 256, NLAT = NB * SEQ, NCTX = NB * CTX, NT = NLAT + NCTX;
constexpr int PW = 2304;
constexpr int PF = 0, PQ = 256, PK = 640, PV = 768, PZ = 896, PX = 1280, PDT = 2176, INW = 2188;
constexpr int FF = 2816, NE = 16, EROWS = 8704;
constexpr int NCH = 34;
constexpr float EPS = 1e-6f;
constexpr int NWAVES = 8, NTHR = 512;

constexpr size_t al4k(size_t x) { return (x + 4095) & ~(size_t)4095; }
constexpr size_t WS_CTL = 0;
constexpr size_t WS_MOD = al4k(WS_CTL + 65536);
constexpr size_t WS_ROPE = al4k(WS_MOD + (size_t)2 * 17 * 6144 * 4);
constexpr size_t WS_HCTX = al4k(WS_ROPE + 64 * 16 * 2 * 4);
constexpr size_t WS_WIN = al4k(WS_HCTX + (size_t)NCTX * D * 4);
constexpr size_t WS_WOUT = al4k(WS_WIN + (size_t)2 * PW * D * 2);
constexpr size_t WS_WGU = al4k(WS_WOUT + (size_t)2 * D * D * 2);
constexpr size_t WS_WD = al4k(WS_WGU + (size_t)NE * 2 * FF * D * 2);
constexpr size_t WS_AFF = al4k(WS_WD + (size_t)NE * D * FF * 2);
constexpr size_t WS_ROWIDX = al4k(WS_AFF + (size_t)NT * 16 * 4);
constexpr size_t WS_GATE = al4k(WS_ROWIDX + (size_t)NE * EROWS * 4);
constexpr size_t WS_SLOT = al4k(WS_GATE + (size_t)NE * EROWS * 4);
constexpr size_t WS_DECAY = al4k(WS_SLOT + (size_t)NT * 16 * 2);
constexpr size_t WS_BUFA = al4k(WS_DECAY + (size_t)NB * NCH * 12 * 4);
constexpr size_t WS_BUFB = al4k(WS_BUFA + (size_t)NT * D * 2);
constexpr size_t WS_BUFC = al4k(WS_BUFB + (size_t)8 * EROWS * FF * 2);
constexpr size_t BC_XC = 0;
constexpr size_t BC_ST = al4k(BC_XC + (size_t)NT * 896 * 2);
constexpr size_t BC_FA = al4k(BC_ST + (size_t)NB * NCH * 12 * 8192 * 2);
constexpr size_t BC_END = al4k(BC_FA + (size_t)NB * 4 * 64 * 64 * 128 * 2);
static_assert(BC_END >= (size_t)NE * EROWS * D * 2, "y must fit the mixer-temporary region");
constexpr size_t WS_END = WS_BUFC + BC_END;

constexpr int LDS_BYTES = 155648;
constexpr int MISC_OFF = 151552;

struct Params { const float* in[23]; float* out; unsigned char* ws; };

__device__ __forceinline__ float bf2f(bf16_t v) { return __uint_as_float((unsigned)v << 16); }
__device__ __forceinline__ unsigned pk2(float lo, float hi) { f32x2 v = {lo, hi}; bf16v2_t b = __builtin_convertvector(v, bf16v2_t); return __builtin_bit_cast(unsigned, b); }
__device__ __forceinline__ float lo2f(unsigned w) { return __uint_as_float(w << 16); }
__device__ __forceinline__ float hi2f(unsigned w) { return __uint_as_float(w & 0xffff0000u); }
__device__ __forceinline__ float wave_sum(float v) {
#pragma unroll
    for (int o = 1; o < 64; o <<= 1) v += __shfl_xor(v, o);
    return v;
}
__device__ __forceinline__ float siluf(float x) { return x / (1.f + __expf(-x)); }
__device__ __forceinline__ float softplusf(float x) { return fmaxf(x, 0.f) + log1pf(__expf(-fabsf(x))); }
__device__ __forceinline__ f32x4 mfma16(bf16x8 a, bf16x8 b, f32x4 c) { return __builtin_amdgcn_mfma_f32_16x16x32_bf16(a, b, c, 0, 0, 0); }
__device__ __forceinline__ bf16x8 frag_lds(const LAS bf16_t* base, int stride, int r0, int k0, int li, int gq) {
    return *(const LAS bf16x8*)(base + (r0 + li) * stride + k0 + 8 * gq);
}
__device__ __forceinline__ bf16x8 frag_glb(const bf16_t* base, size_t stride, int r0, int k0, int li, int gq) {
    return *(const bf16x8*)(base + (size_t)(r0 + li) * stride + k0 + 8 * gq);
}
__device__ __forceinline__ bf16x8 frag_tr(const LAS bf16_t* S, int stride, int k0, int n0, int li, int gq) {
    const LAS bf16_t* p = S + (k0 + 8 * gq + (li >> 2)) * stride + n0 + 4 * (li & 3);
    bf16x4 a = __builtin_amdgcn_ds_read_tr16_b64_v4i16((LAS bf16x4*)p);
    bf16x4 b = __builtin_amdgcn_ds_read_tr16_b64_v4i16((LAS bf16x4*)(p + 4 * stride));
    return (bf16x8){a[0], a[1], a[2], a[3], b[0], b[1], b[2], b[3]};
}
__device__ __forceinline__ bf16x8 frag_tr_split(const LAS bf16_t* S, int stride, int k0, int n0, int li, int gq) {
    const LAS bf16_t* p = S + (k0 + 4 * gq + (li >> 2)) * stride + n0 + 4 * (li & 3);
    bf16x4 a = __builtin_amdgcn_ds_read_tr16_b64_v4i16((LAS bf16x4*)p);
    bf16x4 b = __builtin_amdgcn_ds_read_tr16_b64_v4i16((LAS bf16x4*)(p + 16 * stride));
    return (bf16x8){a[0], a[1], a[2], a[3], b[0], b[1], b[2], b[3]};
}
__device__ __forceinline__ u32x2 pack4(f32x4 v) { u32x2 r; r.x = pk2(v[0], v[1]); r.y = pk2(v[2], v[3]); return r; }
#define LDS_FENCE() asm volatile("s_waitcnt lgkmcnt(0)" ::: "memory")

#define XB_TMO      128
#define XB_XCNT(j)  (256  + 64 * (j))
#define XB_XSUB(j)  (1280 + 64 * (j))
#define XB_XGEN(j)  (2304 + 64 * (j))
#define XB_TOP      3328
#define XB_TOPGEN   3392
#define XCD_BAR_WORDS 3456
#define XB_SPIN_CAP (1u << 22)
__device__ __forceinline__ unsigned xb_ld(unsigned* p)              { return __hip_atomic_load(p, __ATOMIC_RELAXED, __HIP_MEMORY_SCOPE_AGENT); }
__device__ __forceinline__ unsigned xb_add(unsigned* p, unsigned v) { return __hip_atomic_fetch_add(p, v, __ATOMIC_RELAXED, __HIP_MEMORY_SCOPE_AGENT); }
__device__ __forceinline__ unsigned xb_xcc_id() { return (unsigned)__builtin_amdgcn_s_getreg((3 << 11) | 20) & 0xFu; }
#define XB_SPIN(cond, bar) do { unsigned _sp = 0; while (cond) { __builtin_amdgcn_s_sleep(1); \
    if ((++_sp & 255u) == 0u) { if (xb_ld(&(bar)[XB_TMO])) break; if (_sp > XB_SPIN_CAP) { atomicAdd(&(bar)[XB_TMO], 1u); break; } } } } while (0)
struct XcdBarrier { unsigned* bar; unsigned x; volatile LAS unsigned* st; };
__device__ __forceinline__ XcdBarrier xcd_barrier_post(unsigned* bar, volatile LAS unsigned* st) {
    XcdBarrier b; b.bar = bar; b.x = xb_xcc_id(); b.st = st;
    if (threadIdx.x == 0) (void)xb_add(&bar[XB_XCNT(b.x)], 1u);
    return b;
}
__device__ __forceinline__ void xcd_barrier_complete(unsigned* bar, unsigned x, unsigned& nloc, unsigned& nx) {
    const unsigned G = gridDim.x * gridDim.y * gridDim.z;
    unsigned sum, cnt, mine, sp = 0u;
    for (;;) {
        sum = 0u; cnt = 0u; mine = 0u;
#pragma unroll
        for (unsigned j = 0; j < 16; ++j) { const unsigned c = xb_ld(&bar[XB_XCNT(j)]); sum += c; cnt += (c > 0u) ? 1u : 0u; mine = (j == x) ? c : mine; }
        if (sum == G) break;
        __builtin_amdgcn_s_sleep(1);
        if ((++sp & 255u) == 0u) { if (xb_ld(&bar[XB_TMO])) break; if (sp > XB_SPIN_CAP) { atomicAdd(&bar[XB_TMO], 1u); break; } }
    }
    nloc = mine > 0u ? mine : 1u; nx = cnt > 0u ? cnt : 1u;
}
__device__ __forceinline__ void xcd_barrier(const XcdBarrier& b) {
    asm volatile("s_waitcnt vmcnt(0)" ::: "memory");
    __syncthreads();
    if (threadIdx.x == 0) {
        unsigned* bar = b.bar;
        __builtin_amdgcn_s_waitcnt(0);
        unsigned nloc = b.st[0], nx = b.st[1];
        if (nloc == 0u) { xcd_barrier_complete(bar, b.x, nloc, nx); b.st[0] = nloc; b.st[1] = nx; }
        const unsigned old = xb_add(&bar[XB_XSUB(b.x)], 1u);
        const unsigned gen = old / nloc;
        if (old + 1u == (gen + 1u) * nloc) {
            __builtin_amdgcn_fence(__ATOMIC_RELEASE, "agent");
            asm volatile("s_waitcnt vmcnt(0)" ::: "memory");
            const unsigned og = xb_add(&bar[XB_TOP], 1u);
            const unsigned tg = og / nx;
            if (og + 1u == (tg + 1u) * nx) xb_add(&bar[XB_TOPGEN], 1u);
            else XB_SPIN(xb_ld(&bar[XB_TOPGEN]) == tg, bar);
            __builtin_amdgcn_fence(__ATOMIC_ACQUIRE, "agent");
            xb_add(&bar[XB_XGEN(b.x)], 1u);
            asm volatile("s_waitcnt vmcnt(0)" ::: "memory");
        } else {
            XB_SPIN(xb_ld(&bar[XB_XGEN(b.x)]) == gen, bar);
            __builtin_amdgcn_fence(__ATOMIC_ACQUIRE, "agent");
            asm volatile("s_waitcnt vmcnt(0)" ::: "memory");
        }
    }
    __syncthreads();
}
namespace pg8 {
constexpr int BM = 256, BK = 64, HALF = 128, HTB = HALF * BK * 2, STAGE_BYTES = 8 * HTB, NXCD = 8, WGM = 8;
__host__ __device__ __forceinline__ int lds_byte(int r, int c) { const int st = (r >> 4) * 2 + (c >> 5), rr = r & 15, cc = c & 31, ob = rr * 64 + cc * 2; return st * 1024 + (ob ^ (((ob >> 9) & 1) << 5)); }
__host__ __device__ __forceinline__ void stage_rc(int b, int& R, int& C) { const int st = b / 1024, sb = b % 1024, swz = sb ^ (((sb >> 9) & 1) << 5); R = (st >> 1) * 16 + swz / 64; C = (st & 1) * 32 + (swz % 64) / 2; }
__host__ __device__ __forceinline__ int perm32(int rho) { const int n = rho >> 4, i = rho & 15; return 8 * (i >> 2) + 4 * n + (i & 3); }

struct Unit { int pm, pn; };
struct GridOrder {
    int nM, nN, nwg, G, c;
    __device__ __forceinline__ void init(int nM_, int nN_, int G_, int c_) { nM = nM_; nN = nN_; nwg = nM * nN; G = G_; c = c_; }
    __device__ __forceinline__ bool next(int i, Unit& u) const {
        const long L = (long)i * G + c; if (L >= nwg) return false;
        int wgid = (int)L; { const int q = nwg / NXCD, r = nwg % NXCD, xcd = wgid % NXCD, off = wgid / NXCD; wgid = (xcd < r ? xcd * (q + 1) : r * (q + 1) + (xcd - r) * q) + off; }
        const int nig = WGM * nN, gid = wgid / nig, fm = gid * WGM, gsz = (nM - fm) < WGM ? (nM - fm) : WGM;
        u.pm = fm + ((wgid % nig) % gsz); u.pn = (wgid % nig) / gsz; return true;
    }
};

template <class Prob, class Epi>
__device__ __forceinline__ void gemm_phase(LAS unsigned char* lds, const int tid, const Prob& Pb, const GridOrder& S, const Epi& E) {
    const int wid = __builtin_amdgcn_readfirstlane(tid >> 6), lane = tid & 63, wr = wid >> 2, wc = wid & 3, fr = lane & 15, fq = lane >> 4;
    const int K = Pb.K, nt = K / BK;
    int Rr[2], Cc[2];
    unsigned voffB[2];
#pragma unroll
    for (int i = 0; i < 2; ++i) { int R, C; stage_rc(tid * 16 + i * 8192, R, C); Rr[i] = R; Cc[i] = C; const int Rb = Epi::PERM ? ((R & ~31) + perm32(R & 31)) : R;
        voffB[i] = (unsigned)(Rb * K + C) * 2u; }
    const size_t kstep = (size_t)(BK * 2);
    const size_t hstep = (size_t)HALF * K * 2;
    const unsigned ldsw = (unsigned)wid * 1024u;
    const int aoff = lds_byte(wr * 64 + fr, fq * 8), boff = lds_byte(wc * 32 + fr, fq * 8);
#define PG8_SA(b, h) (((b) * 2 + (h)) * HTB)
#define PG8_SB(b, h) ((4 + (b) * 2 + (h)) * HTB)
#define PG8_STAGE(bufoff, gbase, voff) do { _Pragma("unroll") for (int _i = 0; _i < 2; ++_i) \
        __builtin_amdgcn_global_load_lds((const unsigned*)((const char*)(gbase) + (voff)[_i]), (LAS unsigned*)(lds + (bufoff) + ldsw + _i * 8192), 16, 0, 0); } while (0)
#define PG8_LDA(dst, b, h) do { _Pragma("unroll") for (int m = 0; m < 4; ++m) _Pragma("unroll") for (int k = 0; k < 2; ++k) dst[m][k] = *(const LAS bf16x8*)(lds + PG8_SA(b, h) + aoff + m * 2048 + k * 1024); } while (0)
#define PG8_LDB(dst, b, h) do { _Pragma("unroll") for (int n = 0; n < 2; ++n) _Pragma("unroll") for (int k = 0; k < 2; ++k) dst[n][k] = *(const LAS bf16x8*)(lds + PG8_SB(b, h) + boff + n * 2048 + k * 1024); } while (0)
#define PG8_MMA(ai, bj, At, Bt) do { __builtin_amdgcn_s_setprio(1); _Pragma("unroll") for (int m = 0; m < 4; ++m) _Pragma("unroll") for (int n = 0; n < 2; ++n) _Pragma("unroll") for (int k = 0; k < 2; ++k) \
        acc[ai][bj][m][n] = __builtin_amdgcn_mfma_f32_16x16x32_bf16(Bt[n][k], At[m][k], acc[ai][bj][m][n], 0, 0, 0); __builtin_amdgcn_s_setprio(0); } while (0)
#define PG8_WAIT_V(n) asm volatile("s_waitcnt vmcnt(" #n ")" ::: "memory")
#define PG8_WAIT_L(n) asm volatile("s_waitcnt lgkmcnt(" #n ")" ::: "memory")
#define PG8_BAR __builtin_amdgcn_s_barrier()
#define PG8_SCHED __builtin_amdgcn_sched_barrier(0)
    Unit cur, nxt; int ui = 0;
    if (!S.next(0, cur)) return;
    f32x4 acc[2][2][4][2];
#pragma unroll
    for (int a = 0; a < 2; ++a)
#pragma unroll
        for (int b = 0; b < 2; ++b)
#pragma unroll
            for (int m = 0; m < 4; ++m)
#pragma unroll
                for (int n = 0; n < 2; ++n) acc[a][b][m][n] = (f32x4){0.f, 0.f, 0.f, 0.f};
    bf16x8 At[4][2], B0[2][2], B1[2][2];
    unsigned vA0[2], vA1[2], nA0[2], nA1[2];
#define PG8_AVOFF(u, d0, d1) do { const int _r0 = Pb.a_row0(u); _Pragma("unroll") for (int _i = 0; _i < 2; ++_i) { \
        if (Prob::GATHER) { const int _g0 = Pb.rowidx[_r0 + Rr[_i]], _g1 = Pb.rowidx[_r0 + HALF + Rr[_i]]; d0[_i] = (unsigned)(_g0 * K + Cc[_i]) * 2u; d1[_i] = (unsigned)(_g1 * K + Cc[_i]) * 2u; } \
        else { d0[_i] = (unsigned)((_r0 + Rr[_i]) * K + Cc[_i]) * 2u; d1[_i] = (unsigned)((_r0 + HALF + Rr[_i]) * K + Cc[_i]) * 2u; } } } while (0)
    PG8_AVOFF(cur, vA0, vA1);
    const char* const Ab = (const char*)Pb.Abase;
    const char* cB = (const char*)Pb.Btbase + (size_t)Pb.b_row0(cur) * K * 2;
    PG8_STAGE(PG8_SB(0, 0), cB, voffB); PG8_STAGE(PG8_SA(0, 0), Ab, vA0); PG8_STAGE(PG8_SB(0, 1), cB + hstep, voffB); PG8_STAGE(PG8_SA(0, 1), Ab, vA1);
    if (wr == 1) PG8_BAR;
    PG8_WAIT_V(4); PG8_BAR;
    PG8_STAGE(PG8_SB(1, 0), cB + kstep, voffB); PG8_STAGE(PG8_SA(1, 0), Ab + kstep, vA0); PG8_STAGE(PG8_SB(1, 1), cB + hstep + kstep, voffB);
    PG8_WAIT_V(6); PG8_BAR;
    for (;;) {
        const bool has_next = S.next(ui + 1, nxt);
        const char* nB = cB;
        if (has_next) { PG8_AVOFF(nxt, nA0, nA1); nB = (const char*)Pb.Btbase + (size_t)Pb.b_row0(nxt) * K * 2; }
        else { nA0[0] = vA0[0]; nA0[1] = vA0[1]; nA1[0] = vA1[0]; nA1[1] = vA1[1]; }
        for (int t = 0; t < nt; t += 2) {
            const bool last = (t == nt - 2);
            const char* a1 = Ab + (size_t)(t + 1) * kstep;
            const char* a2 = last ? Ab : Ab + (size_t)(t + 2) * kstep; const char* b2 = last ? nB : cB + (size_t)(t + 2) * kstep;
            const char* a3 = a2 + kstep; const char* b3 = b2 + kstep;
            unsigned w0[2], w1[2];
            w0[0] = last ? nA0[0] : vA0[0]; w0[1] = last ? nA0[1] : vA0[1]; w1[0] = last ? nA1[0] : vA1[0]; w1[1] = last ? nA1[1] : vA1[1];
            PG8_LDB(B0, 0, 0); PG8_SCHED; PG8_LDA(At, 0, 0); PG8_STAGE(PG8_SA(1, 1), a1, vA1);
            PG8_WAIT_L(8); PG8_BAR; PG8_WAIT_L(0); PG8_MMA(0, 0, At, B0); PG8_BAR; PG8_SCHED;
            PG8_LDB(B1, 0, 1); PG8_STAGE(PG8_SB(0, 0), b2, voffB);
            PG8_BAR; PG8_WAIT_L(0); PG8_MMA(0, 1, At, B1); PG8_BAR;
            PG8_LDA(At, 0, 1); PG8_STAGE(PG8_SA(0, 0), a2, w0);
            PG8_BAR; PG8_WAIT_L(0); PG8_MMA(1, 0, At, B0); PG8_BAR; PG8_SCHED;
            PG8_STAGE(PG8_SB(0, 1), b2 + hstep, voffB);
            PG8_WAIT_V(6); PG8_BAR; PG8_MMA(1, 1, At, B1); PG8_BAR;
            PG8_LDB(B0, 1, 0); PG8_SCHED; PG8_LDA(At, 1, 0); PG8_STAGE(PG8_SA(0, 1), a2, w1);
            PG8_WAIT_L(8); PG8_BAR; PG8_WAIT_L(0); PG8_MMA(0, 0, At, B0); PG8_BAR; PG8_SCHED;
            PG8_LDB(B1, 1, 1); PG8_STAGE(PG8_SB(1, 0), b3, voffB);
            PG8_BAR; PG8_WAIT_L(0); PG8_MMA(0, 1, At, B1); PG8_BAR;
            PG8_LDA(At, 1, 1); PG8_STAGE(PG8_SA(1, 0), a3, w0);
            PG8_BAR; PG8_WAIT_L(0); PG8_MMA(1, 0, At, B0); PG8_BAR; PG8_SCHED;
            PG8_STAGE(PG8_SB(1, 1), b3 + hstep, voffB);
            PG8_WAIT_V(6); PG8_BAR; PG8_MMA(1, 1, At, B1); PG8_BAR;
        }
        E(acc, cur, wr, wc, fr, fq);
        if (!has_next) break;
#pragma unroll
        for (int a = 0; a < 2; ++a)
#pragma unroll
            for (int b = 0; b < 2; ++b)
#pragma unroll
                for (int m = 0; m < 4; ++m)
#pragma unroll
                    for (int n = 0; n < 2; ++n) acc[a][b][m][n] = (f32x4){0.f, 0.f, 0.f, 0.f};
        cur = nxt; cB = nB; vA0[0] = nA0[0]; vA0[1] = nA0[1]; vA1[0] = nA1[0]; vA1[1] = nA1[1]; ++ui;
    }
    PG8_WAIT_V(0);
    if (wr == 0) PG8_BAR;
    PG8_BAR;
#undef PG8_SA
#undef PG8_SB
#undef PG8_STAGE
#undef PG8_LDA
#undef PG8_LDB
#undef PG8_MMA
#undef PG8_WAIT_V
#undef PG8_WAIT_L
#undef PG8_BAR
#undef PG8_SCHED
#undef PG8_AVOFF
}
__device__ __forceinline__ unsigned cvt_pk_bf16(float lo, float hi) { unsigned r; asm volatile("v_cvt_pk_bf16_f32 %0, %1, %2" : "=v"(r) : "v"(lo), "v"(hi)); return r; }

struct DenseProb {
    static constexpr bool GATHER = false;
    const bf16_t* Abase; const bf16_t* Btbase; const int* rowidx; int K;
    __device__ __forceinline__ int a_row0(const Unit& u) const { return u.pm * BM; }
    __device__ __forceinline__ int b_row0(const Unit& u) const { return u.pn * BM; }
};
struct EpiBf16 {
    static constexpr bool PERM = true;
    bf16_t* O; int ldc;
    __device__ __forceinline__ void operator()(const f32x4 (&acc)[2][2][4][2], const Unit& u, int wr, int wc, int fr, int fq) const {
        const int row0 = u.pm * BM + wr * 64 + fr, col0 = u.pn * BM + wc * 32 + 8 * fq;
#pragma unroll
        for (int ai = 0; ai < 2; ++ai)
#pragma unroll
            for (int m = 0; m < 4; ++m) { bf16_t* rowp = O + (size_t)(row0 + ai * HALF + m * 16) * ldc + col0;
#pragma unroll
                for (int bj = 0; bj < 2; ++bj) { const f32x4 v0 = acc[ai][bj][m][0], v1 = acc[ai][bj][m][1];
                    u32x4 w; w.x = cvt_pk_bf16(v0[0], v0[1]); w.y = cvt_pk_bf16(v0[2], v0[3]); w.z = cvt_pk_bf16(v1[0], v1[1]); w.w = cvt_pk_bf16(v1[2], v1[3]);
                    *(u32x4*)(rowp + bj * HALF) = w; } }
    }
};
struct MoeMap { int EG, e0;
    __device__ __forceinline__ void split(int pm, int& el, int& mt) const { if (pm < EG * 32) { el = pm >> 5; mt = pm & 31; } else { const int q = pm - EG * 32; el = q >> 1; mt = 32 + (q & 1); } }
};
struct GuProb {
    static constexpr bool GATHER = true;
    const bf16_t* Abase; const bf16_t* Btbase; const int* rowidx; int K; MoeMap mp;
    __device__ __forceinline__ int a_row0(const Unit& u) const { int el, mt; mp.split(u.pm, el, mt); return (mp.e0 + el) * EROWS + mt * BM; }
    __device__ __forceinline__ int b_row0(const Unit& u) const { int el, mt; mp.split(u.pm, el, mt); return (mp.e0 + el) * (2 * FF) + u.pn * BM; }
};
struct EpiGU {
    static constexpr bool PERM = true;
    bf16_t* he; MoeMap mp;
    __device__ __forceinline__ void operator()(const f32x4 (&acc)[2][2][4][2], const Unit& u, int wr, int wc, int fr, int fq) const {
        int el, mt; mp.split(u.pm, el, mt);
        const int row0 = el * EROWS + mt * BM + wr * 64 + fr, col0 = u.pn * HALF + wc * 32 + 8 * fq;
#pragma unroll
        for (int ai = 0; ai < 2; ++ai)
#pragma unroll
            for (int m = 0; m < 4; ++m) { bf16_t* rowp = he + (size_t)(row0 + ai * HALF + m * 16) * FF + col0;
                float o[8];
#pragma unroll
                for (int n = 0; n < 2; ++n)
#pragma unroll
                    for (int j = 0; j < 4; ++j) { const float g = acc[ai][0][m][n][j], up = acc[ai][1][m][n][j]; o[n * 4 + j] = g / (1.f + __expf(-g)) * up; }
                u32x4 w; w.x = cvt_pk_bf16(o[0], o[1]); w.y = cvt_pk_bf16(o[2], o[3]); w.z = cvt_pk_bf16(o[4], o[5]); w.w = cvt_pk_bf16(o[6], o[7]);
                *(u32x4*)rowp = w; }
    }
};
struct DownProb {
    static constexpr bool GATHER = false;
    const bf16_t* Abase; const bf16_t* Btbase; const int* rowidx; int K; MoeMap mp;
    __device__ __forceinline__ int a_row0(const Unit& u) const { int el, mt; mp.split(u.pm, el, mt); return el * EROWS + mt * BM; }
    __device__ __forceinline__ int b_row0(const Unit& u) const { int el, mt; mp.split(u.pm, el, mt); return (mp.e0 + el) * D + u.pn * BM; }
};
struct EpiDown {
    static constexpr bool PERM = true;
    bf16_t* y; const float* gate; MoeMap mp;
    __device__ __forceinline__ void operator()(const f32x4 (&acc)[2][2][4][2], const Unit& u, int wr, int wc, int fr, int fq) const {
        int el, mt; mp.split(u.pm, el, mt);
        const int row0 = (mp.e0 + el) * EROWS + mt * BM + wr * 64 + fr, col0 = u.pn * BM + wc * 32 + 8 * fq;
#pragma unroll
        for (int ai = 0; ai < 2; ++ai)
#pragma unroll
            for (int m = 0; m < 4; ++m) { const int row = row0 + ai * HALF + m * 16; const float g = gate[row]; bf16_t* rowp = y + (size_t)row * D + col0;
#pragma unroll
                for (int bj = 0; bj < 2; ++bj) { const f32x4 v0 = acc[ai][bj][m][0] * g, v1 = acc[ai][bj][m][1] * g;
                    u32x4 w; w.x = cvt_pk_bf16(v0[0], v0[1]); w.y = cvt_pk_bf16(v0[2], v0[3]); w.z = cvt_pk_bf16(v1[0], v1[1]); w.w = cvt_pk_bf16(v1[2], v1[3]);
                    *(u32x4*)(rowp + bj * HALF) = w; } }
    }
};
}
struct Frame {
    LAS unsigned char* lds;
    int tid, lane, wave, G, bid;
    float* out; unsigned char* ws;
};
__device__ __forceinline__ const float* INP(int i) {
    const __attribute__((address_space(4))) char* k = (const __attribute__((address_space(4))) char*)__builtin_amdgcn_kernarg_segment_ptr();
    asm volatile("" : "+s"(k));
    return *(const float* const __attribute__((address_space(4)))*)(k + 8 * i);
}
#define IN_X 0
#define IN_C 1
#define IN_CTX 2
#define IN_CCTX 3
#define IN_WADA 4
#define IN_BADA 5
#define IN_GMIXPRE 6
#define IN_GMIXPOST 7
#define IN_GFFNPRE 8
#define IN_GFFNPOST 9
#define IN_WIN 10
#define IN_CONVW 11
#define IN_CONVB 12
#define IN_DTBIAS 13
#define IN_ALOG 14
#define IN_DSKIP 15
#define IN_GSSD 16
#define IN_SINK 17
#define IN_WOUT 18
#define IN_WROUTER 19
#define IN_WGATE 20
#define IN_WUP 21
#define IN_WDOWN 22

__device__ __forceinline__ const float* mod_ptr(const Frame& F, int l, int row  , int part  ) {
    return (const float*)(F.ws + WS_MOD) + ((size_t)(l * 17 + row) * 6144 + part * 1024);
}
__device__ __forceinline__ int tok_modrow(int row) { return row < NLAT ? (row >> 12) : 16; }

template <class RowMap>
__device__ __forceinline__ void transpose_item(const float* W, int K, int N, bf16_t* WT, RowMap rm, LAS float* scr, int kb, int nb, int lane) {
    const int k0 = 64 * kb, n0 = 32 * nb;
    const int nn = n0 + (lane & 31);
#pragma unroll 8
    for (int i = 0; i < 32; ++i) { const int kk = 2 * i + (lane >> 5); scr[kk * 33 + (lane & 31)] = (nn < N) ? W[(size_t)(k0 + kk) * N + nn] : 0.f; }
    LDS_FENCE();
    const int c = lane & 7;
#pragma unroll
    for (int j = 0; j < 4; ++j) { const int n = (lane >> 3) + 8 * j; const LAS float* s = scr + (8 * c) * 33 + n;
        u32x4 o; o.x = pk2(s[0 * 33], s[1 * 33]); o.y = pk2(s[2 * 33], s[3 * 33]); o.z = pk2(s[4 * 33], s[5 * 33]); o.w = pk2(s[6 * 33], s[7 * 33]);
        *(u32x4*)(WT + (size_t)rm(n0 + n) * K + k0 + 8 * c) = o; }
    LDS_FENCE();
}
struct RmId { __device__ __forceinline__ int operator()(int n) const { return n; } };
struct RmGU { int s; __device__ __forceinline__ int operator()(int n) const { return 256 * (n >> 7) + 128 * s + (n & 127); } };

__device__ __forceinline__ void convert_experts(const Frame& F, int l) {
    LAS float* scr = (LAS float*)(F.lds + F.wave * 16384);
    const int gw = F.bid * NWAVES + F.wave, NGW = F.G * NWAVES;
    constexpr int I_G = 16 * 88, I_D = 44 * 32;
    constexpr int PER_E = 2 * I_G + I_D;
    bf16_t* Wgu = (bf16_t*)(F.ws + WS_WGU); bf16_t* Wd = (bf16_t*)(F.ws + WS_WD);
    for (int it = gw; it < NE * PER_E; it += NGW) {
        const int e = it / PER_E; int r = it % PER_E;
        if (r < I_G) { transpose_item(INP(IN_WGATE) + (size_t)(l * NE + e) * D * FF, D, FF, Wgu + (size_t)e * 2 * FF * D, RmGU{0}, scr, r / 88, r % 88, F.lane); continue; } r -= I_G;
        if (r < I_G) { transpose_item(INP(IN_WUP) + (size_t)(l * NE + e) * D * FF, D, FF, Wgu + (size_t)e * 2 * FF * D, RmGU{1}, scr, r / 88, r % 88, F.lane); continue; } r -= I_G;
        transpose_item(INP(IN_WDOWN) + (size_t)(l * NE + e) * FF * D, FF, D, Wd + (size_t)e * D * FF, RmId{}, scr, r / 32, r % 32, F.lane);
    }
}

__device__ __forceinline__ void p0_prologue(const Frame& F) {
    if (F.bid < 192) {
        LAS float* sc = (LAS float*)F.lds;
        LAS float* red = (LAS float*)(F.lds + 17 * 1024 * 4);
        for (int i = F.tid; i < 17 * 1024; i += NTHR) { const int r = i >> 10, k = i & 1023; const float v = r < 16 ? INP(IN_C)[r * 1024 + k] : INP(IN_CCTX)[k]; sc[i] = siluf(v); }
        __syncthreads();
        const int l = F.bid / 96, n0 = (F.bid % 96) * 64;
        const float* W = INP(IN_WADA) + (size_t)l * D * 6144 + n0 + F.lane;
        float acc[17];
#pragma unroll
        for (int r = 0; r < 17; ++r) acc[r] = 0.f;
        for (int k = F.wave; k < 1024; k += 8) { const float w = W[(size_t)k * 6144];
#pragma unroll
            for (int r = 0; r < 17; ++r) acc[r] += sc[r * 1024 + k] * w; }
#pragma unroll
        for (int r = 0; r < 17; ++r) red[(F.wave * 17 + r) * 64 + F.lane] = acc[r];
        __syncthreads();
        for (int i = F.tid; i < 17 * 64; i += NTHR) { const int r = i >> 6, c = i & 63; float s = 0.f;
#pragma unroll
            for (int w = 0; w < 8; ++w) s += red[(w * 17 + r) * 64 + c];
            ((float*)(F.ws + WS_MOD))[(size_t)(l * 17 + r) * 6144 + n0 + c] = s + INP(IN_BADA)[l * 6144 + n0 + c]; }
        __syncthreads();
    }
    if (F.bid == 255) {
        for (int i = F.tid; i < 1024; i += NTHR) { const int pos = i >> 4, f = i & 15; const float inv = powf(10000.f, -(float)f / 16.f); const float ang = (float)pos * inv;
            ((float*)(F.ws + WS_ROPE))[2 * i] = cosf(ang); ((float*)(F.ws + WS_ROPE))[2 * i + 1] = sinf(ang); }
    }
    {
        LAS float* scr = (LAS float*)(F.lds + F.wave * 16384);
        const int gw = F.bid * NWAVES + F.wave, NGW = F.G * NWAVES;
        constexpr int I_IN = 16 * 72, I_OUT = 16 * 32;
        for (int it = gw; it < 2 * (I_IN + I_OUT); it += NGW) {
            const int l = it / (I_IN + I_OUT); int r = it % (I_IN + I_OUT);
            if (r < I_IN) { transpose_item(INP(IN_WIN) + (size_t)l * D * INW, D, INW, (bf16_t*)(F.ws + WS_WIN) + (size_t)l * PW * D, RmId{}, scr, r / 72, r % 72, F.lane); continue; } r -= I_IN;
            transpose_item(INP(IN_WOUT) + (size_t)l * D * D, D, D, (bf16_t*)(F.ws + WS_WOUT) + (size_t)l * D * D, RmId{}, scr, r / 32, r % 32, F.lane);
        }
    }
    convert_experts(F, 0);
}

struct Row16 { f32x4 v[4]; };
__device__ __forceinline__ Row16 ld_row_f32(const float* p, int lane) { Row16 r; const f32x4* q = (const f32x4*)p + lane;
#pragma unroll
    for (int j = 0; j < 4; ++j) r.v[j] = q[64 * j];
    return r; }
__device__ __forceinline__ void st_row_f32(float* p, int lane, const Row16& r) { f32x4* q = (f32x4*)p + lane;
#pragma unroll
    for (int j = 0; j < 4; ++j) q[64 * j] = r.v[j]; }
__device__ __forceinline__ Row16 ld_row_bf16(const bf16_t* p, int lane) { Row16 r; const u32x2* q = (const u32x2*)p + lane;
#pragma unroll
    for (int j = 0; j < 4; ++j) { const u32x2 w = q[64 * j]; r.v[j] = (f32x4){lo2f(w.x), hi2f(w.x), lo2f(w.y), hi2f(w.y)}; }
    return r; }
__device__ __forceinline__ void st_row_bf16(bf16_t* p, int lane, const Row16& r) { u32x2* q = (u32x2*)p + lane;
#pragma unroll
    for (int j = 0; j < 4; ++j) { u32x2 w; w.x = pk2(r.v[j][0], r.v[j][1]); w.y = pk2(r.v[j][2], r.v[j][3]); q[64 * j] = w; } }
__device__ __forceinline__ float row_rstd(const Row16& r) { float s = 0.f;
#pragma unroll
    for (int j = 0; j < 4; ++j) s += (r.v[j][0] * r.v[j][0] + r.v[j][1] * r.v[j][1]) + (r.v[j][2] * r.v[j][2] + r.v[j][3] * r.v[j][3]);
    return rsqrtf(wave_sum(s) * (1.f / D) + EPS); }
__device__ __forceinline__ Row16 norm_mod(const Row16& h, const float* g, const float* sh, const float* sc, int lane) {
    const float rstd = row_rstd(h); const Row16 G = ld_row_f32(g, lane), SH = ld_row_f32(sh, lane), SC = ld_row_f32(sc, lane); Row16 u;
#pragma unroll
    for (int j = 0; j < 4; ++j) u.v[j] = (h.v[j] * rstd * G.v[j]) * (SC.v[j] + 1.f) + SH.v[j];
    return u; }

__device__ __forceinline__ void e1_phase(const Frame& F) {
    const int gw = F.bid * NWAVES + F.wave, NGW = F.G * NWAVES;
    bf16_t* U = (bf16_t*)(F.ws + WS_BUFA);
    for (int row = gw; row < NT; row += NGW) {
        const float* src = row < NLAT ? INP(IN_X) + (size_t)row * D : INP(IN_CTX) + (size_t)(row - NLAT) * D;
        const int mr = tok_modrow(row);
        const Row16 h = ld_row_f32(src, F.lane);
        const Row16 u = norm_mod(h, INP(IN_GMIXPRE), mod_ptr(F, 0, mr, 0), mod_ptr(F, 0, mr, 1), F.lane);
        st_row_bf16(U + (size_t)row * D, F.lane, u);
    }
}

__device__ __forceinline__ void e3_phase(const Frame& F, int l) {
    const int nrows = (l == 0) ? NT : NLAT;
    LAS float* wr = (LAS float*)F.lds;
    for (int i = F.tid; i < 1024 * 16; i += NTHR) wr[(i & 15) * 1024 + (i >> 4)] = INP(IN_WROUTER)[(size_t)l * D * 16 + i];
    __syncthreads();
    const int gw = F.bid * NWAVES + F.wave, NGW = F.G * NWAVES;
    const bf16_t* M = (const bf16_t*)(F.ws + WS_BUFB); bf16_t* U2 = (bf16_t*)(F.ws + WS_BUFA); float* AFF = (float*)(F.ws + WS_AFF);
    for (int row = gw; row < nrows; row += NGW) {
        const float* hsrc; float* hdst;
        if (row < NLAT) { hsrc = (l == 0) ? INP(IN_X) + (size_t)row * D : F.out + (size_t)row * D; hdst = F.out + (size_t)row * D; }
        else { hsrc = INP(IN_CTX) + (size_t)(row - NLAT) * D; hdst = (float*)(F.ws + WS_HCTX) + (size_t)(row - NLAT) * D; }
        const int mr = tok_modrow(row);
        const Row16 m = ld_row_bf16(M + (size_t)row * D, F.lane);
        Row16 h = ld_row_f32(hsrc, F.lane);
        { const float rstd = row_rstd(m); const Row16 G = ld_row_f32(INP(IN_GMIXPOST) + l * D, F.lane), GT = ld_row_f32(mod_ptr(F, l, mr, 2), F.lane);
#pragma unroll
          for (int j = 0; j < 4; ++j) h.v[j] = h.v[j] + GT.v[j] * (m.v[j] * rstd * G.v[j]); }
        st_row_f32(hdst, F.lane, h);
        const Row16 u = norm_mod(h, INP(IN_GFFNPRE) + l * D, mod_ptr(F, l, mr, 3), mod_ptr(F, l, mr, 4), F.lane);
        st_row_bf16(U2 + (size_t)row * D, F.lane, u);
        float lg[16];
#pragma unroll
        for (int e = 0; e < 16; ++e) { float s = 0.f;
#pragma unroll
            for (int j = 0; j < 4; ++j) { const f32x4 w = *(const LAS f32x4*)(wr + e * 1024 + 4 * F.lane + 256 * j); s += u.v[j][0] * w[0] + u.v[j][1] * w[1] + u.v[j][2] * w[2] + u.v[j][3] * w[3]; }
            lg[e] = s; if ((e & 3) == 3) __builtin_amdgcn_sched_barrier(0); }
        {
            const bool b5 = F.lane & 32, b4 = F.lane & 16, b3 = F.lane & 8, b2 = F.lane & 4;
#pragma unroll
            for (int i = 0; i < 8; ++i) { const float snd = b5 ? lg[i] : lg[i + 8], keep = b5 ? lg[i + 8] : lg[i]; lg[i] = keep + __shfl_xor(snd, 32); }
#pragma unroll
            for (int i = 0; i < 4; ++i) { const float snd = b4 ? lg[i] : lg[i + 4], keep = b4 ? lg[i + 4] : lg[i]; lg[i] = keep + __shfl_xor(snd, 16); }
#pragma unroll
            for (int i = 0; i < 2; ++i) { const float snd = b3 ? lg[i] : lg[i + 2], keep = b3 ? lg[i + 2] : lg[i]; lg[i] = keep + __shfl_xor(snd, 8); }
            { const float snd = b2 ? lg[0] : lg[1], keep = b2 ? lg[1] : lg[0]; lg[0] = keep + __shfl_xor(snd, 4); }
            float v = lg[0]; v += __shfl_xor(v, 2); v += __shfl_xor(v, 1);
            float mx = v; mx = fmaxf(mx, __shfl_xor(mx, 4)); mx = fmaxf(mx, __shfl_xor(mx, 8)); mx = fmaxf(mx, __shfl_xor(mx, 16)); mx = fmaxf(mx, __shfl_xor(mx, 32));
            const float ex = __expf(v - mx); float sm = ex; sm += __shfl_xor(sm, 4); sm += __shfl_xor(sm, 8); sm += __shfl_xor(sm, 16); sm += __shfl_xor(sm, 32);
            const int e = ((F.lane >> 5) & 1) * 8 + ((F.lane >> 4) & 1) * 4 + ((F.lane >> 3) & 1) * 2 + ((F.lane >> 2) & 1);
            if ((F.lane & 3) == 0) AFF[(size_t)row * 16 + e] = ex / sm;
        }
    }
}

__device__ __forceinline__ void e5_phase(const Frame& F, int l) {
    const int nrows = (l == 0) ? NT : NLAT;
    const int gw = F.bid * NWAVES + F.wave, NGW = F.G * NWAVES;
    const bf16_t* Y = (const bf16_t*)(F.ws + WS_BUFC); const short* SL = (const short*)(F.ws + WS_SLOT); bf16_t* U = (bf16_t*)(F.ws + WS_BUFA);
    for (int row = gw; row < nrows; row += NGW) {
        float* hp = row < NLAT ? F.out + (size_t)row * D : (float*)(F.ws + WS_HCTX) + (size_t)(row - NLAT) * D;
        const int mr = tok_modrow(row);
        const int myslot = (F.lane < 16) ? (int)SL[(size_t)row * 16 + F.lane] : -1;
        Row16 f;
#pragma unroll
        for (int j = 0; j < 4; ++j) f.v[j] = (f32x4){0.f, 0.f, 0.f, 0.f};
        for (int e = 0; e < 16; ++e) { const int sl = __shfl(myslot, e);
            if (sl >= 0) { const Row16 y = ld_row_bf16(Y + ((size_t)e * EROWS + sl) * D, F.lane);
#pragma unroll
                for (int j = 0; j < 4; ++j) f.v[j] += y.v[j]; } }
        Row16 h = ld_row_f32(hp, F.lane);
        { const float rstd = row_rstd(f); const Row16 G = ld_row_f32(INP(IN_GFFNPOST) + l * D, F.lane), GT = ld_row_f32(mod_ptr(F, l, mr, 5), F.lane);
#pragma unroll
          for (int j = 0; j < 4; ++j) h.v[j] = h.v[j] + GT.v[j] * (f.v[j] * rstd * G.v[j]); }
        st_row_f32(hp, F.lane, h);
        if (l == 0) { const Row16 u = norm_mod(h, INP(IN_GMIXPRE) + D, mod_ptr(F, 1, mr, 0), mod_ptr(F, 1, mr, 1), F.lane); st_row_bf16(U + (size_t)row * D, F.lane, u); }
    }
}

__device__ __forceinline__ void topk_unit(const Frame& F, int kind, int e, int b) {
    const int T = kind ? CTX : SEQ, cap = kind ? 32 : 512;
    const int row0 = kind ? NLAT + b * CTX : b * SEQ, base = kind ? 8192 + b * 32 : b * 512;
    LAS unsigned long long* key = (LAS unsigned long long*)F.lds;
    const float* AFF = (const float*)(F.ws + WS_AFF);
    for (int t = F.tid; t < T; t += NTHR) { const float a = AFF[(size_t)(row0 + t) * 16 + e]; key[t] = ((unsigned long long)__float_as_uint(a) << 32) | (unsigned)(0xFFFFFFFFu - (unsigned)t); }
    __syncthreads();
    for (int k = 2; k <= T; k <<= 1)
        for (int j = k >> 1; j > 0; j >>= 1) {
            for (int i = F.tid; i < T; i += NTHR) { const int x = i ^ j;
                if (x > i) { const unsigned long long a = key[i], c = key[x]; const bool desc = ((i & k) == 0);
                    if (desc ? (a < c) : (a > c)) { key[i] = c; key[x] = a; } } }
            __syncthreads();
        }
    int* RI = (int*)(F.ws + WS_ROWIDX); float* GT = (float*)(F.ws + WS_GATE); short* SL = (short*)(F.ws + WS_SLOT);
    for (int s = F.tid; s < T; s += NTHR) { const unsigned long long kk = key[s]; const int t = (int)(0xFFFFFFFFu - (unsigned)kk);
        if (s < cap) { RI[e * EROWS + base + s] = row0 + t; GT[e * EROWS + base + s] = __uint_as_float((unsigned)(kk >> 32)); SL[(size_t)(row0 + t) * 16 + e] = (short)(base + s); }
        else SL[(size_t)(row0 + t) * 16 + e] = (short)-1; }
    __syncthreads();
}
__device__ __forceinline__ void topk_phase(const Frame& F, int l) {
    const int nunits = (l == 0) ? 512 : 256;
    for (int u = F.bid; u < nunits; u += F.G) { const int kind = u >> 8, e = (u & 255) >> 4, b = u & 15; topk_unit(F, kind, e, b); }
}
__device__ __forceinline__ void chunk_geom(int b, int c, int& rbase, int& t0, int& Tseg) {
    if (c < 2) { rbase = NLAT + b * CTX; t0 = c * 128; Tseg = CTX; } else { rbase = b * SEQ; t0 = (c - 2) * 128; Tseg = SEQ; }
}
__device__ __forceinline__ size_t st_index(int b, int c, int dir, int h) { return ((((size_t)b * NCH + c) * 2 + dir) * 6 + h) * 8192; }

__device__ __forceinline__ void dt_scan(const Frame& F, int l, const bf16_t* Pp, int row0, int dir, int h, float (&dt)[2], float (&incl)[2], float (&dA)[2], float& total) {
    const float bias = INP(IN_DTBIAS)[(l * 2 + dir) * 6 + h], a = -__expf(INP(IN_ALOG)[(l * 2 + dir) * 6 + h]);
#pragma unroll
    for (int q = 0; q < 2; ++q) { const float raw = bf2f(Pp[(size_t)(row0 + 2 * F.lane + q) * PW + PDT + dir * 6 + h]); dt[q] = softplusf(raw + bias); dA[q] = dt[q] * a; }
    float x = dA[0] + dA[1];
#pragma unroll
    for (int o = 1; o < 64; o <<= 1) { const float v = __shfl_up(x, o); if (F.lane >= o) x += v; }
    incl[1] = x; incl[0] = x - dA[1];
    total = __shfl(x, 63);
}

__device__ __forceinline__ void s1_unit(const Frame& F, int l, int b, int c, int g) {
    int rbase, t0, Tseg; chunk_geom(b, c, rbase, t0, Tseg);
    LAS bf16_t* Xs = (LAS bf16_t*)F.lds;
    LAS bf16_t* Bs = (LAS bf16_t*)(F.lds + 51200);
    LAS float* WF = (LAS float*)(F.lds + 86016);
    LAS float* WB = (LAS float*)(F.lds + 87552);
    const bf16_t* Pp = (const bf16_t*)(F.ws + WS_BUFB);
    bf16_t* XC = (bf16_t*)(F.ws + WS_BUFC + BC_XC);
    __syncthreads();
    if (F.tid < 448) {
        const int cg = F.tid % 56, run = F.tid / 56;
        const int ch = cg < 24 ? g * 192 + cg * 8 : (cg < 40 ? 384 + g * 128 + (cg - 24) * 8 : 640 + g * 128 + (cg - 40) * 8);
        float w[5][8], bias[8];
#pragma unroll
        for (int k = 0; k < 5; ++k) { const f32x4 a = *(const f32x4*)(INP(IN_CONVW) + (size_t)(l * 5 + k) * 896 + ch), bb = *(const f32x4*)(INP(IN_CONVW) + (size_t)(l * 5 + k) * 896 + ch + 4);
#pragma unroll
            for (int q = 0; q < 4; ++q) { w[k][q] = a[q]; w[k][4 + q] = bb[q]; } }
        { const f32x4 a = *(const f32x4*)(INP(IN_CONVB) + l * 896 + ch), bb = *(const f32x4*)(INP(IN_CONVB) + l * 896 + ch + 4);
#pragma unroll
          for (int q = 0; q < 4; ++q) { bias[q] = a[q]; bias[4 + q] = bb[q]; } }
        float win[5][8];
        const int tt0 = 16 * run;
#define S1_LOADROW(dst, t) do { const int _t = (t); if (_t >= 0 && _t < Tseg) { const u32x4 _v = *(const u32x4*)(Pp + (size_t)(rbase + _t) * PW + PX + ch); \
            dst[0] = lo2f(_v.x); dst[1] = hi2f(_v.x); dst[2] = lo2f(_v.y); dst[3] = hi2f(_v.y); dst[4] = lo2f(_v.z); dst[5] = hi2f(_v.z); dst[6] = lo2f(_v.w); dst[7] = hi2f(_v.w); } \
            else { _Pragma("unroll") for (int _q = 0; _q < 8; ++_q) dst[_q] = 0.f; } } while (0)
        S1_LOADROW(win[0], t0 + tt0 - 2); S1_LOADROW(win[1], t0 + tt0 - 1); S1_LOADROW(win[2], t0 + tt0); S1_LOADROW(win[3], t0 + tt0 + 1);
#pragma unroll 1
        for (int i = 0; i < 16; ++i) {
            S1_LOADROW(win[4], t0 + tt0 + i + 2);
            float o[8];
#pragma unroll
            for (int q = 0; q < 8; ++q) { float s = bias[q];
#pragma unroll
                for (int k = 0; k < 5; ++k) s += w[k][q] * win[k][q];
                o[q] = siluf(s); }
            u32x4 pk; pk.x = pk2(o[0], o[1]); pk.y = pk2(o[2], o[3]); pk.z = pk2(o[4], o[5]); pk.w = pk2(o[6], o[7]);
            *(u32x4*)(XC + (size_t)(rbase + t0 + tt0 + i) * 896 + ch) = pk;
            if (cg < 24) *(LAS u32x4*)(Xs + (tt0 + i) * 200 + cg * 8) = pk;
            else if (cg < 40) *(LAS u32x4*)(Bs + (tt0 + i) * 136 + (cg - 24) * 8) = pk;
#pragma unroll
            for (int k = 0; k < 4; ++k)
#pragma unroll
                for (int q = 0; q < 8; ++q) win[k][q] = win[k + 1][q];
        }
#undef S1_LOADROW
    }
    if (F.wave < 6) {
        const int dir = F.wave / 3, r = F.wave % 3, h = g * 3 + r;
        float dt[2], incl[2], dA[2], total;
        dt_scan(F, l, Pp, rbase + t0, dir, h, dt, incl, dA, total);
#pragma unroll
        for (int q = 0; q < 2; ++q) {
            const float wgt = dir == 0 ? dt[q] * __expf(total - incl[q]) : dt[q] * __expf(incl[q] - dA[q]);
            (dir == 0 ? WF : WB)[r * 128 + 2 * F.lane + q] = wgt; }
        if (F.lane == 0) ((float*)(F.ws + WS_DECAY))[((b * NCH + c) * 2 + dir) * 6 + h] = __expf(total);
    }
    __syncthreads();
    {
        const int li = F.lane & 15, gq = F.lane >> 4, pt = F.wave & 3, nh = F.wave >> 2;
        bf16x8 fn[4][4];
#pragma unroll
        for (int ks = 0; ks < 4; ++ks)
#pragma unroll
            for (int nt = 0; nt < 4; ++nt) fn[ks][nt] = frag_tr(Bs, 136, 32 * ks, 16 * (4 * nh + nt), li, gq);
        bf16_t* ST = (bf16_t*)(F.ws + WS_BUFC + BC_ST);
#pragma unroll 1
        for (int combo = 0; combo < 6; ++combo) {
            const int dir = combo / 3, r = combo % 3, h = g * 3 + r;
            const LAS float* W = (dir == 0 ? WF : WB) + r * 128;
            f32x4 acc[4];
#pragma unroll
            for (int nt = 0; nt < 4; ++nt) acc[nt] = (f32x4){0.f, 0.f, 0.f, 0.f};
#pragma unroll
            for (int ks = 0; ks < 4; ++ks) {
                const bf16x8 xr = frag_tr(Xs, 200, 32 * ks, r * 64 + 16 * pt, li, gq);
                const f32x4 w0 = *(const LAS f32x4*)(W + 32 * ks + 8 * gq), w1 = *(const LAS f32x4*)(W + 32 * ks + 8 * gq + 4);
                u32x4 pw;
                pw.x = pk2(bf2f((bf16_t)xr[0]) * w0[0], bf2f((bf16_t)xr[1]) * w0[1]); pw.y = pk2(bf2f((bf16_t)xr[2]) * w0[2], bf2f((bf16_t)xr[3]) * w0[3]);
                pw.z = pk2(bf2f((bf16_t)xr[4]) * w1[0], bf2f((bf16_t)xr[5]) * w1[1]); pw.w = pk2(bf2f((bf16_t)xr[6]) * w1[2], bf2f((bf16_t)xr[7]) * w1[3]);
                const bf16x8 xw = __builtin_bit_cast(bf16x8, pw);
#pragma unroll
                for (int nt = 0; nt < 4; ++nt) acc[nt] = mfma16(fn[ks][nt], xw, acc[nt]);
            }
            bf16_t* dst = ST + st_index(b, c, dir, h) + (size_t)(16 * pt + li) * 128;
#pragma unroll
            for (int nt = 0; nt < 4; ++nt) *(u32x2*)(dst + 16 * (4 * nh + nt) + 4 * gq) = pack4(acc[nt]);
        }
    }
}

__device__ __forceinline__ void s2_phase(const Frame& F) {
    bf16_t* ST = (bf16_t*)(F.ws + WS_BUFC + BC_ST); const float* DEC = (const float*)(F.ws + WS_DECAY);
    for (int it = F.bid * NTHR + F.tid; it < NB * 2 * 6 * 64 * 16; it += F.G * NTHR) {
        const int n8 = it & 15, p = (it >> 4) & 63, hh = (it >> 10) % 6, dir = ((it >> 10) / 6) & 1, b = (it >> 10) / 12;
        float hst[8];
#pragma unroll
        for (int q = 0; q < 8; ++q) hst[q] = 0.f;
#pragma unroll 2
        for (int s = 0; s < NCH; ++s) {
            const int c = dir == 0 ? s : (s < 2 ? 1 - s : NCH + 1 - s);
            bf16_t* ptr = ST + st_index(b, c, dir, hh) + p * 128 + n8 * 8;
            const u32x4 v = *(const u32x4*)ptr;
            const float d = DEC[((b * NCH + c) * 2 + dir) * 6 + hh];
            u32x4 o; o.x = pk2(hst[0], hst[1]); o.y = pk2(hst[2], hst[3]); o.z = pk2(hst[4], hst[5]); o.w = pk2(hst[6], hst[7]);
            *(u32x4*)ptr = o;
            hst[0] = hst[0] * d + lo2f(v.x); hst[1] = hst[1] * d + hi2f(v.x); hst[2] = hst[2] * d + lo2f(v.y); hst[3] = hst[3] * d + hi2f(v.y);
            hst[4] = hst[4] * d + lo2f(v.z); hst[5] = hst[5] * d + hi2f(v.z); hst[6] = hst[6] * d + lo2f(v.w); hst[7] = hst[7] * d + hi2f(v.w);
        }
    }
}

__device__ __forceinline__ void s3_unit(const Frame& F, int l, int b, int c) {
    int rbase, t0, Tseg; chunk_geom(b, c, rbase, t0, Tseg);
    LAS bf16_t* Bs = (LAS bf16_t*)F.lds;
    LAS bf16_t* Xs = (LAS bf16_t*)(F.lds + 34816);
    LAS bf16_t* SCR = (LAS bf16_t*)(F.lds + 86016 + F.wave * 4352);
    LAS float* DTF = (LAS float*)(F.lds + 120832);
    LAS float* DTB = DTF + 384; LAS float* ACF = DTF + 768; LAS float* ACB = DTF + 1152;
    const bf16_t* Pp = (const bf16_t*)(F.ws + WS_BUFB);
    const bf16_t* XC = (const bf16_t*)(F.ws + WS_BUFC + BC_XC);
    const bf16_t* ST = (const bf16_t*)(F.ws + WS_BUFC + BC_ST);
    bf16_t* MIX = (bf16_t*)(F.ws + WS_BUFA);
    const int li = F.lane & 15, gq = F.lane >> 4, w = F.wave;
    const int itok = 16 * w + li;
    const size_t grow = (size_t)(rbase + t0 + itok);
    float ss = 0.f;
#pragma unroll 1
    for (int g = 0; g < 2; ++g) {
        __syncthreads();
        for (int i = F.tid; i < 128 * 40; i += NTHR) { const int t = i / 40, cc = i % 40; const size_t rr = (size_t)(rbase + t0 + t) * 896;
            if (cc < 24) *(LAS u32x4*)(Xs + t * 200 + cc * 8) = *(const u32x4*)(XC + rr + g * 192 + cc * 8);
            else *(LAS u32x4*)(Bs + t * 136 + (cc - 24) * 8) = *(const u32x4*)(XC + rr + 384 + g * 128 + (cc - 24) * 8); }
        if (w < 6) {
            const int dir = w / 3, r = w % 3, h = g * 3 + r;
            float dt[2], incl[2], dA[2], total;
            dt_scan(F, l, Pp, rbase + t0, dir, h, dt, incl, dA, total);
#pragma unroll
            for (int q = 0; q < 2; ++q) { const int tt = 2 * F.lane + q;
                if (dir == 0) { DTF[r * 128 + tt] = dt[q]; ACF[r * 128 + tt] = incl[q]; }
                else { DTB[r * 128 + tt] = dt[q]; ACB[r * 128 + tt] = total - (incl[q] - dA[q]); } }
        }
        bf16x8 cf[4];
#pragma unroll
        for (int ks = 0; ks < 4; ++ks) cf[ks] = *(const bf16x8*)(XC + grow * 896 + 640 + g * 128 + 32 * ks + 8 * gq);
        __syncthreads();
        f32x4 cb[8];
#pragma unroll
        for (int jt = 0; jt < 8; ++jt) { cb[jt] = (f32x4){0.f, 0.f, 0.f, 0.f};
#pragma unroll
            for (int ks = 0; ks < 4; ++ks) cb[jt] = mfma16(frag_lds(Bs, 136, 16 * jt, 32 * ks, li, gq), cf[ks], cb[jt]); }
#pragma unroll 1
        for (int r = 0; r < 3; ++r) {
            const int h = g * 3 + r;
            int itk = itok; asm volatile("" : "+v"(itk));
            const float af_i = ACF[r * 128 + itok], ab_i = ACB[r * 128 + itok];
#pragma unroll
            for (int jt = 0; jt < 8; ++jt) { const int jv = 16 * jt + 4 * gq;
                const f32x4 acf = *(const LAS f32x4*)(ACF + r * 128 + jv), dtf = *(const LAS f32x4*)(DTF + r * 128 + jv), acb = *(const LAS f32x4*)(ACB + r * 128 + jv), dtb = *(const LAS f32x4*)(DTB + r * 128 + jv);
                f32x4 mv;
#pragma unroll
                for (int q = 0; q < 4; ++q) { const int j = jv + q;
                    const float mfw = (float)(((itk - j) >> 31) + 1), mbw = (float)(((j - itk) >> 31) + 1);
                    const float ef = mfw * __expf(fminf(af_i - acf[q], 0.f)) * dtf[q];
                    const float eb = mbw * __expf(fminf(ab_i - acb[q], 0.f)) * dtb[q];
                    mv[q] = cb[jt][q] * (ef + eb); }
                *(LAS u32x2*)(SCR + li * 136 + jv) = pack4(mv); }
            LDS_FENCE();
            bf16x8 mf[4];
#pragma unroll
            for (int ks = 0; ks < 4; ++ks) mf[ks] = frag_lds(SCR, 136, 0, 32 * ks, li, gq);
            const float ef_i = __expf(af_i), eb_i = __expf(ab_i), dsk = INP(IN_DSKIP)[l * 6 + h];
            const bf16_t* Hf = ST + st_index(b, c, 0, h); const bf16_t* Hb = ST + st_index(b, c, 1, h);
#pragma unroll
            for (int pt = 0; pt < 4; ++pt) {
                f32x4 ya = (f32x4){0.f, 0.f, 0.f, 0.f}, gf = ya, gb = ya;
#pragma unroll
                for (int ks = 0; ks < 4; ++ks) {
                    ya = mfma16(frag_tr(Xs, 200, 32 * ks, r * 64 + 16 * pt, li, gq), mf[ks], ya);
                    gf = mfma16(frag_glb(Hf, 128, 16 * pt, 32 * ks, li, gq), cf[ks], gf);
                    gb = mfma16(frag_glb(Hb, 128, 16 * pt, 32 * ks, li, gq), cf[ks], gb); }
                const u32x2 xw = *(const LAS u32x2*)(Xs + itok * 200 + r * 64 + 16 * pt + 4 * gq);
                const u32x2 zw = *(const u32x2*)(Pp + grow * PW + PZ + h * 64 + 16 * pt + 4 * gq);
                const float xs_[4] = {lo2f(xw.x), hi2f(xw.x), lo2f(xw.y), hi2f(xw.y)}, zs_[4] = {lo2f(zw.x), hi2f(zw.x), lo2f(zw.y), hi2f(zw.y)};
                f32x4 o;
#pragma unroll
                for (int q = 0; q < 4; ++q) { const float y = ya[q] + ef_i * gf[q] + eb_i * gb[q] + dsk * xs_[q]; o[q] = y * siluf(zs_[q]); ss += o[q] * o[q]; }
                *(u32x2*)(MIX + grow * D + 640 + h * 64 + 16 * pt + 4 * gq) = pack4(o);
            }
            LDS_FENCE();
        }
    }
    ss += __shfl_xor(ss, 16); ss += __shfl_xor(ss, 32);
    const float rstd = rsqrtf(ss * (1.f / 384.f) + EPS);
    asm volatile("s_waitcnt vmcnt(0)" ::: "memory");
#pragma unroll 2
    for (int hp = 0; hp < 24; ++hp) { const int col = (hp >> 2) * 64 + 16 * (hp & 3) + 4 * gq; const f32x4 gs = *(const f32x4*)(INP(IN_GSSD) + l * 384 + col);
        const u32x2 yw = *(const u32x2*)(MIX + grow * D + 640 + col);
#if defined(DBG_ZERO_S)
        const f32x4 o = (f32x4){0.f, 0.f, 0.f, 0.f} * (rstd * gs + lo2f(yw.x));
#else
        const f32x4 o = (f32x4){lo2f(yw.x), hi2f(yw.x), lo2f(yw.y), hi2f(yw.y)} * rstd * gs;
#endif
        *(u32x2*)(MIX + grow * D + 640 + col) = pack4(o); }
}

__device__ __forceinline__ void attn_unit(const Frame& F, int l, int b, int nb, int kvh, bool ctxq) {
    LAS float* ROPE = (LAS float*)F.lds;
    LAS bf16_t* Kt = (LAS bf16_t*)(F.lds + 8192);
    LAS bf16_t* Vt = (LAS bf16_t*)(F.lds + 26624);
    const bf16_t* Pp = (const bf16_t*)(F.ws + WS_BUFB);
    bf16_t* MIX = (bf16_t*)(F.ws + WS_BUFA);
    const int li = F.lane & 15, gq = F.lane >> 4, w = F.wave;
    __syncthreads();
    for (int i = F.tid; i < 2048; i += NTHR) ROPE[i] = ((const float*)(F.ws + WS_ROPE))[i];
    __syncthreads();
    const int qrow_base = ctxq ? NLAT + b * CTX + nb * 128 : b * SEQ + nb * 128;
    bf16x8 qf[3][2]; float m[3], lsum[3];
    f32x4 o[4][3];
#pragma unroll
    for (int qt = 0; qt < 3; ++qt) {
        const int R = 48 * w + 16 * qt, r = R >> 7, qi = (R & 127) + li, h = kvh * 3 + r;
        const bf16_t* qp = Pp + (size_t)(qrow_base + qi) * PW + PQ + h * 64;
        const int tq = nb * 128 + qi;
#pragma unroll
        for (int ks = 0; ks < 2; ++ks) {
            const int d0 = 32 * ks + 8 * gq;
            const u32x4 own = *(const u32x4*)(qp + d0);
            float ov[8] = {lo2f(own.x), hi2f(own.x), lo2f(own.y), hi2f(own.y), lo2f(own.z), hi2f(own.z), lo2f(own.w), hi2f(own.w)};
            if (!ctxq) {
                const u32x4 par = *(const u32x4*)(qp + (d0 ^ 16));
                const float pv[8] = {lo2f(par.x), hi2f(par.x), lo2f(par.y), hi2f(par.y), lo2f(par.z), hi2f(par.z), lo2f(par.w), hi2f(par.w)};
                const int pos = ks == 0 ? (tq >> 6) : (tq & 63), f0 = (8 * gq) & 15;
#pragma unroll
                for (int j = 0; j < 8; ++j) { const float cs = ROPE[(pos * 16 + f0 + j) * 2], sn = ROPE[(pos * 16 + f0 + j) * 2 + 1];
                    ov[j] = (gq < 2) ? (ov[j] * cs - pv[j] * sn) : (pv[j] * sn + ov[j] * cs); }
            }
            u32x4 pq; pq.x = pk2(ov[0] * 0.125f, ov[1] * 0.125f); pq.y = pk2(ov[2] * 0.125f, ov[3] * 0.125f); pq.z = pk2(ov[4] * 0.125f, ov[5] * 0.125f); pq.w = pk2(ov[6] * 0.125f, ov[7] * 0.125f);
            qf[qt][ks] = __builtin_bit_cast(bf16x8, pq);
        }
        m[qt] = INP(IN_SINK)[l * 6 + h]; lsum[qt] = (gq == 0) ? 1.f : 0.f;
#pragma unroll
        for (int dt = 0; dt < 4; ++dt) o[dt][qt] = (f32x4){0.f, 0.f, 0.f, 0.f};
    }
    const int ntile = ctxq ? 2 : 5;
#pragma unroll 1
    for (int ti = 0; ti < ntile; ++ti) {
        const bool local = (!ctxq) && ti < 3;
        const int kb = nb - 1 + ti;
        if (local && (kb < 0 || kb >= 32)) continue;
        const int ct = ctxq ? ti : ti - 3;
        const int krow0 = local ? b * SEQ + kb * 128 : NLAT + b * CTX + ct * 128;
        __syncthreads();
        {
            const int key = F.tid >> 2, part = F.tid & 3, c1 = part < 2 ? part : part + 2, c2 = c1 + 2;
            const bf16_t* kp = Pp + (size_t)(krow0 + key) * PW + PK + kvh * 64;
            const u32x4 a = *(const u32x4*)(kp + 8 * c1), bq = *(const u32x4*)(kp + 8 * c2);
            u32x4 oa = a, ob = bq;
            if (local) {
                const float v1[8] = {lo2f(a.x), hi2f(a.x), lo2f(a.y), hi2f(a.y), lo2f(a.z), hi2f(a.z), lo2f(a.w), hi2f(a.w)};
                const float v2[8] = {lo2f(bq.x), hi2f(bq.x), lo2f(bq.y), hi2f(bq.y), lo2f(bq.z), hi2f(bq.z), lo2f(bq.w), hi2f(bq.w)};
                const int tk = kb * 128 + key, pos = c1 < 4 ? (tk >> 6) : (tk & 63), f0 = (8 * c1) & 15;
                float r1[8], r2[8];
#pragma unroll
                for (int j = 0; j < 8; ++j) { const float cs = ROPE[(pos * 16 + f0 + j) * 2], sn = ROPE[(pos * 16 + f0 + j) * 2 + 1]; r1[j] = v1[j] * cs - v2[j] * sn; r2[j] = v1[j] * sn + v2[j] * cs; }
                oa.x = pk2(r1[0], r1[1]); oa.y = pk2(r1[2], r1[3]); oa.z = pk2(r1[4], r1[5]); oa.w = pk2(r1[6], r1[7]);
                ob.x = pk2(r2[0], r2[1]); ob.y = pk2(r2[2], r2[3]); ob.z = pk2(r2[4], r2[5]); ob.w = pk2(r2[6], r2[7]);
            }
            *(LAS u32x4*)(Kt + key * 72 + 8 * c1) = oa; *(LAS u32x4*)(Kt + key * 72 + 8 * c2) = ob;
#pragma unroll
            for (int q = 0; q < 2; ++q) { const int idx = F.tid + 512 * q, k2 = idx >> 3, chv = idx & 7;
                *(LAS u32x4*)(Vt + k2 * 72 + 8 * chv) = *(const u32x4*)(Pp + (size_t)(krow0 + k2) * PW + PV + kvh * 64 + 8 * chv); }
        }
        __syncthreads();
        const bool masked = local && (kb != nb);
#pragma unroll
        for (int qt = 0; qt < 3; ++qt) {
            __builtin_amdgcn_sched_barrier(0);
            const int qpos = nb * 128 + (((48 * w + 16 * qt) & 127) + li);
#pragma unroll 1
            for (int hf = 0; hf < 2; ++hf) {
                f32x4 s[4];
#pragma unroll
                for (int kt = 0; kt < 4; ++kt) { s[kt] = (f32x4){0.f, 0.f, 0.f, 0.f};
#pragma unroll
                    for (int ks = 0; ks < 2; ++ks) s[kt] = mfma16(frag_lds(Kt, 72, 64 * hf + 16 * kt, 32 * ks, li, gq), qf[qt][ks], s[kt]); }
                float tmax = -1e30f;
#pragma unroll
                for (int kt = 0; kt < 4; ++kt)
#pragma unroll
                    for (int q = 0; q < 4; ++q) {
                        if (masked) { const int kpos = kb * 128 + 64 * hf + 16 * kt + 4 * gq + q; const int dd = qpos - kpos; if (dd > 128 || dd < -128) s[kt][q] = -1e30f; }
                        tmax = fmaxf(tmax, s[kt][q]); }
                tmax = fmaxf(tmax, __shfl_xor(tmax, 16)); tmax = fmaxf(tmax, __shfl_xor(tmax, 32));
                const float mnew = fmaxf(m[qt], tmax), alpha = __expf(m[qt] - mnew);
                float ps = 0.f;
#pragma unroll
                for (int kt = 0; kt < 4; ++kt)
#pragma unroll
                    for (int q = 0; q < 4; ++q) { const float pe = __expf(s[kt][q] - mnew); s[kt][q] = pe; ps += pe; }
                lsum[qt] = lsum[qt] * alpha + ps; m[qt] = mnew;
#pragma unroll
                for (int dt = 0; dt < 4; ++dt) o[dt][qt] = o[dt][qt] * alpha;
#pragma unroll
                for (int k4 = 0; k4 < 2; ++k4) {
                    u32x4 pp; pp.x = pk2(s[2 * k4][0], s[2 * k4][1]); pp.y = pk2(s[2 * k4][2], s[2 * k4][3]); pp.z = pk2(s[2 * k4 + 1][0], s[2 * k4 + 1][1]); pp.w = pk2(s[2 * k4 + 1][2], s[2 * k4 + 1][3]);
                    const bf16x8 pf = __builtin_bit_cast(bf16x8, pp);
#pragma unroll
                    for (int dt = 0; dt < 4; ++dt) o[dt][qt] = mfma16(frag_tr_split(Vt, 72, 64 * hf + 32 * k4, 16 * dt, li, gq), pf, o[dt][qt]);
                }
            }
        }
    }
#pragma unroll
    for (int qt = 0; qt < 3; ++qt) {
        float lt = lsum[qt]; lt += __shfl_xor(lt, 16); lt += __shfl_xor(lt, 32);
        const float inv = 1.f / lt;
        const int R = 48 * w + 16 * qt;
        bf16_t* op = MIX + (size_t)(qrow_base + (R & 127) + li) * D + 256 + (kvh * 3 + (R >> 7)) * 64 + 4 * gq;
#pragma unroll
#if defined(DBG_ZERO_A)
        for (int dt = 0; dt < 4; ++dt) *(u32x2*)(op + 16 * dt) = pack4(o[dt][qt] * 0.f);
#else
        for (int dt = 0; dt < 4; ++dt) *(u32x2*)(op + 16 * dt) = pack4(o[dt][qt] * inv);
#endif
    }
}

#if defined(DBG_ZERO_F)
constexpr float FSCALE512 = 0.f, FSCALE128 = 0.f;
#else
constexpr float FSCALE512 = 1.f / 512.f, FSCALE128 = 1.f / 128.f;
#endif
constexpr int FO_CST = 0, FO_M2 = 18432, FO_Z = 53248, FO_CSB = 90112, FO_FST = 107520, FO_Z2 = 53248, FO_TAB = 126976;
__device__ __forceinline__ void fourier_consts_a(const Frame& F) {
    LAS bf16_t* CSt = (LAS bf16_t*)(F.lds + FO_CST); LAS bf16_t* M2 = (LAS bf16_t*)(F.lds + FO_M2);
    __syncthreads();
    for (int i = F.tid; i < 128 * 64; i += NTHR) { const int cp = i >> 6, c = i & 63; const int ph = (c * (cp & 63)) & 63; const float v = cp < 64 ? cospif(ph / 32.f) : sinpif(ph / 32.f);
        CSt[cp * 72 + c] = (bf16_t)(pk2(v, 0.f) & 0xffff); }
    for (int i = F.tid; i < 128 * 128; i += NTHR) { const int kp = i >> 7, kk = i & 127; const int ph = ((kp & 63) * (kk & 63)) & 63; const float cs = cospif(ph / 32.f), sn = sinpif(ph / 32.f);
        const float v = kp < 64 ? (kk < 64 ? cs : -sn) : (kk < 64 ? -sn : -cs);
        M2[kp * 136 + kk] = (bf16_t)(pk2(v, 0.f) & 0xffff); }
    __syncthreads();
}
__device__ __forceinline__ void fourier_consts_b(const Frame& F) {
    LAS bf16_t* CSb = (LAS bf16_t*)(F.lds + FO_CSB);
    __syncthreads();
    for (int i = F.tid; i < 64 * 128; i += NTHR) { const int k2 = i >> 7, kk = i & 127; const int ph = (k2 * (kk & 63)) & 63; const float v = kk < 64 ? cospif(ph / 32.f) : sinpif(ph / 32.f);
        CSb[k2 * 136 + kk] = (bf16_t)(pk2(v, 0.f) & 0xffff); }
    __syncthreads();
}
__device__ __forceinline__ void fa_unit(const Frame& F, int b, int g, int pr) {
    LAS bf16_t* CSt = (LAS bf16_t*)(F.lds + FO_CST); LAS bf16_t* M2 = (LAS bf16_t*)(F.lds + FO_M2);
    const bf16_t* Pp = (const bf16_t*)(F.ws + WS_BUFB); bf16_t* FA = (bf16_t*)(F.ws + WS_BUFC + BC_FA);
    const int li = F.lane & 15, gq = F.lane >> 4, w = F.wave;
    __syncthreads();
#pragma unroll
    for (int u2 = 0; u2 < 2; ++u2) {
        LAS bf16_t* Z = (LAS bf16_t*)(F.lds + FO_Z + u2 * 18432);
        const int n2 = 2 * pr + u2, n1 = 16 * (w & 3) + li;
        const bf16_t* up = Pp + (size_t)(b * SEQ + 64 * n1 + n2) * PW + PF + g * 64;
        bf16x8 uf[2];
#pragma unroll
        for (int ks = 0; ks < 2; ++ks) uf[ks] = *(const bf16x8*)(up + 32 * ks + 8 * gq);
#pragma unroll
        for (int ctl = 0; ctl < 4; ++ctl) { const int ct = 4 * (w >> 2) + ctl; f32x4 acc = (f32x4){0.f, 0.f, 0.f, 0.f};
#pragma unroll
            for (int ks = 0; ks < 2; ++ks) acc = mfma16(frag_lds(CSt, 72, 16 * ct, 32 * ks, li, gq), uf[ks], acc);
            const int cp = 16 * ct + 4 * gq;
            *(LAS u32x2*)(Z + ((cp < 64 ? 0 : 64) + n1) * 72 + (cp & 63)) = pack4(acc); }
    }
    __syncthreads();
#pragma unroll
    for (int u2 = 0; u2 < 2; ++u2) {
        LAS bf16_t* Z = (LAS bf16_t*)(F.lds + FO_Z + u2 * 18432);
        const int n2 = 2 * pr + u2, kt = w & 3, k1 = 16 * kt + li;
        const int ph = (n2 * k1) & 4095; const float cs = cospif(ph / 2048.f), sn = sinpif(ph / 2048.f);
#pragma unroll
        for (int ctl = 0; ctl < 2; ++ctl) { const int ct = 2 * (w >> 2) + ctl; f32x4 ar = (f32x4){0.f, 0.f, 0.f, 0.f}, ai = ar;
#pragma unroll
            for (int ks = 0; ks < 4; ++ks) { const bf16x8 zf = frag_tr(Z, 72, 32 * ks, 16 * ct, li, gq);
                ar = mfma16(zf, frag_lds(M2, 136, 16 * kt, 32 * ks, li, gq), ar);
                ai = mfma16(zf, frag_lds(M2, 136, 64 + 16 * kt, 32 * ks, li, gq), ai); }
            const f32x4 tr = ar * cs + ai * sn, tim = ai * cs - ar * sn;
            bf16_t* dst = FA + ((((size_t)(b * 4 + g) * 64 + k1) * 64 + n2) * 128) + 16 * ct + 4 * gq;
            *(u32x2*)dst = pack4(tr); *(u32x2*)(dst + 64) = pack4(tim); }
    }
}
__device__ __forceinline__ void fb_unit(const Frame& F, int b, int g, int k1) {
    LAS bf16_t* CSb = (LAS bf16_t*)(F.lds + FO_CSB); LAS bf16_t* Fst = (LAS bf16_t*)(F.lds + FO_FST);
    const bf16_t* FA = (const bf16_t*)(F.ws + WS_BUFC + BC_FA) + (((size_t)(b * 4 + g) * 64 + k1) * 64) * 128;
    bf16_t* MIX = (bf16_t*)(F.ws + WS_BUFA);
    const int li = F.lane & 15, gq = F.lane >> 4, w = F.wave;
    __syncthreads();
#pragma unroll
    for (int q = 0; q < 2; ++q) { const int idx = F.tid + 512 * q, n2 = idx >> 4, ri = (idx >> 3) & 1, cc = idx & 7;
        *(LAS u32x4*)(Fst + (ri * 64 + n2) * 72 + 8 * cc) = *(const u32x4*)(FA + (size_t)idx * 8); }
    __syncthreads();
    const int k2 = 16 * (w & 3) + li;
#pragma unroll
    for (int ctl = 0; ctl < 2; ++ctl) { const int ct = 2 * (w >> 2) + ctl; f32x4 acc = (f32x4){0.f, 0.f, 0.f, 0.f};
#pragma unroll
        for (int ks = 0; ks < 4; ++ks) acc = mfma16(frag_tr(Fst, 72, 32 * ks, 16 * ct, li, gq), frag_lds(CSb, 136, 16 * (w & 3), 32 * ks, li, gq), acc);
        *(u32x2*)(MIX + (size_t)(b * SEQ + 64 * k2 + k1) * D + g * 64 + 16 * ct + 4 * gq) = pack4(acc * FSCALE512); }
}
__device__ __forceinline__ void fctx_unit(const Frame& F, int b, int g) {
    LAS bf16_t* CSt = (LAS bf16_t*)(F.lds + FO_CST); LAS bf16_t* Z2 = (LAS bf16_t*)(F.lds + FO_Z2);
    LAS bf16_t* TAB = (LAS bf16_t*)(F.lds + FO_TAB);
    const bf16_t* Pp = (const bf16_t*)(F.ws + WS_BUFB); bf16_t* MIX = (bf16_t*)(F.ws + WS_BUFA);
    const int li = F.lane & 15, gq = F.lane >> 4, w = F.wave;
    __syncthreads();
    if (F.tid < 256) { TAB[F.tid] = (bf16_t)(pk2(cospif(F.tid / 128.f), 0.f) & 0xffff); TAB[256 + F.tid] = (bf16_t)(pk2(-sinpif(F.tid / 128.f), 0.f) & 0xffff); }
    {
        bf16x8 cfr[2];
#pragma unroll
        for (int ks = 0; ks < 2; ++ks) cfr[ks] = frag_lds(CSt, 72, 16 * w, 32 * ks, li, gq);
#pragma unroll 4
        for (int nt = 0; nt < 16; ++nt) { const int n = 16 * nt + li; const bf16_t* up = Pp + (size_t)(NLAT + b * CTX + n) * PW + PF + g * 64;
            f32x4 acc = (f32x4){0.f, 0.f, 0.f, 0.f};
#pragma unroll
            for (int ks = 0; ks < 2; ++ks) acc = mfma16(cfr[ks], *(const bf16x8*)(up + 32 * ks + 8 * gq), acc);
            const int cp = 16 * w + 4 * gq;
            *(LAS u32x2*)(Z2 + ((cp < 64 ? 0 : 256) + n) * 72 + (cp & 63)) = pack4(acc); }
    }
    __syncthreads();
    f32x4 acc[2][4];
#pragma unroll
    for (int a = 0; a < 2; ++a)
#pragma unroll
        for (int ct = 0; ct < 4; ++ct) acc[a][ct] = (f32x4){0.f, 0.f, 0.f, 0.f};
#pragma unroll 1
    for (int ks = 0; ks < 16; ++ks) {
        bf16x8 zf[4];
#pragma unroll
        for (int ct = 0; ct < 4; ++ct) zf[ct] = frag_tr(Z2, 72, 32 * ks, 16 * ct, li, gq);
#pragma unroll
        for (int a = 0; a < 2; ++a) { const int k = 16 * (2 * w + a) + li; bf16x8 df;
#pragma unroll
            for (int j = 0; j < 8; ++j) { const int kk = 32 * ks + 8 * gq + j; df[j] = (short)TAB[(kk < 256 ? 0 : 256) + ((k * (kk & 255)) & 255)]; }
#pragma unroll
            for (int ct = 0; ct < 4; ++ct) acc[a][ct] = mfma16(zf[ct], df, acc[a][ct]); }
    }
#pragma unroll
    for (int a = 0; a < 2; ++a) { const int k = 16 * (2 * w + a) + li;
#pragma unroll
        for (int ct = 0; ct < 4; ++ct) *(u32x2*)(MIX + (size_t)(NLAT + b * CTX + k) * D + g * 64 + 16 * ct + 4 * gq) = pack4(acc[a][ct] * FSCALE128); }
}
__global__ void __launch_bounds__(NTHR, 2) hybrid_fwd(Params P) {
    extern __shared__ __attribute__((aligned(16))) unsigned char lds_raw[];
    Frame F;
    F.lds = (LAS unsigned char*)lds_raw;
    F.tid = threadIdx.x; F.lane = F.tid & 63; F.wave = __builtin_amdgcn_readfirstlane(F.tid >> 6);
    F.G = gridDim.x; F.bid = blockIdx.x;
    F.out = P.out; F.ws = P.ws;
    volatile LAS unsigned* MISC = (volatile LAS unsigned*)(F.lds + MISC_OFF);
    if (F.tid < 16) MISC[F.tid] = 0u;
    __syncthreads();
    XcdBarrier bar = xcd_barrier_post((unsigned*)(F.ws + WS_CTL), MISC);
#define PHASE_FENCE() do { asm volatile("" : "+v"(F.tid)); F.lane = F.tid & 63; F.wave = __builtin_amdgcn_readfirstlane(F.tid >> 6); \
        asm volatile("" : "+s"(F.ws), "+s"(F.out), "+s"(F.bid), "+s"(F.G)); } while (0)
#define GRID_BAR() do { xcd_barrier(bar); PHASE_FENCE(); } while (0)
#if defined(DBG_REP_K)
#define REPS(k, lay) (((k) == DBG_REP_K && (lay) == DBG_REP_L) ? 2 : 1)
#else
#define REPS(k, lay) 1
#endif

    for (int rep = 0; rep < REPS(0, 0); ++rep) { p0_prologue(F); GRID_BAR(); }
    for (int rep = 0; rep < REPS(1, 0); ++rep) { e1_phase(F); GRID_BAR(); }

#pragma unroll 1
    for (int l = 0; l < 2; ++l) {
        const bool first = (l == 0);
        PHASE_FENCE();
        for (int rep = 0; rep < REPS(2, l); ++rep) {
        {
            pg8::DenseProb pb{(const bf16_t*)(F.ws + WS_BUFA), (const bf16_t*)(F.ws + WS_WIN) + (size_t)l * PW * D, nullptr, D};
            pg8::GridOrder S; S.init(NT / 256, PW / 256, F.G, F.bid);
            pg8::EpiBf16 E{(bf16_t*)(F.ws + WS_BUFB), PW};
            pg8::gemm_phase(F.lds, F.tid, pb, S, E);
        }
        GRID_BAR();
        }
        for (int rep = 0; rep < REPS(3, l); ++rep) {
        {
            const int nAttL = NB * 32 * 2, nAttC = first ? NB * 2 * 2 : 0, nS1 = NB * NCH * 2, nFA = NB * 4 * 32;
            const int total = nAttL + nAttC + nS1 + nFA;
            bool fa_ready = false;
            for (int u = F.bid; u < total; u += F.G) {
                PHASE_FENCE();
                int v = u;
                if (v < nAttL) { const int b = v >> 6, nb = (v >> 1) & 31, kvh = v & 1; attn_unit(F, l, b, nb, kvh, false); continue; } v -= nAttL;
                if (v < nAttC) { const int b = v >> 2, nb = (v >> 1) & 1, kvh = v & 1; attn_unit(F, l, b, nb, kvh, true); continue; } v -= nAttC;
                if (v < nS1) { const int g = v & 1, c = (v >> 1) % NCH, b = (v >> 1) / NCH; s1_unit(F, l, b, c, g); continue; } v -= nS1;
                if (!fa_ready) { fourier_consts_a(F); fa_ready = true; }
                { const int pr = v & 31, g = (v >> 5) & 3, b = v >> 7; fa_unit(F, b, g, pr); }
            }
        }
        GRID_BAR();
        }
        s2_phase(F);
        GRID_BAR();
        for (int rep = 0; rep < REPS(5, l); ++rep) {
        {
            const int c0 = first ? 0 : 2;
            const int nS3 = NB * (NCH - c0), nFC = first ? NB * 4 : 0, nFB = NB * 4 * 64;
            const int total = nS3 + nFC + nFB;
            bool fa_ready = false, fb_ready = false;
            for (int u = F.bid; u < total; u += F.G) {
                PHASE_FENCE();
                int v = u;
                if (v < nS3) { const int c = c0 + v % (NCH - c0), b = v / (NCH - c0); s3_unit(F, l, b, c); continue; } v -= nS3;
                if (v < nFC) { if (!fa_ready) { fourier_consts_a(F); fa_ready = true; } fctx_unit(F, v >> 2, v & 3); fb_ready = false; continue; } v -= nFC;
                if (!fb_ready) { fourier_consts_b(F); fb_ready = true; }
                { const int k1 = v & 63, g = (v >> 6) & 3, b = v >> 8; fb_unit(F, b, g, k1); }
            }
            __syncthreads();
        }
        GRID_BAR();
        }
        for (int rep = 0; rep < REPS(6, l); ++rep) {
        {
            const int rows = first ? NT : NLAT;
            pg8::DenseProb pb{(const bf16_t*)(F.ws + WS_BUFA), (const bf16_t*)(F.ws + WS_WOUT) + (size_t)l * D * D, nullptr, D};
            pg8::GridOrder S; S.init(rows / 256, D / 256, F.G, F.bid);
            pg8::EpiBf16 E{(bf16_t*)(F.ws + WS_BUFB), D};
            pg8::gemm_phase(F.lds, F.tid, pb, S, E);
        }
        GRID_BAR();
        }
        for (int rep = 0; rep < REPS(7, l); ++rep) { e3_phase(F, l); GRID_BAR(); }
#if defined(DBG_STOP)
        if (DBG_STOP == 1 + 2 * l) return;
#endif
        for (int rep = 0; rep < REPS(8, l); ++rep) { topk_phase(F, l); GRID_BAR(); }
#pragma unroll 1
        for (int grp = 0; grp < 2; ++grp) {
            pg8::MoeMap mp{8, grp * 8};
            const int nMv = first ? 8 * 34 : 8 * 32;
            for (int rep = 0; rep < REPS(9, l); ++rep) {
            {
                pg8::GuProb pb{(const bf16_t*)(F.ws + WS_BUFA), (const bf16_t*)(F.ws + WS_WGU), (const int*)(F.ws + WS_ROWIDX), D, mp};
                pg8::GridOrder S; S.init(nMv, 2 * FF / 256, F.G, F.bid);
                pg8::EpiGU E{(bf16_t*)(F.ws + WS_BUFB), mp};
                pg8::gemm_phase(F.lds, F.tid, pb, S, E);
            }
            GRID_BAR();
            }
            for (int rep = 0; rep < REPS(10, l); ++rep) {
            {
                pg8::DownProb pb{(const bf16_t*)(F.ws + WS_BUFB), (const bf16_t*)(F.ws + WS_WD), nullptr, FF, mp};
                pg8::GridOrder S; S.init(nMv, D / 256, F.G, F.bid);
                pg8::EpiDown E{(bf16_t*)(F.ws + WS_BUFC), (const float*)(F.ws + WS_GATE), mp};
                pg8::gemm_phase(F.lds, F.tid, pb, S, E);
            }
            GRID_BAR();
            }
        }
        e5_phase(F, l);
        if (first) { __syncthreads(); convert_experts(F, 1); }
        GRID_BAR();
#if defined(DBG_STOP)
        if (DBG_STOP == 2 + 2 * l) return;
#endif
    }
}

extern "C" void kernel_launch(void* const* d_in, const int* in_sizes, int n_in, void* d_out, int out_size, void* d_ws, size_t ws_size, hipStream_t stream) {
    static int grid = 0;
    if (grid == 0) {
        if (n_in != 23 || out_size != NLAT * D || ws_size < WS_END) { fprintf(stderr, "kernel_launch: unexpected problem (n_in %d out %d ws %zu need %zu)\n", n_in, out_size, ws_size, (size_t)WS_END); grid = -1; return; }
        int dev = 0, cus = 0, per_cu = 0;
        if (hipGetDevice(&dev) != hipSuccess || hipDeviceGetAttribute(&cus, hipDeviceAttributeMultiprocessorCount, dev) != hipSuccess) { grid = -1; return; }
        if (hipFuncSetAttribute((const void*)hybrid_fwd, hipFuncAttributeMaxDynamicSharedMemorySize, LDS_BYTES) != hipSuccess) { fprintf(stderr, "kernel_launch: hipFuncSetAttribute failed\n"); grid = -1; return; }
        if (hipOccupancyMaxActiveBlocksPerMultiprocessor(&per_cu, (const void*)hybrid_fwd, NTHR, LDS_BYTES) != hipSuccess || per_cu < 1) { fprintf(stderr, "kernel_launch: occupancy query says %d\n", per_cu); (void)hipGetLastError(); grid = -1; return; }
        grid = cus;
    }
    if (grid < 0) return;
    (void)in_sizes;
    hipMemsetAsync((char*)d_ws + WS_CTL, 0, 65536, stream);
    Params p{};
    for (int i = 0; i < 23; ++i) p.in[i] = (const float*)d_in[i];
    p.out = (float*)d_out; p.ws = (unsigned char*)d_ws;
    hipLaunchKernelGGL(hybrid_fwd, dim3(grid), dim3(NTHR), LDS_BYTES, stream, p);
}
```

```cpp
#include <hip/hip_runtime.h>
#include <cstdio>
#include <cstdint>

#define LAS __attribute__((address_space(3)))
typedef unsigned short bf16_t;
typedef short bf16x8 __attribute__((ext_vector_type(8)));
typedef short bf16x4 __attribute__((ext_vector_type(4)));
typedef float f32x4 __attribute__((ext_vector_type(4)));
typedef float f32x2 __attribute__((ext_vector_type(2)));
typedef unsigned u32x4 __attribute__((ext_vector_type(4)));
typedef unsigned u32x2 __attribute__((ext_vector_type(2)));
typedef __bf16 bf16v2_t __attribute__((ext_vector_type(2)));

constexpr int D = 1024, NB = 16, SEQ = 4096, CTX = 256, NLAT = NB * SEQ, NCTX = NB * CTX, NT = NLAT + NCTX;
constexpr int PW = 2304;
constexpr int PF = 0, PQ = 256, PK = 640, PV = 768, PZ = 896, PX = 1280, PDT = 2176, INW = 2188;
constexpr int FF = 2816, NE = 16, EROWS = 8704;
constexpr int NCH = 34;
constexpr float EPS = 1e-6f;
constexpr int NWAVES = 8, NTHR = 512;

constexpr size_t al4k(size_t x) { return (x + 4095) & ~(size_t)4095; }
constexpr size_t WS_CTL = 0;
constexpr size_t WS_MOD = al4k(WS_CTL + 65536);
constexpr size_t WS_ROPE = al4k(WS_MOD + (size_t)2 * 17 * 6144 * 4);
constexpr size_t WS_HCTX = al4k(WS_ROPE + 64 * 16 * 2 * 4);
constexpr size_t WS_WIN = al4k(WS_HCTX + (size_t)NCTX * D * 4);
constexpr size_t WS_WOUT = al4k(WS_WIN + (size_t)2 * PW * D * 2);
constexpr size_t WS_WGU = al4k(WS_WOUT + (size_t)2 * D * D * 2);
constexpr size_t WS_WD = al4k(WS_WGU + (size_t)NE * 2 * FF * D * 2);
constexpr size_t WS_AFF = al4k(WS_WD + (size_t)NE * D * FF * 2);
constexpr size_t WS_ROWIDX = al4k(WS_AFF + (size_t)NT * 16 * 4);
constexpr size_t WS_GATE = al4k(WS_ROWIDX + (size_t)NE * EROWS * 4);
constexpr size_t WS_SLOT = al4k(WS_GATE + (size_t)NE * EROWS * 4);
constexpr size_t WS_DECAY = al4k(WS_SLOT + (size_t)NT * 16 * 2);
constexpr size_t WS_BUFA = al4k(WS_DECAY + (size_t)NB * NCH * 12 * 4);
constexpr size_t WS_BUFB = al4k(WS_BUFA + (size_t)NT * D * 2);
constexpr size_t WS_BUFC = al4k(WS_BUFB + (size_t)8 * EROWS * FF * 2);
constexpr size_t BC_XC = 0;
constexpr size_t BC_ST = al4k(BC_XC + (size_t)NT * 896 * 2);
constexpr size_t BC_FA = al4k(BC_ST + (size_t)NB * NCH * 12 * 8192 * 2);
constexpr size_t BC_END = al4k(BC_FA + (size_t)NB * 4 * 64 * 64 * 128 * 2);
static_assert(BC_END >= (size_t)NE * EROWS * D * 2, "y must fit the mixer-temporary region");
constexpr size_t WS_ASORT = WS_BUFC + BC_END;
constexpr size_t WS_END = al4k(WS_ASORT + (size_t)NE * EROWS * D);

constexpr int LDS_BYTES = 155648;
constexpr int MISC_OFF = 151552;

struct Params { const float* in[23]; float* out; unsigned char* ws; };

__device__ __forceinline__ float bf2f(bf16_t v) { return __uint_as_float((unsigned)v << 16); }
__device__ __forceinline__ unsigned pk2(float lo, float hi) { f32x2 v = {lo, hi}; bf16v2_t b = __builtin_convertvector(v, bf16v2_t); return __builtin_bit_cast(unsigned, b); }
__device__ __forceinline__ float lo2f(unsigned w) { return __uint_as_float(w << 16); }
__device__ __forceinline__ float hi2f(unsigned w) { return __uint_as_float(w & 0xffff0000u); }
__device__ __forceinline__ float wave_sum(float v) {
#pragma unroll
    for (int o = 1; o < 64; o <<= 1) v += __shfl_xor(v, o);
    return v;
}
__device__ __forceinline__ float siluf(float x) { return x / (1.f + __expf(-x)); }
__device__ __forceinline__ float softplusf(float x) { return fmaxf(x, 0.f) + log1pf(__expf(-fabsf(x))); }
__device__ __forceinline__ f32x4 mfma16(bf16x8 a, bf16x8 b, f32x4 c) { return __builtin_amdgcn_mfma_f32_16x16x32_bf16(a, b, c, 0, 0, 0); }
__device__ __forceinline__ bf16x8 frag_lds(const LAS bf16_t* base, int stride, int r0, int k0, int li, int gq) {
    return *(const LAS bf16x8*)(base + (r0 + li) * stride + k0 + 8 * gq);
}
__device__ __forceinline__ bf16x8 frag_glb(const bf16_t* base, size_t stride, int r0, int k0, int li, int gq) {
    return *(const bf16x8*)(base + (size_t)(r0 + li) * stride + k0 + 8 * gq);
}
__device__ __forceinline__ bf16x8 frag_tr(const LAS bf16_t* S, int stride, int k0, int n0, int li, int gq) {
    const LAS bf16_t* p = S + (k0 + 8 * gq + (li >> 2)) * stride + n0 + 4 * (li & 3);
    bf16x4 a = __builtin_amdgcn_ds_read_tr16_b64_v4i16((LAS bf16x4*)p);
    bf16x4 b = __builtin_amdgcn_ds_read_tr16_b64_v4i16((LAS bf16x4*)(p + 4 * stride));
    return (bf16x8){a[0], a[1], a[2], a[3], b[0], b[1], b[2], b[3]};
}
__device__ __forceinline__ bf16x8 frag_tr_split(const LAS bf16_t* S, int stride, int k0, int n0, int li, int gq) {
    const LAS bf16_t* p = S + (k0 + 4 * gq + (li >> 2)) * stride + n0 + 4 * (li & 3);
    bf16x4 a = __builtin_amdgcn_ds_read_tr16_b64_v4i16((LAS bf16x4*)p);
    bf16x4 b = __builtin_amdgcn_ds_read_tr16_b64_v4i16((LAS bf16x4*)(p + 16 * stride));
    return (bf16x8){a[0], a[1], a[2], a[3], b[0], b[1], b[2], b[3]};
}
__device__ __forceinline__ u32x2 pack4(f32x4 v) { u32x2 r; r.x = pk2(v[0], v[1]); r.y = pk2(v[2], v[3]); return r; }
#define LDS_FENCE() asm volatile("s_waitcnt lgkmcnt(0)" ::: "memory")

#define XB_TMO      128
#define XB_XCNT(j)  (256  + 64 * (j))
#define XB_XSUB(j)  (1280 + 64 * (j))
#define XB_XGEN(j)  (2304 + 64 * (j))
#define XB_TOP      3328
#define XB_TOPGEN   3392
#define XCD_BAR_WORDS 3456
#define XB_SPIN_CAP (1u << 22)
__device__ __forceinline__ unsigned xb_ld(unsigned* p)              { return __hip_atomic_load(p, __ATOMIC_RELAXED, __HIP_MEMORY_SCOPE_AGENT); }
__device__ __forceinline__ unsigned xb_add(unsigned* p, unsigned v) { return __hip_atomic_fetch_add(p, v, __ATOMIC_RELAXED, __HIP_MEMORY_SCOPE_AGENT); }
__device__ __forceinline__ unsigned xb_xcc_id() { return (unsigned)__builtin_amdgcn_s_getreg((3 << 11) | 20) & 0xFu; }
#define XB_SPIN(cond, bar) do { unsigned _sp = 0; while (cond) { __builtin_amdgcn_s_sleep(1); \
    if ((++_sp & 255u) == 0u) { if (xb_ld(&(bar)[XB_TMO])) break; if (_sp > XB_SPIN_CAP) { atomicAdd(&(bar)[XB_TMO], 1u); break; } } } } while (0)
struct XcdBarrier { unsigned* bar; unsigned x; volatile LAS unsigned* st; };
__device__ __forceinline__ XcdBarrier xcd_barrier_post(unsigned* bar, volatile LAS unsigned* st) {
    XcdBarrier b; b.bar = bar; b.x = xb_xcc_id(); b.st = st;
    if (threadIdx.x == 0) (void)xb_add(&bar[XB_XCNT(b.x)], 1u);
    return b;
}
__device__ __forceinline__ void xcd_barrier_complete(unsigned* bar, unsigned x, unsigned& nloc, unsigned& nx) {
    const unsigned G = gridDim.x * gridDim.y * gridDim.z;
    unsigned sum, cnt, mine, sp = 0u;
    for (;;) {
        sum = 0u; cnt = 0u; mine = 0u;
#pragma unroll
        for (unsigned j = 0; j < 16; ++j) { const unsigned c = xb_ld(&bar[XB_XCNT(j)]); sum += c; cnt += (c > 0u) ? 1u : 0u; mine = (j == x) ? c : mine; }
        if (sum == G) break;
        __builtin_amdgcn_s_sleep(1);
        if ((++sp & 255u) == 0u) { if (xb_ld(&bar[XB_TMO])) break; if (sp > XB_SPIN_CAP) { atomicAdd(&bar[XB_TMO], 1u); break; } }
    }
    nloc = mine > 0u ? mine : 1u; nx = cnt > 0u ? cnt : 1u;
}
__device__ __forceinline__ void xcd_barrier(const XcdBarrier& b) {
    asm volatile("s_waitcnt vmcnt(0)" ::: "memory");
    __syncthreads();
    if (threadIdx.x == 0) {
        unsigned* bar = b.bar;
        __builtin_amdgcn_s_waitcnt(0);
        unsigned nloc = b.st[0], nx = b.st[1];
        if (nloc == 0u) { xcd_barrier_complete(bar, b.x, nloc, nx); b.st[0] = nloc; b.st[1] = nx; }
        const unsigned old = xb_add(&bar[XB_XSUB(b.x)], 1u);
        const unsigned gen = old / nloc;
        if (old + 1u == (gen + 1u) * nloc) {
            __builtin_amdgcn_fence(__ATOMIC_RELEASE, "agent");
            asm volatile("s_waitcnt vmcnt(0)" ::: "memory");
            const unsigned og = xb_add(&bar[XB_TOP], 1u);
            const unsigned tg = og / nx;
            if (og + 1u == (tg + 1u) * nx) xb_add(&bar[XB_TOPGEN], 1u);
            else XB_SPIN(xb_ld(&bar[XB_TOPGEN]) == tg, bar);
            __builtin_amdgcn_fence(__ATOMIC_ACQUIRE, "agent");
            xb_add(&bar[XB_XGEN(b.x)], 1u);
            asm volatile("s_waitcnt vmcnt(0)" ::: "memory");
        } else {
            XB_SPIN(xb_ld(&bar[XB_XGEN(b.x)]) == gen, bar);
            __builtin_amdgcn_fence(__ATOMIC_ACQUIRE, "agent");
            asm volatile("s_waitcnt vmcnt(0)" ::: "memory");
        }
    }
    __syncthreads();
}
namespace pg8 {
constexpr int BM = 256, BK = 64, HALF = 128, HTB = HALF * BK * 2, STAGE_BYTES = 8 * HTB, NXCD = 8, WGM = 8;
__host__ __device__ __forceinline__ int lds_byte(int r, int c) { const int st = (r >> 4) * 2 + (c >> 5), rr = r & 15, cc = c & 31, ob = rr * 64 + cc * 2; return st * 1024 + (ob ^ (((ob >> 9) & 1) << 5)); }
__host__ __device__ __forceinline__ void stage_rc(int b, int& R, int& C) { const int st = b / 1024, sb = b % 1024, swz = sb ^ (((sb >> 9) & 1) << 5); R = (st >> 1) * 16 + swz / 64; C = (st & 1) * 32 + (swz % 64) / 2; }
__host__ __device__ __forceinline__ int perm32(int rho) { const int n = rho >> 4, i = rho & 15; return 8 * (i >> 2) + 4 * n + (i & 3); }

struct Unit { int pm, pn; };
typedef int i32x4 __attribute__((ext_vector_type(4)));
typedef int i32x8 __attribute__((ext_vector_type(8)));
__device__ __forceinline__ bf16x8 lo8(i32x8 a) { return __builtin_bit_cast(bf16x8, (i32x4)__builtin_shufflevector(a, a, 0, 1, 2, 3)); }
__device__ __forceinline__ bf16x8 hi8(i32x8 a) { return __builtin_bit_cast(bf16x8, (i32x4)__builtin_shufflevector(a, a, 4, 5, 6, 7)); }
struct GridOrder {
    int nM, nN, nwg, G, c;
    __device__ __forceinline__ void init(int nM_, int nN_, int G_, int c_) { nM = nM_; nN = nN_; nwg = nM * nN; G = G_; c = c_; }
    __device__ __forceinline__ bool next(int i, Unit& u) const {
        const long L = (long)i * G + c; if (L >= nwg) return false;
        int wgid = (int)L; { const int q = nwg / NXCD, r = nwg % NXCD, xcd = wgid % NXCD, off = wgid / NXCD; wgid = (xcd < r ? xcd * (q + 1) : r * (q + 1) + (xcd - r) * q) + off; }
        const int nig = WGM * nN, gid = wgid / nig, fm = gid * WGM, gsz = (nM - fm) < WGM ? (nM - fm) : WGM;
        u.pm = fm + ((wgid % nig) % gsz); u.pn = (wgid % nig) / gsz; return true;
    }
};

template <class Prob, class Epi>
__device__ __forceinline__ void gemm_phase(LAS unsigned char* lds, const int tid, const Prob& Pb, const GridOrder& S, const Epi& E) {
    const int wid = __builtin_amdgcn_readfirstlane(tid >> 6), lane = tid & 63, wr = wid >> 2, wc = wid & 3, fr = lane & 15, fq = lane >> 4;
    constexpr int ES = Prob::ES;
    const int K = Pb.K, nt = K * ES / 128;
    unsigned voffA[2], voffB[2];
#pragma unroll
    for (int i = 0; i < 2; ++i) { int R, C; stage_rc(tid * 16 + i * 8192, R, C); const int Rb = Epi::PERM ? ((R & ~31) + perm32(R & 31)) : R;
        voffA[i] = (unsigned)(R * K * ES + C * 2); voffB[i] = (unsigned)(Rb * K * ES + C * 2); }
    const size_t kstep = (size_t)(BK * 2);
    const size_t hstep = (size_t)HALF * K * ES;
    const unsigned ldsw = (unsigned)wid * 1024u;
    const int aoff = lds_byte(wr * 64 + fr, fq * 8), boff = lds_byte(wc * 32 + fr, fq * 8);
#define PG8_SA(b, h) (((b) * 2 + (h)) * HTB)
#define PG8_SB(b, h) ((4 + (b) * 2 + (h)) * HTB)
#define PG8_STAGE(bufoff, gbase, voff) do { _Pragma("unroll") for (int _i = 0; _i < 2; ++_i) \
        __builtin_amdgcn_global_load_lds((const unsigned*)((const char*)(gbase) + (voff)[_i]), (LAS unsigned*)(lds + (bufoff) + ldsw + _i * 8192), 16, 0, 0); } while (0)
#define PG8_LDA(dst, b, h) do { _Pragma("unroll") for (int m = 0; m < 4; ++m) { const i32x4 _l0 = *(const LAS i32x4*)(lds + PG8_SA(b, h) + aoff + m * 2048), _l1 = *(const LAS i32x4*)(lds + PG8_SA(b, h) + aoff + m * 2048 + 1024); \
        dst[m] = __builtin_shufflevector(_l0, _l1, 0, 1, 2, 3, 4, 5, 6, 7); } } while (0)
#define PG8_LDB(dst, b, h) do { _Pragma("unroll") for (int n = 0; n < 2; ++n) { const i32x4 _l0 = *(const LAS i32x4*)(lds + PG8_SB(b, h) + boff + n * 2048), _l1 = *(const LAS i32x4*)(lds + PG8_SB(b, h) + boff + n * 2048 + 1024); \
        dst[n] = __builtin_shufflevector(_l0, _l1, 0, 1, 2, 3, 4, 5, 6, 7); } } while (0)
#define PG8_MMA(ai, bj, At, Bt) do { __builtin_amdgcn_s_setprio(1); _Pragma("unroll") for (int m = 0; m < 4; ++m) _Pragma("unroll") for (int n = 0; n < 2; ++n) { \
        if (ES == 2) { acc[ai][bj][m][n] = __builtin_amdgcn_mfma_f32_16x16x32_bf16(lo8(Bt[n]), lo8(At[m]), acc[ai][bj][m][n], 0, 0, 0); \
                       acc[ai][bj][m][n] = __builtin_amdgcn_mfma_f32_16x16x32_bf16(hi8(Bt[n]), hi8(At[m]), acc[ai][bj][m][n], 0, 0, 0); } \
        else asm volatile("v_mfma_scale_f32_16x16x128_f8f6f4 %0, %1, %2, %0, %3, %3 op_sel_hi:[0,0,0]" : "+v"(acc[ai][bj][m][n]) : "v"(Bt[n]), "v"(At[m]), "v"(sc127)); } \
        __builtin_amdgcn_s_setprio(0); } while (0)
#define PG8_WAIT_V(n) asm volatile("s_waitcnt vmcnt(" #n ")" ::: "memory")
#define PG8_WAIT_L(n) asm volatile("s_waitcnt lgkmcnt(" #n ")" ::: "memory")
#define PG8_BAR __builtin_amdgcn_s_barrier()
#define PG8_SCHED __builtin_amdgcn_sched_barrier(0)
    Unit cur, nxt; int ui = 0;
    if (!S.next(0, cur)) return;
    int sc127 = 127; asm volatile("" : "+v"(sc127));
    f32x4 acc[2][2][4][2];
#pragma unroll
    for (int a = 0; a < 2; ++a)
#pragma unroll
        for (int b = 0; b < 2; ++b)
#pragma unroll
            for (int m = 0; m < 4; ++m)
#pragma unroll
                for (int n = 0; n < 2; ++n) acc[a][b][m][n] = (f32x4){0.f, 0.f, 0.f, 0.f};
    i32x8 At[4], B0[2], B1[2];
    const char* cA = (const char*)Pb.Abase + (size_t)Pb.a_row0(cur) * K * ES; const char* cB = (const char*)Pb.Btbase + (size_t)Pb.b_row0(cur) * K * ES;
    PG8_STAGE(PG8_SB(0, 0), cB, voffB); PG8_STAGE(PG8_SA(0, 0), cA, voffA); PG8_STAGE(PG8_SB(0, 1), cB + hstep, voffB); PG8_STAGE(PG8_SA(0, 1), cA + hstep, voffA);
    if (wr == 1) PG8_BAR;
    PG8_WAIT_V(4); PG8_BAR;
    PG8_STAGE(PG8_SB(1, 0), cB + kstep, voffB); PG8_STAGE(PG8_SA(1, 0), cA + kstep, voffA); PG8_STAGE(PG8_SB(1, 1), cB + hstep + kstep, voffB);
    PG8_WAIT_V(6); PG8_BAR;
    for (;;) {
        const bool has_next = S.next(ui + 1, nxt);
        const char* nA = has_next ? (const char*)Pb.Abase + (size_t)Pb.a_row0(nxt) * K * ES : cA; const char* nB = has_next ? (const char*)Pb.Btbase + (size_t)Pb.b_row0(nxt) * K * ES : cB;
        for (int t = 0; t < nt; t += 2) {
            const bool last = (t == nt - 2);
            const char* a1 = cA + (size_t)(t + 1) * kstep;
            const char* a2 = last ? nA : cA + (size_t)(t + 2) * kstep; const char* b2 = last ? nB : cB + (size_t)(t + 2) * kstep;
            const char* a3 = a2 + kstep; const char* b3 = b2 + kstep;
            PG8_LDB(B0, 0, 0); PG8_SCHED; PG8_LDA(At, 0, 0); PG8_STAGE(PG8_SA(1, 1), a1 + hstep, voffA);
            PG8_WAIT_L(8); PG8_BAR; PG8_WAIT_L(0); PG8_MMA(0, 0, At, B0); PG8_BAR; PG8_SCHED;
            PG8_LDB(B1, 0, 1); PG8_STAGE(PG8_SB(0, 0), b2, voffB);
            PG8_BAR; PG8_WAIT_L(0); PG8_MMA(0, 1, At, B1); PG8_BAR;
            PG8_LDA(At, 0, 1); PG8_STAGE(PG8_SA(0, 0), a2, voffA);
            PG8_BAR; PG8_WAIT_L(0); PG8_MMA(1, 0, At, B0); PG8_BAR; PG8_SCHED;
            PG8_STAGE(PG8_SB(0, 1), b2 + hstep, voffB);
            PG8_WAIT_V(6); PG8_BAR; PG8_MMA(1, 1, At, B1); PG8_BAR;
            PG8_LDB(B0, 1, 0); PG8_SCHED; PG8_LDA(At, 1, 0); PG8_STAGE(PG8_SA(0, 1), a2 + hstep, voffA);
            PG8_WAIT_L(8); PG8_BAR; PG8_WAIT_L(0); PG8_MMA(0, 0, At, B0); PG8_BAR; PG8_SCHED;
            PG8_LDB(B1, 1, 1); PG8_STAGE(PG8_SB(1, 0), b3, voffB);
            PG8_BAR; PG8_WAIT_L(0); PG8_MMA(0, 1, At, B1); PG8_BAR;
            PG8_LDA(At, 1, 1); PG8_STAGE(PG8_SA(1, 0), a3, voffA);
            PG8_BAR; PG8_WAIT_L(0); PG8_MMA(1, 0, At, B0); PG8_BAR; PG8_SCHED;
            PG8_STAGE(PG8_SB(1, 1), b3 + hstep, voffB);
            PG8_WAIT_V(6); PG8_BAR; PG8_MMA(1, 1, At, B1); PG8_BAR;
        }
        if (ES == 1) asm volatile("s_nop 15\n\ts_nop 15" ::: "memory");
        E(acc, cur, wr, wc, fr, fq);
        if (!has_next) break;
#pragma unroll
        for (int a = 0; a < 2; ++a)
#pragma unroll
            for (int b = 0; b < 2; ++b)
#pragma unroll
                for (int m = 0; m < 4; ++m)
#pragma unroll
                    for (int n = 0; n < 2; ++n) acc[a][b][m][n] = (f32x4){0.f, 0.f, 0.f, 0.f};
        cur = nxt; cA = nA; cB = nB; ++ui;
    }
    PG8_WAIT_V(0);
    if (wr == 0) PG8_BAR;
    PG8_BAR;
#undef PG8_SA
#undef PG8_SB
#undef PG8_STAGE
#undef PG8_LDA
#undef PG8_LDB
#undef PG8_MMA
#undef PG8_WAIT_V
#undef PG8_WAIT_L
#undef PG8_BAR
#undef PG8_SCHED
}
__device__ __forceinline__ unsigned cvt_pk_bf16(float lo, float hi) { unsigned r; asm volatile("v_cvt_pk_bf16_f32 %0, %1, %2" : "=v"(r) : "v"(lo), "v"(hi)); return r; }

struct DenseProb {
    static constexpr bool GATHER = false; static constexpr int ES = 2;
    const bf16_t* Abase; const bf16_t* Btbase; const int* rowidx; int K;
    __device__ __forceinline__ int a_row0(const Unit& u) const { return u.pm * BM; }
    __device__ __forceinline__ int b_row0(const Unit& u) const { return u.pn * BM; }
};
struct EpiBf16 {
    static constexpr bool PERM = true;
    bf16_t* O; int ldc;
    __device__ __forceinline__ void operator()(const f32x4 (&acc)[2][2][4][2], const Unit& u, int wr, int wc, int fr, int fq) const {
        const int row0 = u.pm * BM + wr * 64 + fr, col0 = u.pn * BM + wc * 32 + 8 * fq;
#pragma unroll
        for (int ai = 0; ai < 2; ++ai)
#pragma unroll
            for (int m = 0; m < 4; ++m) { bf16_t* rowp = O + (size_t)(row0 + ai * HALF + m * 16) * ldc + col0;
#pragma unroll
                for (int bj = 0; bj < 2; ++bj) { const f32x4 v0 = acc[ai][bj][m][0], v1 = acc[ai][bj][m][1];
                    u32x4 w; w.x = cvt_pk_bf16(v0[0], v0[1]); w.y = cvt_pk_bf16(v0[2], v0[3]); w.z = cvt_pk_bf16(v1[0], v1[1]); w.w = cvt_pk_bf16(v1[2], v1[3]);
                    *(u32x4*)(rowp + bj * HALF) = w; } }
    }
};
struct MoeMap { int EG, e0;
    __device__ __forceinline__ void split(int pm, int& el, int& mt) const { if (pm < EG * 32) { el = pm >> 5; mt = pm & 31; } else { const int q = pm - EG * 32; el = q >> 1; mt = 32 + (q & 1); } }
};
__device__ __forceinline__ unsigned pk4_fp8(float a, float b, float c, float d) {
    a = fminf(fmaxf(a, -448.f), 448.f); b = fminf(fmaxf(b, -448.f), 448.f); c = fminf(fmaxf(c, -448.f), 448.f); d = fminf(fmaxf(d, -448.f), 448.f);
    int w = 0; w = __builtin_amdgcn_cvt_pk_fp8_f32(a, b, w, false); w = __builtin_amdgcn_cvt_pk_fp8_f32(c, d, w, true); return (unsigned)w; }
struct GuProb {
    static constexpr bool GATHER = false; static constexpr int ES = 1;
    const void* Abase; const void* Btbase; const int* rowidx; int K; MoeMap mp;
    __device__ __forceinline__ int a_row0(const Unit& u) const { int el, mt; mp.split(u.pm, el, mt); return (mp.e0 + el) * EROWS + mt * BM; }
    __device__ __forceinline__ int b_row0(const Unit& u) const { int el, mt; mp.split(u.pm, el, mt); return (mp.e0 + el) * (2 * FF) + u.pn * BM; }
};
struct EpiGU {
    static constexpr bool PERM = true;
    unsigned char* he; MoeMap mp;
    __device__ __forceinline__ void operator()(const f32x4 (&acc)[2][2][4][2], const Unit& u, int wr, int wc, int fr, int fq) const {
        int el, mt; mp.split(u.pm, el, mt);
        const int row0 = el * EROWS + mt * BM + wr * 64 + fr, col0 = u.pn * HALF + wc * 32 + 8 * fq;
#pragma unroll
        for (int ai = 0; ai < 2; ++ai)
#pragma unroll
            for (int m = 0; m < 4; ++m) { unsigned char* rowp = he + (size_t)(row0 + ai * HALF + m * 16) * FF + col0;
                float o[8];
#pragma unroll
                for (int n = 0; n < 2; ++n)
#pragma unroll
                    for (int j = 0; j < 4; ++j) { const float g = acc[ai][0][m][n][j] * (1.f / 128.f), up = acc[ai][1][m][n][j] * (1.f / 128.f); o[n * 4 + j] = g / (1.f + __expf(-g)) * up * 8.f; }
                u32x2 w; w.x = pk4_fp8(o[0], o[1], o[2], o[3]); w.y = pk4_fp8(o[4], o[5], o[6], o[7]);
                *(u32x2*)rowp = w; }
    }
};
struct DownProb {
    static constexpr bool GATHER = false; static constexpr int ES = 1;
    const void* Abase; const void* Btbase; const int* rowidx; int K; MoeMap mp;
    __device__ __forceinline__ int a_row0(const Unit& u) const { int el, mt; mp.split(u.pm, el, mt); return el * EROWS + mt * BM; }
    __device__ __forceinline__ int b_row0(const Unit& u) const { int el, mt; mp.split(u.pm, el, mt); return (mp.e0 + el) * D + u.pn * BM; }
};
struct EpiDown {
    static constexpr bool PERM = true;
    bf16_t* y; const float* gate; MoeMap mp;
    __device__ __forceinline__ void operator()(const f32x4 (&acc)[2][2][4][2], const Unit& u, int wr, int wc, int fr, int fq) const {
        int el, mt; mp.split(u.pm, el, mt);
        const int row0 = (mp.e0 + el) * EROWS + mt * BM + wr * 64 + fr, col0 = u.pn * BM + wc * 32 + 8 * fq;
#pragma unroll
        for (int ai = 0; ai < 2; ++ai)
#pragma unroll
            for (int m = 0; m < 4; ++m) { const int row = row0 + ai * HALF + m * 16; const float g = gate[row] * (1.f / 2048.f); bf16_t* rowp = y + (size_t)row * D + col0;
#pragma unroll
                for (int bj = 0; bj < 2; ++bj) { const f32x4 v0 = acc[ai][bj][m][0] * g, v1 = acc[ai][bj][m][1] * g;
                    u32x4 w; w.x = cvt_pk_bf16(v0[0], v0[1]); w.y = cvt_pk_bf16(v0[2], v0[3]); w.z = cvt_pk_bf16(v1[0], v1[1]); w.w = cvt_pk_bf16(v1[2], v1[3]);
                    *(u32x4*)(rowp + bj * HALF) = w; } }
    }
};
}
struct Frame {
    LAS unsigned char* lds;
    int tid, lane, wave, G, bid;
    float* out; unsigned char* ws;
};
__device__ __forceinline__ const float* INP(int i) {
    const __attribute__((address_space(4))) char* k = (const __attribute__((address_space(4))) char*)__builtin_amdgcn_kernarg_segment_ptr();
    asm volatile("" : "+s"(k));
    return *(const float* const __attribute__((address_space(4)))*)(k + 8 * i);
}
#define IN_X 0
#define IN_C 1
#define IN_CTX 2
#define IN_CCTX 3
#define IN_WADA 4
#define IN_BADA 5
#define IN_GMIXPRE 6
#define IN_GMIXPOST 7
#define IN_GFFNPRE 8
#define IN_GFFNPOST 9
#define IN_WIN 10
#define IN_CONVW 11
#define IN_CONVB 12
#define IN_DTBIAS 13
#define IN_ALOG 14
#define IN_DSKIP 15
#define IN_GSSD 16
#define IN_SINK 17
#define IN_WOUT 18
#define IN_WROUTER 19
#define IN_WGATE 20
#define IN_WUP 21
#define IN_WDOWN 22

__device__ __forceinline__ const float* mod_ptr(const Frame& F, int l, int row  , int part  ) {
    return (const float*)(F.ws + WS_MOD) + ((size_t)(l * 17 + row) * 6144 + part * 1024);
}
__device__ __forceinline__ int tok_modrow(int row) { return row < NLAT ? (row >> 12) : 16; }

template <class RowMap>
__device__ __forceinline__ void transpose_item(const float* W, int K, int N, bf16_t* WT, RowMap rm, LAS float* scr, int kb, int nb, int lane) {
    const int k0 = 64 * kb, n0 = 32 * nb;
    const int nn = n0 + (lane & 31);
#pragma unroll 8
    for (int i = 0; i < 32; ++i) { const int kk = 2 * i + (lane >> 5); scr[kk * 33 + (lane & 31)] = (nn < N) ? W[(size_t)(k0 + kk) * N + nn] : 0.f; }
    LDS_FENCE();
    const int c = lane & 7;
#pragma unroll
    for (int j = 0; j < 4; ++j) { const int n = (lane >> 3) + 8 * j; const LAS float* s = scr + (8 * c) * 33 + n;
        u32x4 o; o.x = pk2(s[0 * 33], s[1 * 33]); o.y = pk2(s[2 * 33], s[3 * 33]); o.z = pk2(s[4 * 33], s[5 * 33]); o.w = pk2(s[6 * 33], s[7 * 33]);
        *(u32x4*)(WT + (size_t)rm(n0 + n) * K + k0 + 8 * c) = o; }
    LDS_FENCE();
}
struct RmId { __device__ __forceinline__ int operator()(int n) const { return n; } };
struct RmGU { int s; __device__ __forceinline__ int operator()(int n) const { return 256 * (n >> 7) + 128 * s + (n & 127); } };
template <class RowMap>
__device__ __forceinline__ void transpose_item_fp8(const float* W, int K, int N, unsigned char* WT, RowMap rm, float scale, LAS float* scr, int kb, int nb, int lane) {
    const int k0 = 64 * kb, n0 = 32 * nb;
#pragma unroll 8
    for (int i = 0; i < 32; ++i) { const int kk = 2 * i + (lane >> 5); scr[kk * 33 + (lane & 31)] = W[(size_t)(k0 + kk) * N + n0 + (lane & 31)] * scale; }
    LDS_FENCE();
    const int c = lane & 7;
#pragma unroll
    for (int j = 0; j < 4; ++j) { const int n = (lane >> 3) + 8 * j; const LAS float* s = scr + (8 * c) * 33 + n;
        u32x2 o; o.x = pg8::pk4_fp8(s[0 * 33], s[1 * 33], s[2 * 33], s[3 * 33]); o.y = pg8::pk4_fp8(s[4 * 33], s[5 * 33], s[6 * 33], s[7 * 33]);
        *(u32x2*)(WT + (size_t)rm(n0 + n) * K + k0 + 8 * c) = o; }
    LDS_FENCE();
}

__device__ __forceinline__ void convert_experts(const Frame& F, int l) {
    LAS float* scr = (LAS float*)(F.lds + F.wave * 16384);
    const int gw = F.bid * NWAVES + F.wave, NGW = F.G * NWAVES;
    constexpr int I_G = 16 * 88, I_D = 44 * 32;
    constexpr int PER_E = 2 * I_G + I_D;
    unsigned char* Wgu = F.ws + WS_WGU; unsigned char* Wd = F.ws + WS_WD;
    for (int it = gw; it < NE * PER_E; it += NGW) {
        const int e = it / PER_E; int r = it % PER_E;
        if (r < I_G) { transpose_item_fp8(INP(IN_WGATE) + (size_t)(l * NE + e) * D * FF, D, FF, Wgu + (size_t)e * 2 * FF * D, RmGU{0}, 128.f, scr, r / 88, r % 88, F.lane); continue; } r -= I_G;
        if (r < I_G) { transpose_item_fp8(INP(IN_WUP) + (size_t)(l * NE + e) * D * FF, D, FF, Wgu + (size_t)e * 2 * FF * D, RmGU{1}, 128.f, scr, r / 88, r % 88, F.lane); continue; } r -= I_G;
        transpose_item_fp8(INP(IN_WDOWN) + (size_t)(l * NE + e) * FF * D, FF, D, Wd + (size_t)e * D * FF, RmId{}, 256.f, scr, r / 32, r % 32, F.lane);
    }
}

__device__ __forceinline__ void p0_prologue(const Frame& F) {
    if (F.bid < 192) {
        LAS float* sc = (LAS float*)F.lds;
        LAS float* red = (LAS float*)(F.lds + 17 * 1024 * 4);
        for (int i = F.tid; i < 17 * 1024; i += NTHR) { const int r = i >> 10, k = i & 1023; const float v = r < 16 ? INP(IN_C)[r * 1024 + k] : INP(IN_CCTX)[k]; sc[i] = siluf(v); }
        __syncthreads();
        const int l = F.bid / 96, n0 = (F.bid % 96) * 64;
        const float* W = INP(IN_WADA) + (size_t)l * D * 6144 + n0 + F.lane;
        float acc[17];
#pragma unroll
        for (int r = 0; r < 17; ++r) acc[r] = 0.f;
        for (int k = F.wave; k < 1024; k += 8) { const float w = W[(size_t)k * 6144];
#pragma unroll
            for (int r = 0; r < 17; ++r) acc[r] += sc[r * 1024 + k] * w; }
#pragma unroll
        for (int r = 0; r < 17; ++r) red[(F.wave * 17 + r) * 64 + F.lane] = acc[r];
        __syncthreads();
        for (int i = F.tid; i < 17 * 64; i += NTHR) { const int r = i >> 6, c = i & 63; float s = 0.f;
#pragma unroll
            for (int w = 0; w < 8; ++w) s += red[(w * 17 + r) * 64 + c];
            ((float*)(F.ws + WS_MOD))[(size_t)(l * 17 + r) * 6144 + n0 + c] = s + INP(IN_BADA)[l * 6144 + n0 + c]; }
        __syncthreads();
    }
    if (F.bid == 255) {
        for (int i = F.tid; i < 1024; i += NTHR) { const int pos = i >> 4, f = i & 15; const float inv = powf(10000.f, -(float)f / 16.f); const float ang = (float)pos * inv;
            ((float*)(F.ws + WS_ROPE))[2 * i] = cosf(ang); ((float*)(F.ws + WS_ROPE))[2 * i + 1] = sinf(ang); }
    }
    {
        LAS float* scr = (LAS float*)(F.lds + F.wave * 16384);
        const int gw = F.bid * NWAVES + F.wave, NGW = F.G * NWAVES;
        constexpr int I_IN = 16 * 72, I_OUT = 16 * 32;
        for (int it = gw; it < 2 * (I_IN + I_OUT); it += NGW) {
            const int l = it / (I_IN + I_OUT); int r = it % (I_IN + I_OUT);
            if (r < I_IN) { transpose_item(INP(IN_WIN) + (size_t)l * D * INW, D, INW, (bf16_t*)(F.ws + WS_WIN) + (size_t)l * PW * D, RmId{}, scr, r / 72, r % 72, F.lane); continue; } r -= I_IN;
            transpose_item(INP(IN_WOUT) + (size_t)l * D * D, D, D, (bf16_t*)(F.ws + WS_WOUT) + (size_t)l * D * D, RmId{}, scr, r / 32, r % 32, F.lane);
        }
    }
    convert_experts(F, 0);
}

struct Row16 { f32x4 v[4]; };
__device__ __forceinline__ Row16 ld_row_f32(const float* p, int lane) { Row16 r; const f32x4* q = (const f32x4*)p + lane;
#pragma unroll
    for (int j = 0; j < 4; ++j) r.v[j] = q[64 * j];
    return r; }
__device__ __forceinline__ void st_row_f32(float* p, int lane, const Row16& r) { f32x4* q = (f32x4*)p + lane;
#pragma unroll
    for (int j = 0; j < 4; ++j) q[64 * j] = r.v[j]; }
__device__ __forceinline__ Row16 ld_row_bf16(const bf16_t* p, int lane) { Row16 r; const u32x2* q = (const u32x2*)p + lane;
#pragma unroll
    for (int j = 0; j < 4; ++j) { const u32x2 w = q[64 * j]; r.v[j] = (f32x4){lo2f(w.x), hi2f(w.x), lo2f(w.y), hi2f(w.y)}; }
    return r; }
__device__ __forceinline__ void st_row_bf16(bf16_t* p, int lane, const Row16& r) { u32x2* q = (u32x2*)p + lane;
#pragma unroll
    for (int j = 0; j < 4; ++j) { u32x2 w; w.x = pk2(r.v[j][0], r.v[j][1]); w.y = pk2(r.v[j][2], r.v[j][3]); q[64 * j] = w; } }
__device__ __forceinline__ float row_rstd(const Row16& r) { float s = 0.f;
#pragma unroll
    for (int j = 0; j < 4; ++j) s += (r.v[j][0] * r.v[j][0] + r.v[j][1] * r.v[j][1]) + (r.v[j][2] * r.v[j][2] + r.v[j][3] * r.v[j][3]);
    return rsqrtf(wave_sum(s) * (1.f / D) + EPS); }
__device__ __forceinline__ Row16 norm_mod(const Row16& h, const float* g, const float* sh, const float* sc, int lane) {
    const float rstd = row_rstd(h); const Row16 G = ld_row_f32(g, lane), SH = ld_row_f32(sh, lane), SC = ld_row_f32(sc, lane); Row16 u;
#pragma unroll
    for (int j = 0; j < 4; ++j) u.v[j] = (h.v[j] * rstd * G.v[j]) * (SC.v[j] + 1.f) + SH.v[j];
    return u; }

__device__ __forceinline__ void e1_phase(const Frame& F) {
    const int gw = F.bid * NWAVES + F.wave, NGW = F.G * NWAVES;
    bf16_t* U = (bf16_t*)(F.ws + WS_BUFA);
    for (int row = gw; row < NT; row += NGW) {
        const float* src = row < NLAT ? INP(IN_X) + (size_t)row * D : INP(IN_CTX) + (size_t)(row - NLAT) * D;
        const int mr = tok_modrow(row);
        const Row16 h = ld_row_f32(src, F.lane);
        const Row16 u = norm_mod(h, INP(IN_GMIXPRE), mod_ptr(F, 0, mr, 0), mod_ptr(F, 0, mr, 1), F.lane);
        st_row_bf16(U + (size_t)row * D, F.lane, u);
    }
}

__device__ __forceinline__ void e3_phase(const Frame& F, int l) {
    const int nrows = (l == 0) ? NT : NLAT;
    LAS float* wr = (LAS float*)F.lds;
    for (int i = F.tid; i < 1024 * 16; i += NTHR) wr[(i & 15) * 1024 + (i >> 4)] = INP(IN_WROUTER)[(size_t)l * D * 16 + i];
    __syncthreads();
    const int gw = F.bid * NWAVES + F.wave, NGW = F.G * NWAVES;
    const bf16_t* M = (const bf16_t*)(F.ws + WS_BUFB); unsigned char* U2 = F.ws + WS_BUFA; float* AFF = (float*)(F.ws + WS_AFF);
    for (int row = gw; row < nrows; row += NGW) {
        const float* hsrc; float* hdst;
        if (row < NLAT) { hsrc = (l == 0) ? INP(IN_X) + (size_t)row * D : F.out + (size_t)row * D; hdst = F.out + (size_t)row * D; }
        else { hsrc = INP(IN_CTX) + (size_t)(row - NLAT) * D; hdst = (float*)(F.ws + WS_HCTX) + (size_t)(row - NLAT) * D; }
        const int mr = tok_modrow(row);
        const Row16 m = ld_row_bf16(M + (size_t)row * D, F.lane);
        Row16 h = ld_row_f32(hsrc, F.lane);
        { const float rstd = row_rstd(m); const Row16 G = ld_row_f32(INP(IN_GMIXPOST) + l * D, F.lane), GT = ld_row_f32(mod_ptr(F, l, mr, 2), F.lane);
#pragma unroll
          for (int j = 0; j < 4; ++j) h.v[j] = h.v[j] + GT.v[j] * (m.v[j] * rstd * G.v[j]); }
        st_row_f32(hdst, F.lane, h);
        const Row16 u = norm_mod(h, INP(IN_GFFNPRE) + l * D, mod_ptr(F, l, mr, 3), mod_ptr(F, l, mr, 4), F.lane);
        { unsigned* q8 = (unsigned*)(U2 + (size_t)row * D) + F.lane;
#pragma unroll
          for (int j = 0; j < 4; ++j) q8[64 * j] = pg8::pk4_fp8(u.v[j][0], u.v[j][1], u.v[j][2], u.v[j][3]); }
        float lg[16];
#pragma unroll
        for (int e = 0; e < 16; ++e) { float s = 0.f;
#pragma unroll
            for (int j = 0; j < 4; ++j) { const f32x4 w = *(const LAS f32x4*)(wr + e * 1024 + 4 * F.lane + 256 * j); s += u.v[j][0] * w[0] + u.v[j][1] * w[1] + u.v[j][2] * w[2] + u.v[j][3] * w[3]; }
            lg[e] = s; if ((e & 3) == 3) __builtin_amdgcn_sched_barrier(0); }
        {
            const bool b5 = F.lane & 32, b4 = F.lane & 16, b3 = F.lane & 8, b2 = F.lane & 4;
#pragma unroll
            for (int i = 0; i < 8; ++i) { const float snd = b5 ? lg[i] : lg[i + 8], keep = b5 ? lg[i + 8] : lg[i]; lg[i] = keep + __shfl_xor(snd, 32); }
#pragma unroll
            for (int i = 0; i < 4; ++i) { const float snd = b4 ? lg[i] : lg[i + 4], keep = b4 ? lg[i + 4] : lg[i]; lg[i] = keep + __shfl_xor(snd, 16); }
#pragma unroll
            for (int i = 0; i < 2; ++i) { const float snd = b3 ? lg[i] : lg[i + 2], keep = b3 ? lg[i + 2] : lg[i]; lg[i] = keep + __shfl_xor(snd, 8); }
            { const float snd = b2 ? lg[0] : lg[1], keep = b2 ? lg[1] : lg[0]; lg[0] = keep + __shfl_xor(snd, 4); }
            float v = lg[0]; v += __shfl_xor(v, 2); v += __shfl_xor(v, 1);
            float mx = v; mx = fmaxf(mx, __shfl_xor(mx, 4)); mx = fmaxf(mx, __shfl_xor(mx, 8)); mx = fmaxf(mx, __shfl_xor(mx, 16)); mx = fmaxf(mx, __shfl_xor(mx, 32));
            const float ex = __expf(v - mx); float sm = ex; sm += __shfl_xor(sm, 4); sm += __shfl_xor(sm, 8); sm += __shfl_xor(sm, 16); sm += __shfl_xor(sm, 32);
            const int e = ((F.lane >> 5) & 1) * 8 + ((F.lane >> 4) & 1) * 4 + ((F.lane >> 3) & 1) * 2 + ((F.lane >> 2) & 1);
            if ((F.lane & 3) == 0) AFF[(size_t)row * 16 + e] = ex / sm;
        }
    }
}

__device__ __forceinline__ void e5_phase(const Frame& F, int l) {
    const int nrows = (l == 0) ? NT : NLAT;
    const int gw = F.bid * NWAVES + F.wave, NGW = F.G * NWAVES;
    const bf16_t* Y = (const bf16_t*)(F.ws + WS_BUFC); const short* SL = (const short*)(F.ws + WS_SLOT); bf16_t* U = (bf16_t*)(F.ws + WS_BUFA);
    for (int row = gw; row < nrows; row += NGW) {
        float* hp = row < NLAT ? F.out + (size_t)row * D : (float*)(F.ws + WS_HCTX) + (size_t)(row - NLAT) * D;
        const int mr = tok_modrow(row);
        const int myslot = (F.lane < 16) ? (int)SL[(size_t)row * 16 + F.lane] : -1;
        Row16 f;
#pragma unroll
        for (int j = 0; j < 4; ++j) f.v[j] = (f32x4){0.f, 0.f, 0.f, 0.f};
        for (int e = 0; e < 16; ++e) { const int sl = __shfl(myslot, e);
            if (sl >= 0) { const Row16 y = ld_row_bf16(Y + ((size_t)e * EROWS + sl) * D, F.lane);
#pragma unroll
                for (int j = 0; j < 4; ++j) f.v[j] += y.v[j]; } }
        Row16 h = ld_row_f32(hp, F.lane);
        { const float rstd = row_rstd(f); const Row16 G = ld_row_f32(INP(IN_GFFNPOST) + l * D, F.lane), GT = ld_row_f32(mod_ptr(F, l, mr, 5), F.lane);
#pragma unroll
          for (int j = 0; j < 4; ++j) h.v[j] = h.v[j] + GT.v[j] * (f.v[j] * rstd * G.v[j]); }
        st_row_f32(hp, F.lane, h);
        if (l == 0) { const Row16 u = norm_mod(h, INP(IN_GMIXPRE) + D, mod_ptr(F, 1, mr, 0), mod_ptr(F, 1, mr, 1), F.lane); st_row_bf16(U + (size_t)row * D, F.lane, u); }
    }
}

__device__ __forceinline__ void topk_unit(const Frame& F, int kind, int e, int b) {
    const int T = kind ? CTX : SEQ, cap = kind ? 32 : 512;
    const int row0 = kind ? NLAT + b * CTX : b * SEQ, base = kind ? 8192 + b * 32 : b * 512;
    LAS unsigned long long* key = (LAS unsigned long long*)F.lds;
    const float* AFF = (const float*)(F.ws + WS_AFF);
    for (int t = F.tid; t < T; t += NTHR) { const float a = AFF[(size_t)(row0 + t) * 16 + e]; key[t] = ((unsigned long long)__float_as_uint(a) << 32) | (unsigned)(0xFFFFFFFFu - (unsigned)t); }
    __syncthreads();
    for (int k = 2; k <= T; k <<= 1)
        for (int j = k >> 1; j > 0; j >>= 1) {
            for (int i = F.tid; i < T; i += NTHR) { const int x = i ^ j;
                if (x > i) { const unsigned long long a = key[i], c = key[x]; const bool desc = ((i & k) == 0);
                    if (desc ? (a < c) : (a > c)) { key[i] = c; key[x] = a; } } }
            __syncthreads();
        }
    int* RI = (int*)(F.ws + WS_ROWIDX); float* GT = (float*)(F.ws + WS_GATE); short* SL = (short*)(F.ws + WS_SLOT);
    for (int s = F.tid; s < T; s += NTHR) { const unsigned long long kk = key[s]; const int t = (int)(0xFFFFFFFFu - (unsigned)kk);
        if (s < cap) { RI[e * EROWS + base + s] = row0 + t; GT[e * EROWS + base + s] = __uint_as_float((unsigned)(kk >> 32)); SL[(size_t)(row0 + t) * 16 + e] = (short)(base + s); }
        else SL[(size_t)(row0 + t) * 16 + e] = (short)-1; }
    { const unsigned char* U8 = F.ws + WS_BUFA; unsigned char* AS = F.ws + WS_ASORT + ((size_t)e * EROWS + base) * D;
      for (int s = F.wave; s < cap; s += NWAVES) { const int t = (int)(0xFFFFFFFFu - (unsigned)key[s]);
          *(u32x4*)(AS + (size_t)s * D + 16 * F.lane) = *(const u32x4*)(U8 + (size_t)(row0 + t) * D + 16 * F.lane); } }
    __syncthreads();
}
__device__ __forceinline__ void topk_phase(const Frame& F, int l) {
    const int nunits = (l == 0) ? 512 : 256;
    for (int u = F.bid; u < nunits; u += F.G) { const int kind = u >> 8, e = (u & 255) >> 4, b = u & 15; topk_unit(F, kind, e, b); }
}
__device__ __forceinline__ void chunk_geom(int b, int c, int& rbase, int& t0, int& Tseg) {
    if (c < 2) { rbase = NLAT + b * CTX; t0 = c * 128; Tseg = CTX; } else { rbase = b * SEQ; t0 = (c - 2) * 128; Tseg = SEQ; }
}
__device__ __forceinline__ size_t st_index(int b, int c, int dir, int h) { return ((((size_t)b * NCH + c) * 2 + dir) * 6 + h) * 8192; }

__device__ __forceinline__ void dt_scan(const Frame& F, int l, const bf16_t* Pp, int row0, int dir, int h, float (&dt)[2], float (&incl)[2], float (&dA)[2], float& total) {
    const float bias = INP(IN_DTBIAS)[(l * 2 + dir) * 6 + h], a = -__expf(INP(IN_ALOG)[(l * 2 + dir) * 6 + h]);
#pragma unroll
    for (int q = 0; q < 2; ++q) { const float raw = bf2f(Pp[(size_t)(row0 + 2 * F.lane + q) * PW + PDT + dir * 6 + h]); dt[q] = softplusf(raw + bias); dA[q] = dt[q] * a; }
    float x = dA[0] + dA[1];
#pragma unroll
    for (int o = 1; o < 64; o <<= 1) { const float v = __shfl_up(x, o); if (F.lane >= o) x += v; }
    incl[1] = x; incl[0] = x - dA[1];
    total = __shfl(x, 63);
}

__device__ __forceinline__ void s1_unit(const Frame& F, int l, int b, int c, int g) {
    int rbase, t0, Tseg; chunk_geom(b, c, rbase, t0, Tseg);
    LAS bf16_t* Xs = (LAS bf16_t*)F.lds;
    LAS bf16_t* Bs = (LAS bf16_t*)(F.lds + 51200);
    LAS float* WF = (LAS float*)(F.lds + 86016);
    LAS float* WB = (LAS float*)(F.lds + 87552);
    const bf16_t* Pp = (const bf16_t*)(F.ws + WS_BUFB);
    bf16_t* XC = (bf16_t*)(F.ws + WS_BUFC + BC_XC);
    __syncthreads();
    if (F.tid < 448) {
        const int cg = F.tid % 56, run = F.tid / 56;
        const int ch = cg < 24 ? g * 192 + cg * 8 : (cg < 40 ? 384 + g * 128 + (cg - 24) * 8 : 640 + g * 128 + (cg - 40) * 8);
        float w[5][8], bias[8];
#pragma unroll
        for (int k = 0; k < 5; ++k) { const f32x4 a = *(const f32x4*)(INP(IN_CONVW) + (size_t)(l * 5 + k) * 896 + ch), bb = *(const f32x4*)(INP(IN_CONVW) + (size_t)(l * 5 + k) * 896 + ch + 4);
#pragma unroll
            for (int q = 0; q < 4; ++q) { w[k][q] = a[q]; w[k][4 + q] = bb[q]; } }
        { const f32x4 a = *(const f32x4*)(INP(IN_CONVB) + l * 896 + ch), bb = *(const f32x4*)(INP(IN_CONVB) + l * 896 + ch + 4);
#pragma unroll
          for (int q = 0; q < 4; ++q) { bias[q] = a[q]; bias[4 + q] = bb[q]; } }
        float win[5][8];
        const int tt0 = 16 * run;
#define S1_LOADROW(dst, t) do { const int _t = (t); if (_t >= 0 && _t < Tseg) { const u32x4 _v = *(const u32x4*)(Pp + (size_t)(rbase + _t) * PW + PX + ch); \
            dst[0] = lo2f(_v.x); dst[1] = hi2f(_v.x); dst[2] = lo2f(_v.y); dst[3] = hi2f(_v.y); dst[4] = lo2f(_v.z); dst[5] = hi2f(_v.z); dst[6] = lo2f(_v.w); dst[7] = hi2f(_v.w); } \
            else { _Pragma("unroll") for (int _q = 0; _q < 8; ++_q) dst[_q] = 0.f; } } while (0)
        S1_LOADROW(win[0], t0 + tt0 - 2); S1_LOADROW(win[1], t0 + tt0 - 1); S1_LOADROW(win[2], t0 + tt0); S1_LOADROW(win[3], t0 + tt0 + 1);
#pragma unroll 1
        for (int i = 0; i < 16; ++i) {
            S1_LOADROW(win[4], t0 + tt0 + i + 2);
            float o[8];
#pragma unroll
            for (int q = 0; q < 8; ++q) { float s = bias[q];
#pragma unroll
                for (int k = 0; k < 5; ++k) s += w[k][q] * win[k][q];
                o[q] = siluf(s); }
            u32x4 pk; pk.x = pk2(o[0], o[1]); pk.y = pk2(o[2], o[3]); pk.z = pk2(o[4], o[5]); pk.w = pk2(o[6], o[7]);
            *(u32x4*)(XC + (size_t)(rbase + t0 + tt0 + i) * 896 + ch) = pk;
            if (cg < 24) *(LAS u32x4*)(Xs + (tt0 + i) * 200 + cg * 8) = pk;
            else if (cg < 40) *(LAS u32x4*)(Bs + (tt0 + i) * 136 + (cg - 24) * 8) = pk;
#pragma unroll
            for (int k = 0; k < 4; ++k)
#pragma unroll
                for (int q = 0; q < 8; ++q) win[k][q] = win[k + 1][q];
        }
#undef S1_LOADROW
    }
    if (F.wave < 6) {
        const int dir = F.wave / 3, r = F.wave % 3, h = g * 3 + r;
        float dt[2], incl[2], dA[2], total;
        dt_scan(F, l, Pp, rbase + t0, dir, h, dt, incl, dA, total);
#pragma unroll
        for (int q = 0; q < 2; ++q) {
            const float wgt = dir == 0 ? dt[q] * __expf(total - incl[q]) : dt[q] * __expf(incl[q] - dA[q]);
            (dir == 0 ? WF : WB)[r * 128 + 2 * F.lane + q] = wgt; }
        if (F.lane == 0) ((float*)(F.ws + WS_DECAY))[((b * NCH + c) * 2 + dir) * 6 + h] = __expf(total);
    }
    __syncthreads();
    {
        const int li = F.lane & 15, gq = F.lane >> 4, pt = F.wave & 3, nh = F.wave >> 2;
        bf16x8 fn[4][4];
#pragma unroll
        for (int ks = 0; ks < 4; ++ks)
#pragma unroll
            for (int nt = 0; nt < 4; ++nt) fn[ks][nt] = frag_tr(Bs, 136, 32 * ks, 16 * (4 * nh + nt), li, gq);
        bf16_t* ST = (bf16_t*)(F.ws + WS_BUFC + BC_ST);
#pragma unroll 1
        for (int combo = 0; combo < 6; ++combo) {
            const int dir = combo / 3, r = combo % 3, h = g * 3 + r;
            const LAS float* W = (dir == 0 ? WF : WB) + r * 128;
            f32x4 acc[4];
#pragma unroll
            for (int nt = 0; nt < 4; ++nt) acc[nt] = (f32x4){0.f, 0.f, 0.f, 0.f};
#pragma unroll
            for (int ks = 0; ks < 4; ++ks) {
                const bf16x8 xr = frag_tr(Xs, 200, 32 * ks, r * 64 + 16 * pt, li, gq);
                const f32x4 w0 = *(const LAS f32x4*)(W + 32 * ks + 8 * gq), w1 = *(const LAS f32x4*)(W + 32 * ks + 8 * gq + 4);
                u32x4 pw;
                pw.x = pk2(bf2f((bf16_t)xr[0]) * w0[0], bf2f((bf16_t)xr[1]) * w0[1]); pw.y = pk2(bf2f((bf16_t)xr[2]) * w0[2], bf2f((bf16_t)xr[3]) * w0[3]);
                pw.z = pk2(bf2f((bf16_t)xr[4]) * w1[0], bf2f((bf16_t)xr[5]) * w1[1]); pw.w = pk2(bf2f((bf16_t)xr[6]) * w1[2], bf2f((bf16_t)xr[7]) * w1[3]);
                const bf16x8 xw = __builtin_bit_cast(bf16x8, pw);
#pragma unroll
                for (int nt = 0; nt < 4; ++nt) acc[nt] = mfma16(fn[ks][nt], xw, acc[nt]);
            }
            bf16_t* dst = ST + st_index(b, c, dir, h) + (size_t)(16 * pt + li) * 128;
#pragma unroll
            for (int nt = 0; nt < 4; ++nt) *(u32x2*)(dst + 16 * (4 * nh + nt) + 4 * gq) = pack4(acc[nt]);
        }
    }
}

__device__ __forceinline__ void s2_phase(const Frame& F) {
    bf16_t* ST = (bf16_t*)(F.ws + WS_BUFC + BC_ST); const float* DEC = (const float*)(F.ws + WS_DECAY);
    for (int it = F.bid * NTHR + F.tid; it < NB * 2 * 6 * 64 * 16; it += F.G * NTHR) {
        const int n8 = it & 15, p = (it >> 4) & 63, hh = (it >> 10) % 6, dir = ((it >> 10) / 6) & 1, b = (it >> 10) / 12;
        float hst[8];
#pragma unroll
        for (int q = 0; q < 8; ++q) hst[q] = 0.f;
#pragma unroll 2
        for (int s = 0; s < NCH; ++s) {
            const int c = dir == 0 ? s : (s < 2 ? 1 - s : NCH + 1 - s);
            bf16_t* ptr = ST + st_index(b, c, dir, hh) + p * 128 + n8 * 8;
            const u32x4 v = *(const u32x4*)ptr;
            const float d = DEC[((b * NCH + c) * 2 + dir) * 6 + hh];
            u32x4 o; o.x = pk2(hst[0], hst[1]); o.y = pk2(hst[2], hst[3]); o.z = pk2(hst[4], hst[5]); o.w = pk2(hst[6], hst[7]);
            *(u32x4*)ptr = o;
            hst[0] = hst[0] * d + lo2f(v.x); hst[1] = hst[1] * d + hi2f(v.x); hst[2] = hst[2] * d + lo2f(v.y); hst[3] = hst[3] * d + hi2f(v.y);
            hst[4] = hst[4] * d + lo2f(v.z); hst[5] = hst[5] * d + hi2f(v.z); hst[6] = hst[6] * d + lo2f(v.w); hst[7] = hst[7] * d + hi2f(v.w);
        }
    }
}

__device__ __forceinline__ void s3_unit(const Frame& F, int l, int b, int c) {
    int rbase, t0, Tseg; chunk_geom(b, c, rbase, t0, Tseg);
    LAS bf16_t* Bs = (LAS bf16_t*)F.lds;
    LAS bf16_t* Xs = (LAS bf16_t*)(F.lds + 34816);
    LAS bf16_t* SCR = (LAS bf16_t*)(F.lds + 86016 + F.wave * 4352);
    LAS float* DTF = (LAS float*)(F.lds + 120832);
    LAS float* DTB = DTF + 384; LAS float* ACF = DTF + 768; LAS float* ACB = DTF + 1152;
    const bf16_t* Pp = (const bf16_t*)(F.ws + WS_BUFB);
    const bf16_t* XC = (const bf16_t*)(F.ws + WS_BUFC + BC_XC);
    const bf16_t* ST = (const bf16_t*)(F.ws + WS_BUFC + BC_ST);
    bf16_t* MIX = (bf16_t*)(F.ws + WS_BUFA);
    const int li = F.lane & 15, gq = F.lane >> 4, w = F.wave;
    const int itok = 16 * w + li;
    const size_t grow = (size_t)(rbase + t0 + itok);
    float ss = 0.f;
#pragma unroll 1
    for (int g = 0; g < 2; ++g) {
        __syncthreads();
        for (int i = F.tid; i < 128 * 40; i += NTHR) { const int t = i / 40, cc = i % 40; const size_t rr = (size_t)(rbase + t0 + t) * 896;
            if (cc < 24) *(LAS u32x4*)(Xs + t * 200 + cc * 8) = *(const u32x4*)(XC + rr + g * 192 + cc * 8);
            else *(LAS u32x4*)(Bs + t * 136 + (cc - 24) * 8) = *(const u32x4*)(XC + rr + 384 + g * 128 + (cc - 24) * 8); }
        if (w < 6) {
            const int dir = w / 3, r = w % 3, h = g * 3 + r;
            float dt[2], incl[2], dA[2], total;
            dt_scan(F, l, Pp, rbase + t0, dir, h, dt, incl, dA, total);
#pragma unroll
            for (int q = 0; q < 2; ++q) { const int tt = 2 * F.lane + q;
                if (dir == 0) { DTF[r * 128 + tt] = dt[q]; ACF[r * 128 + tt] = incl[q]; }
                else { DTB[r * 128 + tt] = dt[q]; ACB[r * 128 + tt] = total - (incl[q] - dA[q]); } }
        }
        bf16x8 cf[4];
#pragma unroll
        for (int ks = 0; ks < 4; ++ks) cf[ks] = *(const bf16x8*)(XC + grow * 896 + 640 + g * 128 + 32 * ks + 8 * gq);
        __syncthreads();
        f32x4 cb[8];
#pragma unroll
        for (int jt = 0; jt < 8; ++jt) { cb[jt] = (f32x4){0.f, 0.f, 0.f, 0.f};
#pragma unroll
            for (int ks = 0; ks < 4; ++ks) cb[jt] = mfma16(frag_lds(Bs, 136, 16 * jt, 32 * ks, li, gq), cf[ks], cb[jt]); }
#pragma unroll 1
        for (int r = 0; r < 3; ++r) {
            const int h = g * 3 + r;
            int itk = itok; asm volatile("" : "+v"(itk));
            const float af_i = ACF[r * 128 + itok], ab_i = ACB[r * 128 + itok];
#pragma unroll
            for (int jt = 0; jt < 8; ++jt) { const int jv = 16 * jt + 4 * gq;
                const f32x4 acf = *(const LAS f32x4*)(ACF + r * 128 + jv), dtf = *(const LAS f32x4*)(DTF + r * 128 + jv), acb = *(const LAS f32x4*)(ACB + r * 128 + jv), dtb = *(const LAS f32x4*)(DTB + r * 128 + jv);
                f32x4 mv;
#pragma unroll
                for (int q = 0; q < 4; ++q) { const int j = jv + q;
                    const float mfw = (float)(((itk - j) >> 31) + 1), mbw = (float)(((j - itk) >> 31) + 1);
                    const float ef = mfw * __expf(fminf(af_i - acf[q], 0.f)) * dtf[q];
                    const float eb = mbw * __expf(fminf(ab_i - acb[q], 0.f)) * dtb[q];
                    mv[q] = cb[jt][q] * (ef + eb); }
                *(LAS u32x2*)(SCR + li * 136 + jv) = pack4(mv); }
            LDS_FENCE();
            bf16x8 mf[4];
#pragma unroll
            for (int ks = 0; ks < 4; ++ks) mf[ks] = frag_lds(SCR, 136, 0, 32 * ks, li, gq);
            const float ef_i = __expf(af_i), eb_i = __expf(ab_i), dsk = INP(IN_DSKIP)[l * 6 + h];
            const bf16_t* Hf = ST + st_index(b, c, 0, h); const bf16_t* Hb = ST + st_index(b, c, 1, h);
#pragma unroll
            for (int pt = 0; pt < 4; ++pt) {
                f32x4 ya = (f32x4){0.f, 0.f, 0.f, 0.f}, gf = ya, gb = ya;
#pragma unroll
                for (int ks = 0; ks < 4; ++ks) {
                    ya = mfma16(frag_tr(Xs, 200, 32 * ks, r * 64 + 16 * pt, li, gq), mf[ks], ya);
                    gf = mfma16(frag_glb(Hf, 128, 16 * pt, 32 * ks, li, gq), cf[ks], gf);
                    gb = mfma16(frag_glb(Hb, 128, 16 * pt, 32 * ks, li, gq), cf[ks], gb); }
                const u32x2 xw = *(const LAS u32x2*)(Xs + itok * 200 + r * 64 + 16 * pt + 4 * gq);
                const u32x2 zw = *(const u32x2*)(Pp + grow * PW + PZ + h * 64 + 16 * pt + 4 * gq);
                const float xs_[4] = {lo2f(xw.x), hi2f(xw.x), lo2f(xw.y), hi2f(xw.y)}, zs_[4] = {lo2f(zw.x), hi2f(zw.x), lo2f(zw.y), hi2f(zw.y)};
                f32x4 o;
#pragma unroll
                for (int q = 0; q < 4; ++q) { const float y = ya[q] + ef_i * gf[q] + eb_i * gb[q] + dsk * xs_[q]; o[q] = y * siluf(zs_[q]); ss += o[q] * o[q]; }
                *(u32x2*)(MIX + grow * D + 640 + h * 64 + 16 * pt + 4 * gq) = pack4(o);
            }
            LDS_FENCE();
        }
    }
    ss += __shfl_xor(ss, 16); ss += __shfl_xor(ss, 32);
    const float rstd = rsqrtf(ss * (1.f / 384.f) + EPS);
    asm volatile("s_waitcnt vmcnt(0)" ::: "memory");
#pragma unroll 2
    for (int hp = 0; hp < 24; ++hp) { const int col = (hp >> 2) * 64 + 16 * (hp & 3) + 4 * gq; const f32x4 gs = *(const f32x4*)(INP(IN_GSSD) + l * 384 + col);
        const u32x2 yw = *(const u32x2*)(MIX + grow * D + 640 + col);
#if defined(DBG_ZERO_S)
        const f32x4 o = (f32x4){0.f, 0.f, 0.f, 0.f} * (rstd * gs + lo2f(yw.x));
#else
        const f32x4 o = (f32x4){lo2f(yw.x), hi2f(yw.x), lo2f(yw.y), hi2f(yw.y)} * rstd * gs;
#endif
        *(u32x2*)(MIX + grow * D + 640 + col) = pack4(o); }
}

__device__ __forceinline__ void attn_unit(const Frame& F, int l, int b, int nb, int kvh, bool ctxq) {
    LAS float* ROPE = (LAS float*)F.lds;
    LAS bf16_t* Kt = (LAS bf16_t*)(F.lds + 8192);
    LAS bf16_t* Vt = (LAS bf16_t*)(F.lds + 26624);
    const bf16_t* Pp = (const bf16_t*)(F.ws + WS_BUFB);
    bf16_t* MIX = (bf16_t*)(F.ws + WS_BUFA);
    const int li = F.lane & 15, gq = F.lane >> 4, w = F.wave;
    __syncthreads();
    for (int i = F.tid; i < 2048; i += NTHR) ROPE[i] = ((const float*)(F.ws + WS_ROPE))[i];
    __syncthreads();
    const int qrow_base = ctxq ? NLAT + b * CTX + nb * 128 : b * SEQ + nb * 128;
    bf16x8 qf[3][2]; float m[3], lsum[3];
    f32x4 o[4][3];
#pragma unroll
    for (int qt = 0; qt < 3; ++qt) {
        const int R = 48 * w + 16 * qt, r = R >> 7, qi = (R & 127) + li, h = kvh * 3 + r;
        const bf16_t* qp = Pp + (size_t)(qrow_base + qi) * PW + PQ + h * 64;
        const int tq = nb * 128 + qi;
#pragma unroll
        for (int ks = 0; ks < 2; ++ks) {
            const int d0 = 32 * ks + 8 * gq;
            const u32x4 own = *(const u32x4*)(qp + d0);
            float ov[8] = {lo2f(own.x), hi2f(own.x), lo2f(own.y), hi2f(own.y), lo2f(own.z), hi2f(own.z), lo2f(own.w), hi2f(own.w)};
            if (!ctxq) {
                const u32x4 par = *(const u32x4*)(qp + (d0 ^ 16));
                const float pv[8] = {lo2f(par.x), hi2f(par.x), lo2f(par.y), hi2f(par.y), lo2f(par.z), hi2f(par.z), lo2f(par.w), hi2f(par.w)};
                const int pos = ks == 0 ? (tq >> 6) : (tq & 63), f0 = (8 * gq) & 15;
#pragma unroll
                for (int j = 0; j < 8; ++j) { const float cs = ROPE[(pos * 16 + f0 + j) * 2], sn = ROPE[(pos * 16 + f0 + j) * 2 + 1];
                    ov[j] = (gq < 2) ? (ov[j] * cs - pv[j] * sn) : (pv[j] * sn + ov[j] * cs); }
            }
            u32x4 pq; pq.x = pk2(ov[0] * 0.125f, ov[1] * 0.125f); pq.y = pk2(ov[2] * 0.125f, ov[3] * 0.125f); pq.z = pk2(ov[4] * 0.125f, ov[5] * 0.125f); pq.w = pk2(ov[6] * 0.125f, ov[7] * 0.125f);
            qf[qt][ks] = __builtin_bit_cast(bf16x8, pq);
        }
        m[qt] = INP(IN_SINK)[l * 6 + h]; lsum[qt] = (gq == 0) ? 1.f : 0.f;
#pragma unroll
        for (int dt = 0; dt < 4; ++dt) o[dt][qt] = (f32x4){0.f, 0.f, 0.f, 0.f};
    }
    const int ntile = ctxq ? 2 : 5;
#pragma unroll 1
    for (int ti = 0; ti < ntile; ++ti) {
        const bool local = (!ctxq) && ti < 3;
        const int kb = nb - 1 + ti;
        if (local && (kb < 0 || kb >= 32)) continue;
        const int ct = ctxq ? ti : ti - 3;
        const int krow0 = local ? b * SEQ + kb * 128 : NLAT + b * CTX + ct * 128;
        __syncthreads();
        {
            const int key = F.tid >> 2, part = F.tid & 3, c1 = part < 2 ? part : part + 2, c2 = c1 + 2;
            const bf16_t* kp = Pp + (size_t)(krow0 + key) * PW + PK + kvh * 64;
            const u32x4 a = *(const u32x4*)(kp + 8 * c1), bq = *(const u32x4*)(kp + 8 * c2);
            u32x4 oa = a, ob = bq;
            if (local) {
                const float v1[8] = {lo2f(a.x), hi2f(a.x), lo2f(a.y), hi2f(a.y), lo2f(a.z), hi2f(a.z), lo2f(a.w), hi2f(a.w)};
                const float v2[8] = {lo2f(bq.x), hi2f(bq.x), lo2f(bq.y), hi2f(bq.y), lo2f(bq.z), hi2f(bq.z), lo2f(bq.w), hi2f(bq.w)};
                const int tk = kb * 128 + key, pos = c1 < 4 ? (tk >> 6) : (tk & 63), f0 = (8 * c1) & 15;
                float r1[8], r2[8];
#pragma unroll
                for (int j = 0; j < 8; ++j) { const float cs = ROPE[(pos * 16 + f0 + j) * 2], sn = ROPE[(pos * 16 + f0 + j) * 2 + 1]; r1[j] = v1[j] * cs - v2[j] * sn; r2[j] = v1[j] * sn + v2[j] * cs; }
                oa.x = pk2(r1[0], r1[1]); oa.y = pk2(r1[2], r1[3]); oa.z = pk2(r1[4], r1[5]); oa.w = pk2(r1[6], r1[7]);
                ob.x = pk2(r2[0], r2[1]); ob.y = pk2(r2[2], r2[3]); ob.z = pk2(r2[4], r2[5]); ob.w = pk2(r2[6], r2[7]);
            }
            *(LAS u32x4*)(Kt + key * 72 + 8 * c1) = oa; *(LAS u32x4*)(Kt + key * 72 + 8 * c2) = ob;
#pragma unroll
            for (int q = 0; q < 2; ++q) { const int idx = F.tid + 512 * q, k2 = idx >> 3, chv = idx & 7;
                *(LAS u32x4*)(Vt + k2 * 72 + 8 * chv) = *(const u32x4*)(Pp + (size_t)(krow0 + k2) * PW + PV + kvh * 64 + 8 * chv); }
        }
        __syncthreads();
        const bool masked = local && (kb != nb);
#pragma unroll
        for (int qt = 0; qt < 3; ++qt) {
            __builtin_amdgcn_sched_barrier(0);
            const int qpos = nb * 128 + (((48 * w + 16 * qt) & 127) + li);
#pragma unroll 1
            for (int hf = 0; hf < 2; ++hf) {
                f32x4 s[4];
#pragma unroll
                for (int kt = 0; kt < 4; ++kt) { s[kt] = (f32x4){0.f, 0.f, 0.f, 0.f};
#pragma unroll
                    for (int ks = 0; ks < 2; ++ks) s[kt] = mfma16(frag_lds(Kt, 72, 64 * hf + 16 * kt, 32 * ks, li, gq), qf[qt][ks], s[kt]); }
                float tmax = -1e30f;
#pragma unroll
                for (int kt = 0; kt < 4; ++kt)
#pragma unroll
                    for (int q = 0; q < 4; ++q) {
                        if (masked) { const int kpos = kb * 128 + 64 * hf + 16 * kt + 4 * gq + q; const int dd = qpos - kpos; if (dd > 128 || dd < -128) s[kt][q] = -1e30f; }
                        tmax = fmaxf(tmax, s[kt][q]); }
                tmax = fmaxf(tmax, __shfl_xor(tmax, 16)); tmax = fmaxf(tmax, __shfl_xor(tmax, 32));
                const float mnew = fmaxf(m[qt], tmax), alpha = __expf(m[qt] - mnew);
                float ps = 0.f;
#pragma unroll
                for (int kt = 0; kt < 4; ++kt)
#pragma unroll
                    for (int q = 0; q < 4; ++q) { const float pe = __expf(s[kt][q] - mnew); s[kt][q] = pe; ps += pe; }
                lsum[qt] = lsum[qt] * alpha + ps; m[qt] = mnew;
#pragma unroll
                for (int dt = 0; dt < 4; ++dt) o[dt][qt] = o[dt][qt] * alpha;
#pragma unroll
                for (int k4 = 0; k4 < 2; ++k4) {
                    u32x4 pp; pp.x = pk2(s[2 * k4][0], s[2 * k4][1]); pp.y = pk2(s[2 * k4][2], s[2 * k4][3]); pp.z = pk2(s[2 * k4 + 1][0], s[2 * k4 + 1][1]); pp.w = pk2(s[2 * k4 + 1][2], s[2 * k4 + 1][3]);
                    const bf16x8 pf = __builtin_bit_cast(bf16x8, pp);
#pragma unroll
                    for (int dt = 0; dt < 4; ++dt) o[dt][qt] = mfma16(frag_tr_split(Vt, 72, 64 * hf + 32 * k4, 16 * dt, li, gq), pf, o[dt][qt]);
                }
            }
        }
    }
#pragma unroll
    for (int qt = 0; qt < 3; ++qt) {
        float lt = lsum[qt]; lt += __shfl_xor(lt, 16); lt += __shfl_xor(lt, 32);
        const float inv = 1.f / lt;
        const int R = 48 * w + 16 * qt;
        bf16_t* op = MIX + (size_t)(qrow_base + (R & 127) + li) * D + 256 + (kvh * 3 + (R >> 7)) * 64 + 4 * gq;
#pragma unroll
#if defined(DBG_ZERO_A)
        for (int dt = 0; dt < 4; ++dt) *(u32x2*)(op + 16 * dt) = pack4(o[dt][qt] * 0.f);
#else
        for (int dt = 0; dt < 4; ++dt) *(u32x2*)(op + 16 * dt) = pack4(o[dt][qt] * inv);
#endif
    }
}

#if defined(DBG_ZERO_F)
constexpr float FSCALE512 = 0.f, FSCALE128 = 0.f;
#else
constexpr float FSCALE512 = 1.f / 512.f, FSCALE128 = 1.f / 128.f;
#endif
constexpr int FO_CST = 0, FO_M2 = 18432, FO_Z = 53248, FO_CSB = 90112, FO_FST = 107520, FO_Z2 = 53248, FO_TAB = 126976;
__device__ __forceinline__ void fourier_consts_a(const Frame& F) {
    LAS bf16_t* CSt = (LAS bf16_t*)(F.lds + FO_CST); LAS bf16_t* M2 = (LAS bf16_t*)(F.lds + FO_M2);
    __syncthreads();
    for (int i = F.tid; i < 128 * 64; i += NTHR) { const int cp = i >> 6, c = i & 63; const int ph = (c * (cp & 63)) & 63; const float v = cp < 64 ? cospif(ph / 32.f) : sinpif(ph / 32.f);
        CSt[cp * 72 + c] = (bf16_t)(pk2(v, 0.f) & 0xffff); }
    for (int i = F.tid; i < 128 * 128; i += NTHR) { const int kp = i >> 7, kk = i & 127; const int ph = ((kp & 63) * (kk & 63)) & 63; const float cs = cospif(ph / 32.f), sn = sinpif(ph / 32.f);
        const float v = kp < 64 ? (kk < 64 ? cs : -sn) : (kk < 64 ? -sn : -cs);
        M2[kp * 136 + kk] = (bf16_t)(pk2(v, 0.f) & 0xffff); }
    __syncthreads();
}
__device__ __forceinline__ void fourier_consts_b(const Frame& F) {
    LAS bf16_t* CSb = (LAS bf16_t*)(F.lds + FO_CSB);
    __syncthreads();
    for (int i = F.tid; i < 64 * 128; i += NTHR) { const int k2 = i >> 7, kk = i & 127; const int ph = (k2 * (kk & 63)) & 63; const float v = kk < 64 ? cospif(ph / 32.f) : sinpif(ph / 32.f);
        CSb[k2 * 136 + kk] = (bf16_t)(pk2(v, 0.f) & 0xffff); }
    __syncthreads();
}
__device__ __forceinline__ void fa_unit(const Frame& F, int b, int g, int pr) {
    LAS bf16_t* CSt = (LAS bf16_t*)(F.lds + FO_CST); LAS bf16_t* M2 = (LAS bf16_t*)(F.lds + FO_M2);
    const bf16_t* Pp = (const bf16_t*)(F.ws + WS_BUFB); bf16_t* FA = (bf16_t*)(F.ws + WS_BUFC + BC_FA);
    const int li = F.lane & 15, gq = F.lane >> 4, w = F.wave;
    __syncthreads();
#pragma unroll
    for (int u2 = 0; u2 < 2; ++u2) {
        LAS bf16_t* Z = (LAS bf16_t*)(F.lds + FO_Z + u2 * 18432);
        const int n2 = 2 * pr + u2, n1 = 16 * (w & 3) + li;
        const bf16_t* up = Pp + (size_t)(b * SEQ + 64 * n1 + n2) * PW + PF + g * 64;
        bf16x8 uf[2];
#pragma unroll
        for (int ks = 0; ks < 2; ++ks) uf[ks] = *(const bf16x8*)(up + 32 * ks + 8 * gq);
#pragma unroll
        for (int ctl = 0; ctl < 4; ++ctl) { const int ct = 4 * (w >> 2) + ctl; f32x4 acc = (f32x4){0.f, 0.f, 0.f, 0.f};
#pragma unroll
            for (int ks = 0; ks < 2; ++ks) acc = mfma16(frag_lds(CSt, 72, 16 * ct, 32 * ks, li, gq), uf[ks], acc);
            const int cp = 16 * ct + 4 * gq;
            *(LAS u32x2*)(Z + ((cp < 64 ? 0 : 64) + n1) * 72 + (cp & 63)) = pack4(acc); }
    }
    __syncthreads();
#pragma unroll
    for (int u2 = 0; u2 < 2; ++u2) {
        LAS bf16_t* Z = (LAS bf16_t*)(F.lds + FO_Z + u2 * 18432);
        const int n2 = 2 * pr + u2, kt = w & 3, k1 = 16 * kt + li;
        const int ph = (n2 * k1) & 4095; const float cs = cospif(ph / 2048.f), sn = sinpif(ph / 2048.f);
#pragma unroll
        for (int ctl = 0; ctl < 2; ++ctl) { const int ct = 2 * (w >> 2) + ctl; f32x4 ar = (f32x4){0.f, 0.f, 0.f, 0.f}, ai = ar;
#pragma unroll
            for (int ks = 0; ks < 4; ++ks) { const bf16x8 zf = frag_tr(Z, 72, 32 * ks, 16 * ct, li, gq);
                ar = mfma16(zf, frag_lds(M2, 136, 16 * kt, 32 * ks, li, gq), ar);
                ai = mfma16(zf, frag_lds(M2, 136, 64 + 16 * kt, 32 * ks, li, gq), ai); }
            const f32x4 tr = ar * cs + ai * sn, tim = ai * cs - ar * sn;
            bf16_t* dst = FA + ((((size_t)(b * 4 + g) * 64 + k1) * 64 + n2) * 128) + 16 * ct + 4 * gq;
            *(u32x2*)dst = pack4(tr); *(u32x2*)(dst + 64) = pack4(tim); }
    }
}
__device__ __forceinline__ void fb_unit(const Frame& F, int b, int g, int k1) {
    LAS bf16_t* CSb = (LAS bf16_t*)(F.lds + FO_CSB); LAS bf16_t* Fst = (LAS bf16_t*)(F.lds + FO_FST);
    const bf16_t* FA = (const bf16_t*)(F.ws + WS_BUFC + BC_FA) + (((size_t)(b * 4 + g) * 64 + k1) * 64) * 128;
    bf16_t* MIX = (bf16_t*)(F.ws + WS_BUFA);
    const int li = F.lane & 15, gq = F.lane >> 4, w = F.wave;
    __syncthreads();
#pragma unroll
    for (int q = 0; q < 2; ++q) { const int idx = F.tid + 512 * q, n2 = idx >> 4, ri = (idx >> 3) & 1, cc = idx & 7;
        *(LAS u32x4*)(Fst + (ri * 64 + n2) * 72 + 8 * cc) = *(const u32x4*)(FA + (size_t)idx * 8); }
    __syncthreads();
    const int k2 = 16 * (w & 3) + li;
#pragma unroll
    for (int ctl = 0; ctl < 2; ++ctl) { const int ct = 2 * (w >> 2) + ctl; f32x4 acc = (f32x4){0.f, 0.f, 0.f, 0.f};
#pragma unroll
        for (int ks = 0; ks < 4; ++ks) acc = mfma16(frag_tr(Fst, 72, 32 * ks, 16 * ct, li, gq), frag_lds(CSb, 136, 16 * (w & 3), 32 * ks, li, gq), acc);
        *(u32x2*)(MIX + (size_t)(b * SEQ + 64 * k2 + k1) * D + g * 64 + 16 * ct + 4 * gq) = pack4(acc * FSCALE512); }
}
__device__ __forceinline__ void fctx_unit(const Frame& F, int b, int g) {
    LAS bf16_t* CSt = (LAS bf16_t*)(F.lds + FO_CST); LAS bf16_t* Z2 = (LAS bf16_t*)(F.lds + FO_Z2);
    LAS bf16_t* TAB = (LAS bf16_t*)(F.lds + FO_TAB);
    const bf16_t* Pp = (const bf16_t*)(F.ws + WS_BUFB); bf16_t* MIX = (bf16_t*)(F.ws + WS_BUFA);
    const int li = F.lane & 15, gq = F.lane >> 4, w = F.wave;
    __syncthreads();
    if (F.tid < 256) { TAB[F.tid] = (bf16_t)(pk2(cospif(F.tid / 128.f), 0.f) & 0xffff); TAB[256 + F.tid] = (bf16_t)(pk2(-sinpif(F.tid / 128.f), 0.f) & 0xffff); }
    {
        bf16x8 cfr[2];
#pragma unroll
        for (int ks = 0; ks < 2; ++ks) cfr[ks] = frag_lds(CSt, 72, 16 * w, 32 * ks, li, gq);
#pragma unroll 4
        for (int nt = 0; nt < 16; ++nt) { const int n = 16 * nt + li; const bf16_t* up = Pp + (size_t)(NLAT + b * CTX + n) * PW + PF + g * 64;
            f32x4 acc = (f32x4){0.f, 0.f, 0.f, 0.f};
#pragma unroll
            for (int ks = 0; ks < 2; ++ks) acc = mfma16(cfr[ks], *(const bf16x8*)(up + 32 * ks + 8 * gq), acc);
            const int cp = 16 * w + 4 * gq;
            *(LAS u32x2*)(Z2 + ((cp < 64 ? 0 : 256) + n) * 72 + (cp & 63)) = pack4(acc); }
    }
    __syncthreads();
    f32x4 acc[2][4];
#pragma unroll
    for (int a = 0; a < 2; ++a)
#pragma unroll
        for (int ct = 0; ct < 4; ++ct) acc[a][ct] = (f32x4){0.f, 0.f, 0.f, 0.f};
#pragma unroll 1
    for (int ks = 0; ks < 16; ++ks) {
        bf16x8 zf[4];
#pragma unroll
        for (int ct = 0; ct < 4; ++ct) zf[ct] = frag_tr(Z2, 72, 32 * ks, 16 * ct, li, gq);
#pragma unroll
        for (int a = 0; a < 2; ++a) { const int k = 16 * (2 * w + a) + li; bf16x8 df;
#pragma unroll
            for (int j = 0; j < 8; ++j) { const int kk = 32 * ks + 8 * gq + j; df[j] = (short)TAB[(kk < 256 ? 0 : 256) + ((k * (kk & 255)) & 255)]; }
#pragma unroll
            for (int ct = 0; ct < 4; ++ct) acc[a][ct] = mfma16(zf[ct], df, acc[a][ct]); }
    }
#pragma unroll
    for (int a = 0; a < 2; ++a) { const int k = 16 * (2 * w + a) + li;
#pragma unroll
        for (int ct = 0; ct < 4; ++ct) *(u32x2*)(MIX + (size_t)(NLAT + b * CTX + k) * D + g * 64 + 16 * ct + 4 * gq) = pack4(acc[a][ct] * FSCALE128); }
}
__global__ void __launch_bounds__(NTHR, 2) hybrid_fwd(Params P) {
    extern __shared__ __attribute__((aligned(16))) unsigned char lds_raw[];
    Frame F;
    F.lds = (LAS unsigned char*)lds_raw;
    F.tid = threadIdx.x; F.lane = F.tid & 63; F.wave = __builtin_amdgcn_readfirstlane(F.tid >> 6);
    F.G = gridDim.x; F.bid = blockIdx.x;
    F.out = P.out; F.ws = P.ws;
    volatile LAS unsigned* MISC = (volatile LAS unsigned*)(F.lds + MISC_OFF);
    if (F.tid < 16) MISC[F.tid] = 0u;
    __syncthreads();
    XcdBarrier bar = xcd_barrier_post((unsigned*)(F.ws + WS_CTL), MISC);
#define PHASE_FENCE() do { asm volatile("" : "+v"(F.tid)); F.lane = F.tid & 63; F.wave = __builtin_amdgcn_readfirstlane(F.tid >> 6); \
        asm volatile("" : "+s"(F.ws), "+s"(F.out), "+s"(F.bid), "+s"(F.G)); } while (0)
#define GRID_BAR() do { xcd_barrier(bar); PHASE_FENCE(); } while (0)
#if defined(DBG_REP_K)
#define REPS(k, lay) (((k) == DBG_REP_K && (lay) == DBG_REP_L) ? 2 : 1)
#else
#define REPS(k, lay) 1
#endif

    for (int rep = 0; rep < REPS(0, 0); ++rep) { p0_prologue(F); GRID_BAR(); }
    for (int rep = 0; rep < REPS(1, 0); ++rep) { e1_phase(F); GRID_BAR(); }

#pragma unroll 1
    for (int l = 0; l < 2; ++l) {
        const bool first = (l == 0);
        PHASE_FENCE();
        for (int rep = 0; rep < REPS(2, l); ++rep) {
        {
            pg8::DenseProb pb{(const bf16_t*)(F.ws + WS_BUFA), (const bf16_t*)(F.ws + WS_WIN) + (size_t)l * PW * D, nullptr, D};
            pg8::GridOrder S; S.init(NT / 256, PW / 256, F.G, F.bid);
            pg8::EpiBf16 E{(bf16_t*)(F.ws + WS_BUFB), PW};
            pg8::gemm_phase(F.lds, F.tid, pb, S, E);
        }
        GRID_BAR();
        }
        for (int rep = 0; rep < REPS(3, l); ++rep) {
        {
            const int nAttL = NB * 32 * 2, nAttC = first ? NB * 2 * 2 : 0, nS1 = NB * NCH * 2, nFA = NB * 4 * 32;
            const int total = nAttL + nAttC + nS1 + nFA;
            bool fa_ready = false;
            for (int u = F.bid; u < total; u += F.G) {
                PHASE_FENCE();
                int v = u;
                if (v < nAttL) { const int b = v >> 6, nb = (v >> 1) & 31, kvh = v & 1; attn_unit(F, l, b, nb, kvh, false); continue; } v -= nAttL;
                if (v < nAttC) { const int b = v >> 2, nb = (v >> 1) & 1, kvh = v & 1; attn_unit(F, l, b, nb, kvh, true); continue; } v -= nAttC;
                if (v < nS1) { const int g = v & 1, c = (v >> 1) % NCH, b = (v >> 1) / NCH; s1_unit(F, l, b, c, g); continue; } v -= nS1;
                if (!fa_ready) { fourier_consts_a(F); fa_ready = true; }
                { const int pr = v & 31, g = (v >> 5) & 3, b = v >> 7; fa_unit(F, b, g, pr); }
            }
        }
        GRID_BAR();
        }
        s2_phase(F);
        GRID_BAR();
        for (int rep = 0; rep < REPS(5, l); ++rep) {
        {
            const int c0 = first ? 0 : 2;
            const int nS3 = NB * (NCH - c0), nFC = first ? NB * 4 : 0, nFB = NB * 4 * 64;
            const int total = nS3 + nFC + nFB;
            bool fa_ready = false, fb_ready = false;
            for (int u = F.bid; u < total; u += F.G) {
                PHASE_FENCE();
                int v = u;
                if (v < nS3) { const int c = c0 + v % (NCH - c0), b = v / (NCH - c0); s3_unit(F, l, b, c); continue; } v -= nS3;
                if (v < nFC) { if (!fa_ready) { fourier_consts_a(F); fa_ready = true; } fctx_unit(F, v >> 2, v & 3); fb_ready = false; continue; } v -= nFC;
                if (!fb_ready) { fourier_consts_b(F); fb_ready = true; }
                { const int k1 = v & 63, g = (v >> 6) & 3, b = v >> 8; fb_unit(F, b, g, k1); }
            }
            __syncthreads();
        }
        GRID_BAR();
        }
        for (int rep = 0; rep < REPS(6, l); ++rep) {
        {
            const int rows = first ? NT : NLAT;
            pg8::DenseProb pb{(const bf16_t*)(F.ws + WS_BUFA), (const bf16_t*)(F.ws + WS_WOUT) + (size_t)l * D * D, nullptr, D};
            pg8::GridOrder S; S.init(rows / 256, D / 256, F.G, F.bid);
            pg8::EpiBf16 E{(bf16_t*)(F.ws + WS_BUFB), D};
            pg8::gemm_phase(F.lds, F.tid, pb, S, E);
        }
        GRID_BAR();
        }
        for (int rep = 0; rep < REPS(7, l); ++rep) { e3_phase(F, l); GRID_BAR(); }
#if defined(DBG_STOP)
        if (DBG_STOP == 1 + 2 * l) return;
#endif
        for (int rep = 0; rep < REPS(8, l); ++rep) { topk_phase(F, l); GRID_BAR(); }
        {
            pg8::MoeMap mp{16, 0};
            const int nMv = first ? 16 * 34 : 16 * 32;
            for (int rep = 0; rep < REPS(9, l); ++rep) {
            {
                pg8::GuProb pb{(const void*)(F.ws + WS_ASORT), (const void*)(F.ws + WS_WGU), nullptr, D, mp};
                pg8::GridOrder S; S.init(nMv, 2 * FF / 256, F.G, F.bid);
                pg8::EpiGU E{F.ws + WS_BUFB, mp};
                pg8::gemm_phase(F.lds, F.tid, pb, S, E);
            }
            GRID_BAR();
            }
            for (int rep = 0; rep < REPS(10, l); ++rep) {
            {
                pg8::DownProb pb{(const void*)(F.ws + WS_BUFB), (const void*)(F.ws + WS_WD), nullptr, FF, mp};
                pg8::GridOrder S; S.init(nMv, D / 256, F.G, F.bid);
                pg8::EpiDown E{(bf16_t*)(F.ws + WS_BUFC), (const float*)(F.ws + WS_GATE), mp};
                pg8::gemm_phase(F.lds, F.tid, pb, S, E);
            }
            GRID_BAR();
            }
        }
        e5_phase(F, l);
        if (first) { __syncthreads(); convert_experts(F, 1); }
        GRID_BAR();
#if defined(DBG_STOP)
        if (DBG_STOP == 2 + 2 * l) return;
#endif
    }
}

extern "C" void kernel_launch(void* const* d_in, const int* in_sizes, int n_in, void* d_out, int out_size, void* d_ws, size_t ws_size, hipStream_t stream) {
    static int grid = 0;
    if (grid == 0) {
        if (n_in != 23 || out_size != NLAT * D || ws_size < WS_END) { fprintf(stderr, "kernel_launch: unexpected problem (n_in %d out %d ws %zu need %zu)\n", n_in, out_size, ws_size, (size_t)WS_END); grid = -1; return; }
        int dev = 0, cus = 0, per_cu = 0;
        if (hipGetDevice(&dev) != hipSuccess || hipDeviceGetAttribute(&cus, hipDeviceAttributeMultiprocessorCount, dev) != hipSuccess) { grid = -1; return; }
        if (hipFuncSetAttribute((const void*)hybrid_fwd, hipFuncAttributeMaxDynamicSharedMemorySize, LDS_BYTES) != hipSuccess) { fprintf(stderr, "kernel_launch: hipFuncSetAttribute failed\n"); grid = -1; return; }
        if (hipOccupancyMaxActiveBlocksPerMultiprocessor(&per_cu, (const void*)hybrid_fwd, NTHR, LDS_BYTES) != hipSuccess || per_cu < 1) { fprintf(stderr, "kernel_launch: occupancy query says %d\n", per_cu); (void)hipGetLastError(); grid = -1; return; }
        grid = cus;
    }
    if (grid < 0) return;
    (void)in_sizes;
    hipMemsetAsync((char*)d_ws + WS_CTL, 0, 65536, stream);
    Params p{};
    for (int i = 0; i < 23; ++i) p.in[i] = (const float*)d_in[i];
    p.out = (float*)d_out; p.ws = (unsigned char*)d_ws;
    hipLaunchKernelGGL(hybrid_fwd, dim3(grid), dim3(NTHR), LDS_BYTES, stream, p);
}
```

```cpp
#include <hip/hip_runtime.h>
#include <cstdio>
#include <cstdint>

#define LAS __attribute__((address_space(3)))
typedef unsigned short bf16_t;
typedef short bf16x8 __attribute__((ext_vector_type(8)));
typedef short bf16x4 __attribute__((ext_vector_type(4)));
typedef float f32x4 __attribute__((ext_vector_type(4)));
typedef float f32x2 __attribute__((ext_vector_type(2)));
typedef unsigned u32x4 __attribute__((ext_vector_type(4)));
typedef unsigned u32x2 __attribute__((ext_vector_type(2)));
typedef __bf16 bf16v2_t __attribute__((ext_vector_type(2)));

constexpr int D = 1024, NB = 16, SEQ = 4096, CTX = 256, NLAT = NB * SEQ, NCTX = NB * CTX, NT = NLAT + NCTX;
constexpr int PW = 2304;
constexpr int PF = 0, PQ = 256, PK = 640, PV = 768, PZ = 896, PX = 1280, PDT = 2176, INW = 2188;
constexpr int FF = 2816, NE = 16, EROWS = 8704;
constexpr int NCH = 34;
constexpr float EPS = 1e-6f;
constexpr int NWAVES = 8, NTHR = 512;

constexpr size_t al4k(size_t x) { return (x + 4095) & ~(size_t)4095; }
constexpr size_t WS_CTL = 0;
constexpr size_t WS_MOD = al4k(WS_CTL + 65536);
constexpr size_t WS_ROPE = al4k(WS_MOD + (size_t)2 * 17 * 6144 * 4);
constexpr size_t WS_HCTX = al4k(WS_ROPE + 64 * 16 * 2 * 4);
constexpr size_t WS_WIN = al4k(WS_HCTX + (size_t)NCTX * D * 4);
constexpr size_t WS_WOUT = al4k(WS_WIN + (size_t)2 * PW * D * 2);
constexpr size_t WS_WGU = al4k(WS_WOUT + (size_t)2 * D * D * 2);
constexpr size_t WS_WD = al4k(WS_WGU + (size_t)NE * 2 * FF * D * 2);
constexpr size_t WS_AFF = al4k(WS_WD + (size_t)NE * D * FF * 2);
constexpr size_t WS_ROWIDX = al4k(WS_AFF + (size_t)NT * 16 * 4);
constexpr size_t WS_GATE = al4k(WS_ROWIDX + (size_t)NE * EROWS * 4);
constexpr size_t WS_SLOT = al4k(WS_GATE + (size_t)NE * EROWS * 4);
constexpr size_t WS_DECAY = al4k(WS_SLOT + (size_t)NT * 16 * 2);
constexpr size_t WS_BUFA = al4k(WS_DECAY + (size_t)NB * NCH * 12 * 4);
constexpr size_t WS_BUFB = al4k(WS_BUFA + (size_t)NT * D * 2);
constexpr size_t WS_BUFC = al4k(WS_BUFB + (size_t)8 * EROWS * FF * 2);
constexpr size_t BC_XC = 0;
constexpr size_t BC_ST = al4k(BC_XC + (size_t)NT * 896 * 2);
constexpr size_t BC_FA = al4k(BC_ST + (size_t)NB * NCH * 12 * 8192 * 2);
constexpr size_t BC_END = al4k(BC_FA + (size_t)NB * 4 * 64 * 64 * 128 * 2);
static_assert(BC_END >= (size_t)NE * EROWS * D * 2, "y must fit the mixer-temporary region");
constexpr size_t WS_ASORT = WS_BUFC + BC_END;
constexpr size_t WS_END = al4k(WS_ASORT + (size_t)NE * EROWS * D);

constexpr int LDS_BYTES = 155648;
constexpr int MISC_OFF = 151552;

struct Params { const float* in[23]; float* out; unsigned char* ws; };

__device__ __forceinline__ float bf2f(bf16_t v) { return __uint_as_float((unsigned)v << 16); }
__device__ __forceinline__ unsigned pk2(float lo, float hi) { f32x2 v = {lo, hi}; bf16v2_t b = __builtin_convertvector(v, bf16v2_t); return __builtin_bit_cast(unsigned, b); }
__device__ __forceinline__ float lo2f(unsigned w) { return __uint_as_float(w << 16); }
__device__ __forceinline__ float hi2f(unsigned w) { return __uint_as_float(w & 0xffff0000u); }
__device__ __forceinline__ float wave_sum(float v) {
#pragma unroll
    for (int o = 1; o < 64; o <<= 1) v += __shfl_xor(v, o);
    return v;
}
__device__ __forceinline__ float siluf(float x) { return x / (1.f + __expf(-x)); }
__device__ __forceinline__ float softplusf(float x) { return fmaxf(x, 0.f) + log1pf(__expf(-fabsf(x))); }
__device__ __forceinline__ f32x4 mfma16(bf16x8 a, bf16x8 b, f32x4 c) { return __builtin_amdgcn_mfma_f32_16x16x32_bf16(a, b, c, 0, 0, 0); }
__device__ __forceinline__ bf16x8 frag_lds(const LAS bf16_t* base, int stride, int r0, int k0, int li, int gq) {
    return *(const LAS bf16x8*)(base + (r0 + li) * stride + k0 + 8 * gq);
}
__device__ __forceinline__ bf16x8 frag_glb(const bf16_t* base, size_t stride, int r0, int k0, int li, int gq) {
    return *(const bf16x8*)(base + (size_t)(r0 + li) * stride + k0 + 8 * gq);
}
__device__ __forceinline__ bf16x8 frag_tr(const LAS bf16_t* S, int stride, int k0, int n0, int li, int gq) {
    const LAS bf16_t* p = S + (k0 + 8 * gq + (li >> 2)) * stride + n0 + 4 * (li & 3);
    bf16x4 a = __builtin_amdgcn_ds_read_tr16_b64_v4i16((LAS bf16x4*)p);
    bf16x4 b = __builtin_amdgcn_ds_read_tr16_b64_v4i16((LAS bf16x4*)(p + 4 * stride));
    return (bf16x8){a[0], a[1], a[2], a[3], b[0], b[1], b[2], b[3]};
}
__device__ __forceinline__ bf16x8 frag_tr_split(const LAS bf16_t* S, int stride, int k0, int n0, int li, int gq) {
    const LAS bf16_t* p = S + (k0 + 4 * gq + (li >> 2)) * stride + n0 + 4 * (li & 3);
    bf16x4 a = __builtin_amdgcn_ds_read_tr16_b64_v4i16((LAS bf16x4*)p);
    bf16x4 b = __builtin_amdgcn_ds_read_tr16_b64_v4i16((LAS bf16x4*)(p + 16 * stride));
    return (bf16x8){a[0], a[1], a[2], a[3], b[0], b[1], b[2], b[3]};
}
__device__ __forceinline__ u32x2 pack4(f32x4 v) { u32x2 r; r.x = pk2(v[0], v[1]); r.y = pk2(v[2], v[3]); return r; }
#define LDS_FENCE() asm volatile("s_waitcnt lgkmcnt(0)" ::: "memory")

#define XB_TMO      128
#define XB_XCNT(j)  (256  + 64 * (j))
#define XB_XSUB(j)  (1280 + 64 * (j))
#define XB_XGEN(j)  (2304 + 64 * (j))
#define XB_TOP      3328
#define XB_TOPGEN   3392
#define XCD_BAR_WORDS 3456
#define XB_SPIN_CAP (1u << 22)
__device__ __forceinline__ unsigned xb_ld(unsigned* p)              { return __hip_atomic_load(p, __ATOMIC_RELAXED, __HIP_MEMORY_SCOPE_AGENT); }
__device__ __forceinline__ unsigned xb_add(unsigned* p, unsigned v) { return __hip_atomic_fetch_add(p, v, __ATOMIC_RELAXED, __HIP_MEMORY_SCOPE_AGENT); }
__device__ __forceinline__ unsigned xb_xcc_id() { return (unsigned)__builtin_amdgcn_s_getreg((3 << 11) | 20) & 0xFu; }
#define XB_SPIN(cond, bar) do { unsigned _sp = 0; while (cond) { __builtin_amdgcn_s_sleep(1); \
    if ((++_sp & 255u) == 0u) { if (xb_ld(&(bar)[XB_TMO])) break; if (_sp > XB_SPIN_CAP) { atomicAdd(&(bar)[XB_TMO], 1u); break; } } } } while (0)
struct XcdBarrier { unsigned* bar; unsigned x; volatile LAS unsigned* st; };
__device__ __forceinline__ XcdBarrier xcd_barrier_post(unsigned* bar, volatile LAS unsigned* st) {
    XcdBarrier b; b.bar = bar; b.x = xb_xcc_id(); b.st = st;
    if (threadIdx.x == 0) (void)xb_add(&bar[XB_XCNT(b.x)], 1u);
    return b;
}
__device__ __forceinline__ void xcd_barrier_complete(unsigned* bar, unsigned x, unsigned& nloc, unsigned& nx) {
    const unsigned G = gridDim.x * gridDim.y * gridDim.z;
    unsigned sum, cnt, mine, sp = 0u;
    for (;;) {
        sum = 0u; cnt = 0u; mine = 0u;
#pragma unroll
        for (unsigned j = 0; j < 16; ++j) { const unsigned c = xb_ld(&bar[XB_XCNT(j)]); sum += c; cnt += (c > 0u) ? 1u : 0u; mine = (j == x) ? c : mine; }
        if (sum == G) break;
        __builtin_amdgcn_s_sleep(1);
        if ((++sp & 255u) == 0u) { if (xb_ld(&bar[XB_TMO])) break; if (sp > XB_SPIN_CAP) { atomicAdd(&bar[XB_TMO], 1u); break; } }
    }
    nloc = mine > 0u ? mine : 1u; nx = cnt > 0u ? cnt : 1u;
}
__device__ __noinline__ void xcd_barrier_impl(unsigned* bar_, unsigned x_, volatile LAS unsigned* st_) {
    XcdBarrier b; b.bar = bar_; b.x = x_; b.st = st_;
    asm volatile("s_waitcnt vmcnt(0)" ::: "memory");
    __syncthreads();
    if (threadIdx.x == 0) {
        unsigned* bar = b.bar;
        __builtin_amdgcn_s_waitcnt(0);
        unsigned nloc = b.st[0], nx = b.st[1];
        if (nloc == 0u) { xcd_barrier_complete(bar, b.x, nloc, nx); b.st[0] = nloc; b.st[1] = nx; }
        const unsigned old = xb_add(&bar[XB_XSUB(b.x)], 1u);
        const unsigned gen = old / nloc;
        if (old + 1u == (gen + 1u) * nloc) {
            __builtin_amdgcn_fence(__ATOMIC_RELEASE, "agent");
            asm volatile("s_waitcnt vmcnt(0)" ::: "memory");
            const unsigned og = xb_add(&bar[XB_TOP], 1u);
            const unsigned tg = og / nx;
            if (og + 1u == (tg + 1u) * nx) xb_add(&bar[XB_TOPGEN], 1u);
            else XB_SPIN(xb_ld(&bar[XB_TOPGEN]) == tg, bar);
            __builtin_amdgcn_fence(__ATOMIC_ACQUIRE, "agent");
            xb_add(&bar[XB_XGEN(b.x)], 1u);
            asm volatile("s_waitcnt vmcnt(0)" ::: "memory");
        } else {
            XB_SPIN(xb_ld(&bar[XB_XGEN(b.x)]) == gen, bar);
            __builtin_amdgcn_fence(__ATOMIC_ACQUIRE, "agent");
            asm volatile("s_waitcnt vmcnt(0)" ::: "memory");
        }
    }
    __syncthreads();
}
__device__ __forceinline__ void xcd_barrier(const XcdBarrier& b) { xcd_barrier_impl(b.bar, b.x, b.st); }
namespace pg8 {
constexpr int BM = 256, BK = 64, HALF = 128, HTB = HALF * BK * 2, STAGE_BYTES = 8 * HTB, NXCD = 8, WGM = 8;
__host__ __device__ __forceinline__ int lds_byte(int r, int c) { const int st = (r >> 4) * 2 + (c >> 5), rr = r & 15, cc = c & 31, ob = rr * 64 + cc * 2; return st * 1024 + (ob ^ (((ob >> 9) & 1) << 5)); }
__host__ __device__ __forceinline__ void stage_rc(int b, int& R, int& C) { const int st = b / 1024, sb = b % 1024, swz = sb ^ (((sb >> 9) & 1) << 5); R = (st >> 1) * 16 + swz / 64; C = (st & 1) * 32 + (swz % 64) / 2; }
__host__ __device__ __forceinline__ int perm32(int rho) { const int n = rho >> 4, i = rho & 15; return 8 * (i >> 2) + 4 * n + (i & 3); }

struct Unit { int pm, pn; };
typedef int i32x4 __attribute__((ext_vector_type(4)));
typedef int i32x8 __attribute__((ext_vector_type(8)));
__device__ __forceinline__ bf16x8 lo8(i32x8 a) { return __builtin_bit_cast(bf16x8, (i32x4)__builtin_shufflevector(a, a, 0, 1, 2, 3)); }
__device__ __forceinline__ bf16x8 hi8(i32x8 a) { return __builtin_bit_cast(bf16x8, (i32x4)__builtin_shufflevector(a, a, 4, 5, 6, 7)); }
struct GridOrder {
    int nM, nN, nwg, G, c;
    __device__ __forceinline__ void init(int nM_, int nN_, int G_, int c_) { nM = nM_; nN = nN_; nwg = nM * nN; G = G_; c = c_; }
    __device__ __forceinline__ bool next(int i, Unit& u) const {
        const long L = (long)i * G + c; if (L >= nwg) return false;
        int wgid = (int)L; { const int q = nwg / NXCD, r = nwg % NXCD, xcd = wgid % NXCD, off = wgid / NXCD; wgid = (xcd < r ? xcd * (q + 1) : r * (q + 1) + (xcd - r) * q) + off; }
        const int nig = WGM * nN, gid = wgid / nig, fm = gid * WGM, gsz = (nM - fm) < WGM ? (nM - fm) : WGM;
        u.pm = fm + ((wgid % nig) % gsz); u.pn = (wgid % nig) / gsz; return true;
    }
};

template <class Prob, class Epi>
__device__ __forceinline__ void gemm_phase(LAS unsigned char* lds, const int tid, const Prob& Pb, const GridOrder& S, const Epi& E) {
    const int wid = __builtin_amdgcn_readfirstlane(tid >> 6), lane = tid & 63, wr = wid >> 2, wc = wid & 3, fr = lane & 15, fq = lane >> 4;
    constexpr int ES = Prob::ES;
    const int K = Pb.K, nt = K * ES / 128;
    unsigned voffA[2], voffB[2];
#pragma unroll
    for (int i = 0; i < 2; ++i) { int R, C; stage_rc(tid * 16 + i * 8192, R, C); const int Rb = Epi::PERM ? ((R & ~31) + perm32(R & 31)) : R;
        voffA[i] = (unsigned)(R * K * ES + C * 2); voffB[i] = (unsigned)(Rb * K * ES + C * 2); }
    const size_t kstep = (size_t)(BK * 2);
    const size_t hstep = (size_t)HALF * K * ES;
    const unsigned ldsw = (unsigned)wid * 1024u;
    const int aoff = lds_byte(wr * 64 + fr, fq * 8), boff = lds_byte(wc * 32 + fr, fq * 8);
#define PG8_SA(b, h) (((b) * 2 + (h)) * HTB)
#define PG8_SB(b, h) ((4 + (b) * 2 + (h)) * HTB)
#define PG8_STAGE(bufoff, gbase, voff) do { _Pragma("unroll") for (int _i = 0; _i < 2; ++_i) \
        __builtin_amdgcn_global_load_lds((const unsigned*)((const char*)(gbase) + (voff)[_i]), (LAS unsigned*)(lds + (bufoff) + ldsw + _i * 8192), 16, 0, 0); } while (0)
#define PG8_LDA(dst, b, h) do { _Pragma("unroll") for (int m = 0; m < 4; ++m) { const i32x4 _l0 = *(const LAS i32x4*)(lds + PG8_SA(b, h) + aoff + m * 2048), _l1 = *(const LAS i32x4*)(lds + PG8_SA(b, h) + aoff + m * 2048 + 1024); \
        dst[m] = __builtin_shufflevector(_l0, _l1, 0, 1, 2, 3, 4, 5, 6, 7); } } while (0)
#define PG8_LDB(dst, b, h) do { _Pragma("unroll") for (int n = 0; n < 2; ++n) { const i32x4 _l0 = *(const LAS i32x4*)(lds + PG8_SB(b, h) + boff + n * 2048), _l1 = *(const LAS i32x4*)(lds + PG8_SB(b, h) + boff + n * 2048 + 1024); \
        dst[n] = __builtin_shufflevector(_l0, _l1, 0, 1, 2, 3, 4, 5, 6, 7); } } while (0)
#define PG8_MMA(ai, bj, At, Bt) do { __builtin_amdgcn_s_setprio(1); _Pragma("unroll") for (int m = 0; m < 4; ++m) _Pragma("unroll") for (int n = 0; n < 2; ++n) { \
        if (ES == 2) { acc[ai][bj][m][n] = __builtin_amdgcn_mfma_f32_16x16x32_bf16(lo8(Bt[n]), lo8(At[m]), acc[ai][bj][m][n], 0, 0, 0); \
                       acc[ai][bj][m][n] = __builtin_amdgcn_mfma_f32_16x16x32_bf16(hi8(Bt[n]), hi8(At[m]), acc[ai][bj][m][n], 0, 0, 0); } \
        else { asm volatile("v_mfma_scale_f32_16x16x128_f8f6f4 %0, %1, %2, %0, %3, %3 op_sel_hi:[0,0,0]" : "+v"(acc[ai][bj][m][n]) : "v"(Bt[n]), "v"(At[m]), "v"(sc127)); DBG_EXTRA_MFMA(Bt[n], At[m]); } } \
        __builtin_amdgcn_s_setprio(0); } while (0)
#define PG8_WAIT_V(n) asm volatile("s_waitcnt vmcnt(" #n ")" ::: "memory")
#define PG8_WAIT_L(n) asm volatile("s_waitcnt lgkmcnt(" #n ")" ::: "memory")
#define PG8_BAR __builtin_amdgcn_s_barrier()
#define PG8_SCHED __builtin_amdgcn_sched_barrier(0)
    Unit cur, nxt; int ui = 0;
    if (!S.next(0, cur)) return;
#if defined(DBG_MFMA2)
    f32x4 dummy = {0.f, 0.f, 0.f, 0.f};
#define DBG_EXTRA_MFMA(b, a) asm volatile("v_mfma_scale_f32_16x16x128_f8f6f4 %0, %1, %2, %0, %3, %3 op_sel_hi:[0,0,0]" : "+v"(dummy) : "v"(b), "v"(a), "v"(sc127))
#else
#define DBG_EXTRA_MFMA(b, a) do {} while (0)
#endif
    int sc127 = 127; asm volatile("" : "+v"(sc127));
    f32x4 acc[2][2][4][2];
#pragma unroll
    for (int a = 0; a < 2; ++a)
#pragma unroll
        for (int b = 0; b < 2; ++b)
#pragma unroll
            for (int m = 0; m < 4; ++m)
#pragma unroll
                for (int n = 0; n < 2; ++n) acc[a][b][m][n] = (f32x4){0.f, 0.f, 0.f, 0.f};
    i32x8 At[4], B0[2], B1[2];
    const char* cA = (const char*)Pb.Abase + (size_t)Pb.a_row0(cur) * K * ES; const char* cB = (const char*)Pb.Btbase + (size_t)Pb.b_row0(cur) * K * ES;
    PG8_STAGE(PG8_SB(0, 0), cB, voffB); PG8_STAGE(PG8_SA(0, 0), cA, voffA); PG8_STAGE(PG8_SB(0, 1), cB + hstep, voffB); PG8_STAGE(PG8_SA(0, 1), cA + hstep, voffA);
    if (wr == 1) PG8_BAR;
    PG8_WAIT_V(4); PG8_BAR;
    PG8_STAGE(PG8_SB(1, 0), cB + kstep, voffB); PG8_STAGE(PG8_SA(1, 0), cA + kstep, voffA); PG8_STAGE(PG8_SB(1, 1), cB + hstep + kstep, voffB);
    PG8_WAIT_V(6); PG8_BAR;
    for (;;) {
        const bool has_next = S.next(ui + 1, nxt);
        const char* nA = has_next ? (const char*)Pb.Abase + (size_t)Pb.a_row0(nxt) * K * ES : cA; const char* nB = has_next ? (const char*)Pb.Btbase + (size_t)Pb.b_row0(nxt) * K * ES : cB;
        for (int t = 0; t < nt; t += 2) {
            const bool last = (t == nt - 2);
            const char* a1 = cA + (size_t)(t + 1) * kstep;
            const char* a2 = last ? nA : cA + (size_t)(t + 2) * kstep; const char* b2 = last ? nB : cB + (size_t)(t + 2) * kstep;
            const char* a3 = a2 + kstep; const char* b3 = b2 + kstep;
            PG8_LDB(B0, 0, 0); PG8_SCHED; PG8_LDA(At, 0, 0); PG8_STAGE(PG8_SA(1, 1), a1 + hstep, voffA);
            PG8_WAIT_L(8); PG8_BAR; PG8_WAIT_L(0); PG8_MMA(0, 0, At, B0); PG8_BAR; PG8_SCHED;
            PG8_LDB(B1, 0, 1); PG8_STAGE(PG8_SB(0, 0), b2, voffB);
            PG8_BAR; PG8_WAIT_L(0); PG8_MMA(0, 1, At, B1); PG8_BAR;
            PG8_LDA(At, 0, 1); PG8_STAGE(PG8_SA(0, 0), a2, voffA);
            PG8_BAR; PG8_WAIT_L(0); PG8_MMA(1, 0, At, B0); PG8_BAR; PG8_SCHED;
            PG8_STAGE(PG8_SB(0, 1), b2 + hstep, voffB);
            PG8_WAIT_V(6); PG8_BAR; PG8_MMA(1, 1, At, B1); PG8_BAR;
            PG8_LDB(B0, 1, 0); PG8_SCHED; PG8_LDA(At, 1, 0); PG8_STAGE(PG8_SA(0, 1), a2 + hstep, voffA);
            PG8_WAIT_L(8); PG8_BAR; PG8_WAIT_L(0); PG8_MMA(0, 0, At, B0); PG8_BAR; PG8_SCHED;
            PG8_LDB(B1, 1, 1); PG8_STAGE(PG8_SB(1, 0), b3, voffB);
            PG8_BAR; PG8_WAIT_L(0); PG8_MMA(0, 1, At, B1); PG8_BAR;
            PG8_LDA(At, 1, 1); PG8_STAGE(PG8_SA(1, 0), a3, voffA);
            PG8_BAR; PG8_WAIT_L(0); PG8_MMA(1, 0, At, B0); PG8_BAR; PG8_SCHED;
            PG8_STAGE(PG8_SB(1, 1), b3 + hstep, voffB);
            PG8_WAIT_V(6); PG8_BAR; PG8_MMA(1, 1, At, B1); PG8_BAR;
        }
        if (ES == 1) asm volatile("s_nop 15\n\ts_nop 15" ::: "memory");
        E(acc, cur, wr, wc, fr, fq);
        if (!has_next) break;
#pragma unroll
        for (int a = 0; a < 2; ++a)
#pragma unroll
            for (int b = 0; b < 2; ++b)
#pragma unroll
                for (int m = 0; m < 4; ++m)
#pragma unroll
                    for (int n = 0; n < 2; ++n) acc[a][b][m][n] = (f32x4){0.f, 0.f, 0.f, 0.f};
        cur = nxt; cA = nA; cB = nB; ++ui;
    }
    PG8_WAIT_V(0);
    if (wr == 0) PG8_BAR;
    PG8_BAR;
#undef PG8_SA
#undef PG8_SB
#undef PG8_STAGE
#undef PG8_LDA
#undef PG8_LDB
#undef PG8_MMA
#undef PG8_WAIT_V
#undef PG8_WAIT_L
#undef PG8_BAR
#undef PG8_SCHED
}
__device__ __forceinline__ unsigned cvt_pk_bf16(float lo, float hi) { unsigned r; asm volatile("v_cvt_pk_bf16_f32 %0, %1, %2" : "=v"(r) : "v"(lo), "v"(hi)); return r; }

struct DenseProb {
    static constexpr bool GATHER = false; static constexpr int ES = 2;
    const bf16_t* Abase; const bf16_t* Btbase; const int* rowidx; int K;
    __device__ __forceinline__ int a_row0(const Unit& u) const { return u.pm * BM; }
    __device__ __forceinline__ int b_row0(const Unit& u) const { return u.pn * BM; }
};
struct EpiBf16 {
    static constexpr bool PERM = true;
    bf16_t* O; int ldc;
    __device__ __forceinline__ void operator()(const f32x4 (&acc)[2][2][4][2], const Unit& u, int wr, int wc, int fr, int fq) const {
        const int row0 = u.pm * BM + wr * 64 + fr, col0 = u.pn * BM + wc * 32 + 8 * fq;
#pragma unroll
        for (int ai = 0; ai < 2; ++ai)
#pragma unroll
            for (int m = 0; m < 4; ++m) { bf16_t* rowp = O + (size_t)(row0 + ai * HALF + m * 16) * ldc + col0;
#pragma unroll
                for (int bj = 0; bj < 2; ++bj) { const f32x4 v0 = acc[ai][bj][m][0], v1 = acc[ai][bj][m][1];
                    u32x4 w; w.x = cvt_pk_bf16(v0[0], v0[1]); w.y = cvt_pk_bf16(v0[2], v0[3]); w.z = cvt_pk_bf16(v1[0], v1[1]); w.w = cvt_pk_bf16(v1[2], v1[3]);
                    *(u32x4*)(rowp + bj * HALF) = w; } }
    }
};
struct MoeMap { int EG, e0;
    __device__ __forceinline__ void split(int pm, int& el, int& mt) const { if (pm < EG * 32) { el = pm >> 5; mt = pm & 31; } else { const int q = pm - EG * 32; el = q >> 1; mt = 32 + (q & 1); } }
};
__device__ __forceinline__ unsigned pk4_fp8(float a, float b, float c, float d) {
    a = fminf(fmaxf(a, -448.f), 448.f); b = fminf(fmaxf(b, -448.f), 448.f); c = fminf(fmaxf(c, -448.f), 448.f); d = fminf(fmaxf(d, -448.f), 448.f);
    int w = 0; w = __builtin_amdgcn_cvt_pk_fp8_f32(a, b, w, false); w = __builtin_amdgcn_cvt_pk_fp8_f32(c, d, w, true); return (unsigned)w; }
struct GuProb {
    static constexpr bool GATHER = false; static constexpr int ES = 1;
    const void* Abase; const void* Btbase; const int* rowidx; int K; MoeMap mp;
    __device__ __forceinline__ int a_row0(const Unit& u) const { int el, mt; mp.split(u.pm, el, mt); return (mp.e0 + el) * EROWS + mt * BM; }
    __device__ __forceinline__ int b_row0(const Unit& u) const { int el, mt; mp.split(u.pm, el, mt); return (mp.e0 + el) * (2 * FF) + u.pn * BM; }
};
struct EpiGU {
    static constexpr bool PERM = true;
    unsigned char* he; MoeMap mp;
    __device__ __forceinline__ void operator()(const f32x4 (&acc)[2][2][4][2], const Unit& u, int wr, int wc, int fr, int fq) const {
        int el, mt; mp.split(u.pm, el, mt);
        const int row0 = el * EROWS + mt * BM + wr * 64 + fr, col0 = u.pn * HALF + wc * 32 + 8 * fq;
#pragma unroll
        for (int ai = 0; ai < 2; ++ai)
#pragma unroll
            for (int m = 0; m < 4; ++m) { unsigned char* rowp = he + (size_t)(row0 + ai * HALF + m * 16) * FF + col0;
                float o[8];
#pragma unroll
                for (int n = 0; n < 2; ++n)
#pragma unroll
                    for (int j = 0; j < 4; ++j) { const float g = acc[ai][0][m][n][j] * (1.f / 128.f), up = acc[ai][1][m][n][j] * (1.f / 128.f); o[n * 4 + j] = g / (1.f + __expf(-g)) * up * 8.f; }
                u32x2 w; w.x = pk4_fp8(o[0], o[1], o[2], o[3]); w.y = pk4_fp8(o[4], o[5], o[6], o[7]);
                *(u32x2*)rowp = w; }
    }
};
struct DownProb {
    static constexpr bool GATHER = false; static constexpr int ES = 1;
    const void* Abase; const void* Btbase; const int* rowidx; int K; MoeMap mp;
    __device__ __forceinline__ int a_row0(const Unit& u) const { int el, mt; mp.split(u.pm, el, mt); return el * EROWS + mt * BM; }
    __device__ __forceinline__ int b_row0(const Unit& u) const { int el, mt; mp.split(u.pm, el, mt); return (mp.e0 + el) * D + u.pn * BM; }
};
struct EpiDown {
    static constexpr bool PERM = true;
    bf16_t* y; const float* gate; MoeMap mp;
    __device__ __forceinline__ void operator()(const f32x4 (&acc)[2][2][4][2], const Unit& u, int wr, int wc, int fr, int fq) const {
        int el, mt; mp.split(u.pm, el, mt);
        const int row0 = (mp.e0 + el) * EROWS + mt * BM + wr * 64 + fr, col0 = u.pn * BM + wc * 32 + 8 * fq;
#pragma unroll
        for (int ai = 0; ai < 2; ++ai)
#pragma unroll
            for (int m = 0; m < 4; ++m) { const int row = row0 + ai * HALF + m * 16; const float g = gate[row] * (1.f / 2048.f); bf16_t* rowp = y + (size_t)row * D + col0;
#pragma unroll
                for (int bj = 0; bj < 2; ++bj) { const f32x4 v0 = acc[ai][bj][m][0] * g, v1 = acc[ai][bj][m][1] * g;
                    u32x4 w; w.x = cvt_pk_bf16(v0[0], v0[1]); w.y = cvt_pk_bf16(v0[2], v0[3]); w.z = cvt_pk_bf16(v1[0], v1[1]); w.w = cvt_pk_bf16(v1[2], v1[3]);
                    *(u32x4*)(rowp + bj * HALF) = w; } }
    }
};
}
struct Frame {
    LAS unsigned char* lds;
    int tid, lane, wave, G, bid;
    float* out; unsigned char* ws;
};
__device__ __forceinline__ const float* INP(int i) {
    const __attribute__((address_space(4))) char* k = (const __attribute__((address_space(4))) char*)__builtin_amdgcn_kernarg_segment_ptr();
    asm volatile("" : "+s"(k));
    return *(const float* const __attribute__((address_space(4)))*)(k + 8 * i);
}
#define IN_X 0
#define IN_C 1
#define IN_CTX 2
#define IN_CCTX 3
#define IN_WADA 4
#define IN_BADA 5
#define IN_GMIXPRE 6
#define IN_GMIXPOST 7
#define IN_GFFNPRE 8
#define IN_GFFNPOST 9
#define IN_WIN 10
#define IN_CONVW 11
#define IN_CONVB 12
#define IN_DTBIAS 13
#define IN_ALOG 14
#define IN_DSKIP 15
#define IN_GSSD 16
#define IN_SINK 17
#define IN_WOUT 18
#define IN_WROUTER 19
#define IN_WGATE 20
#define IN_WUP 21
#define IN_WDOWN 22

__device__ __forceinline__ const float* mod_ptr(const Frame& F, int l, int row  , int part  ) {
    return (const float*)(F.ws + WS_MOD) + ((size_t)(l * 17 + row) * 6144 + part * 1024);
}
__device__ __forceinline__ int tok_modrow(int row) { return row < NLAT ? (row >> 12) : 16; }

template <class RowMap>
__device__ __forceinline__ void transpose_item(const float* W, int K, int N, bf16_t* WT, RowMap rm, LAS float* scr, int kb, int nb, int lane) {
    const int k0 = 64 * kb, n0 = 32 * nb;
    const int nn = n0 + (lane & 31);
#pragma unroll 8
    for (int i = 0; i < 32; ++i) { const int kk = 2 * i + (lane >> 5); scr[kk * 33 + (lane & 31)] = (nn < N) ? W[(size_t)(k0 + kk) * N + nn] : 0.f; }
    LDS_FENCE();
    const int c = lane & 7;
#pragma unroll
    for (int j = 0; j < 4; ++j) { const int n = (lane >> 3) + 8 * j; const LAS float* s = scr + (8 * c) * 33 + n;
        u32x4 o; o.x = pk2(s[0 * 33], s[1 * 33]); o.y = pk2(s[2 * 33], s[3 * 33]); o.z = pk2(s[4 * 33], s[5 * 33]); o.w = pk2(s[6 * 33], s[7 * 33]);
        *(u32x4*)(WT + (size_t)rm(n0 + n) * K + k0 + 8 * c) = o; }
    LDS_FENCE();
}
struct RmId { __device__ __forceinline__ int operator()(int n) const { return n; } };
struct RmGU { int s; __device__ __forceinline__ int operator()(int n) const { return 256 * (n >> 7) + 128 * s + (n & 127); } };
template <class RowMap>
__device__ __forceinline__ void transpose_item_fp8(const float* W, int K, int N, unsigned char* WT, RowMap rm, float scale, LAS float* scr, int kb, int nb, int lane) {
    const int k0 = 64 * kb, n0 = 32 * nb;
#pragma unroll 8
    for (int i = 0; i < 32; ++i) { const int kk = 2 * i + (lane >> 5); scr[kk * 33 + (lane & 31)] = W[(size_t)(k0 + kk) * N + n0 + (lane & 31)] * scale; }
    LDS_FENCE();
    const int c = lane & 7;
#pragma unroll
    for (int j = 0; j < 4; ++j) { const int n = (lane >> 3) + 8 * j; const LAS float* s = scr + (8 * c) * 33 + n;
        u32x2 o; o.x = pg8::pk4_fp8(s[0 * 33], s[1 * 33], s[2 * 33], s[3 * 33]); o.y = pg8::pk4_fp8(s[4 * 33], s[5 * 33], s[6 * 33], s[7 * 33]);
        *(u32x2*)(WT + (size_t)rm(n0 + n) * K + k0 + 8 * c) = o; }
    LDS_FENCE();
}

__device__ __forceinline__ void convert_experts(const Frame& F, int l) {
    LAS float* scr = (LAS float*)(F.lds + F.wave * 16384);
    const int gw = F.bid * NWAVES + F.wave, NGW = F.G * NWAVES;
    constexpr int I_G = 16 * 88, I_D = 44 * 32;
    constexpr int PER_E = 2 * I_G + I_D;
    unsigned char* Wgu = F.ws + WS_WGU; unsigned char* Wd = F.ws + WS_WD;
    for (int it = gw; it < NE * PER_E; it += NGW) {
        const int e = it / PER_E; int r = it % PER_E;
        if (r < I_G) { transpose_item_fp8(INP(IN_WGATE) + (size_t)(l * NE + e) * D * FF, D, FF, Wgu + (size_t)e * 2 * FF * D, RmGU{0}, 128.f, scr, r / 88, r % 88, F.lane); continue; } r -= I_G;
        if (r < I_G) { transpose_item_fp8(INP(IN_WUP) + (size_t)(l * NE + e) * D * FF, D, FF, Wgu + (size_t)e * 2 * FF * D, RmGU{1}, 128.f, scr, r / 88, r % 88, F.lane); continue; } r -= I_G;
        transpose_item_fp8(INP(IN_WDOWN) + (size_t)(l * NE + e) * FF * D, FF, D, Wd + (size_t)e * D * FF, RmId{}, 256.f, scr, r / 32, r % 32, F.lane);
    }
}

__device__ __forceinline__ void p0_prologue(const Frame& F) {
    if (F.bid < 192) {
        LAS float* sc = (LAS float*)F.lds;
        LAS float* red = (LAS float*)(F.lds + 17 * 1024 * 4);
        for (int i = F.tid; i < 17 * 1024; i += NTHR) { const int r = i >> 10, k = i & 1023; const float v = r < 16 ? INP(IN_C)[r * 1024 + k] : INP(IN_CCTX)[k]; sc[i] = siluf(v); }
        __syncthreads();
        const int l = F.bid / 96, n0 = (F.bid % 96) * 64;
        const float* W = INP(IN_WADA) + (size_t)l * D * 6144 + n0 + F.lane;
        float acc[17];
#pragma unroll
        for (int r = 0; r < 17; ++r) acc[r] = 0.f;
        for (int k = F.wave; k < 1024; k += 8) { const float w = W[(size_t)k * 6144];
#pragma unroll
            for (int r = 0; r < 17; ++r) acc[r] += sc[r * 1024 + k] * w; }
#pragma unroll
        for (int r = 0; r < 17; ++r) red[(F.wave * 17 + r) * 64 + F.lane] = acc[r];
        __syncthreads();
        for (int i = F.tid; i < 17 * 64; i += NTHR) { const int r = i >> 6, c = i & 63; float s = 0.f;
#pragma unroll
            for (int w = 0; w < 8; ++w) s += red[(w * 17 + r) * 64 + c];
            ((float*)(F.ws + WS_MOD))[(size_t)(l * 17 + r) * 6144 + n0 + c] = s + INP(IN_BADA)[l * 6144 + n0 + c]; }
        __syncthreads();
    }
    if (F.bid == 255) {
        for (int i = F.tid; i < 1024; i += NTHR) { const int pos = i >> 4, f = i & 15; const float inv = powf(10000.f, -(float)f / 16.f); const float ang = (float)pos * inv;
            ((float*)(F.ws + WS_ROPE))[2 * i] = cosf(ang); ((float*)(F.ws + WS_ROPE))[2 * i + 1] = sinf(ang); }
    }
    {
        LAS float* scr = (LAS float*)(F.lds + F.wave * 16384);
        const int gw = F.bid * NWAVES + F.wave, NGW = F.G * NWAVES;
        constexpr int I_IN = 16 * 72, I_OUT = 16 * 32;
        for (int it = gw; it < 2 * (I_IN + I_OUT); it += NGW) {
            const int l = it / (I_IN + I_OUT); int r = it % (I_IN + I_OUT);
            if (r < I_IN) { transpose_item(INP(IN_WIN) + (size_t)l * D * INW, D, INW, (bf16_t*)(F.ws + WS_WIN) + (size_t)l * PW * D, RmId{}, scr, r / 72, r % 72, F.lane); continue; } r -= I_IN;
            transpose_item(INP(IN_WOUT) + (size_t)l * D * D, D, D, (bf16_t*)(F.ws + WS_WOUT) + (size_t)l * D * D, RmId{}, scr, r / 32, r % 32, F.lane);
        }
    }
    convert_experts(F, 0);
}

struct Row16 { f32x4 v[4]; };
__device__ __forceinline__ Row16 ld_row_f32(const float* p, int lane) { Row16 r; const f32x4* q = (const f32x4*)p + lane;
#pragma unroll
    for (int j = 0; j < 4; ++j) r.v[j] = q[64 * j];
    return r; }
__device__ __forceinline__ void st_row_f32(float* p, int lane, const Row16& r) { f32x4* q = (f32x4*)p + lane;
#pragma unroll
    for (int j = 0; j < 4; ++j) q[64 * j] = r.v[j]; }
__device__ __forceinline__ Row16 ld_row_bf16(const bf16_t* p, int lane) { Row16 r; const u32x2* q = (const u32x2*)p + lane;
#pragma unroll
    for (int j = 0; j < 4; ++j) { const u32x2 w = q[64 * j]; r.v[j] = (f32x4){lo2f(w.x), hi2f(w.x), lo2f(w.y), hi2f(w.y)}; }
    return r; }
__device__ __forceinline__ void st_row_bf16(bf16_t* p, int lane, const Row16& r) { u32x2* q = (u32x2*)p + lane;
#pragma unroll
    for (int j = 0; j < 4; ++j) { u32x2 w; w.x = pk2(r.v[j][0], r.v[j][1]); w.y = pk2(r.v[j][2], r.v[j][3]); q[64 * j] = w; } }
__device__ __forceinline__ float row_rstd(const Row16& r) { float s = 0.f;
#pragma unroll
    for (int j = 0; j < 4; ++j) s += (r.v[j][0] * r.v[j][0] + r.v[j][1] * r.v[j][1]) + (r.v[j][2] * r.v[j][2] + r.v[j][3] * r.v[j][3]);
    return rsqrtf(wave_sum(s) * (1.f / D) + EPS); }
__device__ __forceinline__ Row16 norm_mod(const Row16& h, const float* g, const float* sh, const float* sc, int lane) {
    const float rstd = row_rstd(h); const Row16 G = ld_row_f32(g, lane), SH = ld_row_f32(sh, lane), SC = ld_row_f32(sc, lane); Row16 u;
#pragma unroll
    for (int j = 0; j < 4; ++j) u.v[j] = (h.v[j] * rstd * G.v[j]) * (SC.v[j] + 1.f) + SH.v[j];
    return u; }

struct RawRow8 { u32x2 w[4]; };
__device__ __forceinline__ RawRow8 ld_raw_bf16(const bf16_t* p, int lane) { RawRow8 r; const u32x2* q = (const u32x2*)p + lane;
#pragma unroll
    for (int j = 0; j < 4; ++j) r.w[j] = q[64 * j];
    return r; }
__device__ __forceinline__ Row16 cvt_raw(const RawRow8& r) { Row16 o;
#pragma unroll
    for (int j = 0; j < 4; ++j) o.v[j] = (f32x4){lo2f(r.w[j].x), hi2f(r.w[j].x), lo2f(r.w[j].y), hi2f(r.w[j].y)};
    return o; }
__device__ __forceinline__ Row16 row_mul(const Row16& a, const Row16& b) { Row16 o;
#pragma unroll
    for (int j = 0; j < 4; ++j) o.v[j] = a.v[j] * b.v[j];
    return o; }
__device__ __forceinline__ Row16 row_mul1p(const Row16& a, const Row16& b) { Row16 o;
#pragma unroll
    for (int j = 0; j < 4; ++j) o.v[j] = a.v[j] * (b.v[j] + 1.f);
    return o; }

__device__ __forceinline__ void e1_phase(const Frame& F) {
    const int gw = F.bid * NWAVES + F.wave, NGW = F.G * NWAVES, rpw = (NT + NGW - 1) / NGW;
    const int r0 = gw * rpw, r1 = (r0 + rpw < NT) ? r0 + rpw : NT;
    bf16_t* U = (bf16_t*)(F.ws + WS_BUFA);
    int cur = -1; Row16 Bv, Cv;
#define E1_SRC(r) ((r) < NLAT ? INP(IN_X) + (size_t)(r) * D : INP(IN_CTX) + (size_t)((r) - NLAT) * D)
    Row16 hN; if (r0 < r1) hN = ld_row_f32(E1_SRC(r0), F.lane);
    for (int row = r0; row < r1; ++row) {
        const Row16 h = hN;
        if (row + 1 < r1) hN = ld_row_f32(E1_SRC(row + 1), F.lane);
        const int mr = tok_modrow(row);
        if (mr != cur) { cur = mr; Bv = row_mul1p(ld_row_f32(INP(IN_GMIXPRE), F.lane), ld_row_f32(mod_ptr(F, 0, mr, 1), F.lane)); Cv = ld_row_f32(mod_ptr(F, 0, mr, 0), F.lane); }
        const float rstd = row_rstd(h); Row16 u;
#pragma unroll
        for (int j = 0; j < 4; ++j) u.v[j] = h.v[j] * rstd * Bv.v[j] + Cv.v[j];
        st_row_bf16(U + (size_t)row * D, F.lane, u);
    }
#undef E1_SRC
}

__device__ __forceinline__ void e3_phase(const Frame& F, int l) {
    const int nrows = (l == 0) ? NT : NLAT;
    LAS float* wr = (LAS float*)F.lds;
    for (int i = F.tid; i < 1024 * 16; i += NTHR) wr[(i & 15) * 1024 + (i >> 4)] = INP(IN_WROUTER)[(size_t)l * D * 16 + i];
    __syncthreads();
    const int gw = F.bid * NWAVES + F.wave, NGW = F.G * NWAVES, rpw = (nrows + NGW - 1) / NGW;
    const int r0 = gw * rpw, r1 = (r0 + rpw < nrows) ? r0 + rpw : nrows;
    const bf16_t* M = (const bf16_t*)(F.ws + WS_BUFB); unsigned char* U2 = F.ws + WS_BUFA; float* AFF = (float*)(F.ws + WS_AFF);
    const float* xin = INP(IN_X); const float* cin = INP(IN_CTX);
#define E3_HSRC(r) ((r) < NLAT ? ((l == 0) ? xin + (size_t)(r) * D : F.out + (size_t)(r) * D) : cin + (size_t)((r) - NLAT) * D)
    int cur = -1; Row16 Av, Bv, Cv;
    RawRow8 mN; Row16 hN;
    if (r0 < r1) { mN = ld_raw_bf16(M + (size_t)r0 * D, F.lane); hN = ld_row_f32(E3_HSRC(r0), F.lane); }
    for (int row = r0; row < r1; ++row) {
        const Row16 m = cvt_raw(mN); Row16 h = hN;
        if (row + 1 < r1) { mN = ld_raw_bf16(M + (size_t)(row + 1) * D, F.lane); hN = ld_row_f32(E3_HSRC(row + 1), F.lane); }
        const int mr = tok_modrow(row);
        if (mr != cur) { cur = mr;
            Av = row_mul(ld_row_f32(INP(IN_GMIXPOST) + l * D, F.lane), ld_row_f32(mod_ptr(F, l, mr, 2), F.lane));
            Bv = row_mul1p(ld_row_f32(INP(IN_GFFNPRE) + l * D, F.lane), ld_row_f32(mod_ptr(F, l, mr, 4), F.lane));
            Cv = ld_row_f32(mod_ptr(F, l, mr, 3), F.lane); }
        float* hdst = row < NLAT ? F.out + (size_t)row * D : (float*)(F.ws + WS_HCTX) + (size_t)(row - NLAT) * D;
        { const float rstd = row_rstd(m);
#pragma unroll
          for (int j = 0; j < 4; ++j) h.v[j] = h.v[j] + Av.v[j] * (m.v[j] * rstd); }
        st_row_f32(hdst, F.lane, h);
        Row16 u;
        { const float rstd = row_rstd(h);
#pragma unroll
          for (int j = 0; j < 4; ++j) u.v[j] = h.v[j] * rstd * Bv.v[j] + Cv.v[j]; }
        { unsigned* q8 = (unsigned*)(U2 + (size_t)row * D) + F.lane;
#pragma unroll
          for (int j = 0; j < 4; ++j) q8[64 * j] = pg8::pk4_fp8(u.v[j][0], u.v[j][1], u.v[j][2], u.v[j][3]); }
        float lg[16];
#pragma unroll
        for (int e = 0; e < 16; ++e) { float s = 0.f;
#pragma unroll
            for (int j = 0; j < 4; ++j) { const f32x4 w = *(const LAS f32x4*)(wr + e * 1024 + 4 * F.lane + 256 * j); s += u.v[j][0] * w[0] + u.v[j][1] * w[1] + u.v[j][2] * w[2] + u.v[j][3] * w[3]; }
            lg[e] = s; if ((e & 3) == 3) __builtin_amdgcn_sched_barrier(0); }
        {
            const bool b5 = F.lane & 32, b4 = F.lane & 16, b3 = F.lane & 8, b2 = F.lane & 4;
#pragma unroll
            for (int i = 0; i < 8; ++i) { const float snd = b5 ? lg[i] : lg[i + 8], keep = b5 ? lg[i + 8] : lg[i]; lg[i] = keep + __shfl_xor(snd, 32); }
#pragma unroll
            for (int i = 0; i < 4; ++i) { const float snd = b4 ? lg[i] : lg[i + 4], keep = b4 ? lg[i + 4] : lg[i]; lg[i] = keep + __shfl_xor(snd, 16); }
#pragma unroll
            for (int i = 0; i < 2; ++i) { const float snd = b3 ? lg[i] : lg[i + 2], keep = b3 ? lg[i + 2] : lg[i]; lg[i] = keep + __shfl_xor(snd, 8); }
            { const float snd = b2 ? lg[0] : lg[1], keep = b2 ? lg[1] : lg[0]; lg[0] = keep + __shfl_xor(snd, 4); }
            float v = lg[0]; v += __shfl_xor(v, 2); v += __shfl_xor(v, 1);
            float mx = v; mx = fmaxf(mx, __shfl_xor(mx, 4)); mx = fmaxf(mx, __shfl_xor(mx, 8)); mx = fmaxf(mx, __shfl_xor(mx, 16)); mx = fmaxf(mx, __shfl_xor(mx, 32));
            const float ex = __expf(v - mx); float sm = ex; sm += __shfl_xor(sm, 4); sm += __shfl_xor(sm, 8); sm += __shfl_xor(sm, 16); sm += __shfl_xor(sm, 32);
            const int e = ((F.lane >> 5) & 1) * 8 + ((F.lane >> 4) & 1) * 4 + ((F.lane >> 3) & 1) * 2 + ((F.lane >> 2) & 1);
            if ((F.lane & 3) == 0) AFF[(size_t)row * 16 + e] = ex / sm;
        }
    }
#undef E3_HSRC
}

__device__ __forceinline__ void e5_phase(const Frame& F, int l) {
    const int nrows = (l == 0) ? NT : NLAT;
    const int gw = F.bid * NWAVES + F.wave, NGW = F.G * NWAVES, rpw = (nrows + NGW - 1) / NGW;
    const int r0 = gw * rpw, r1 = (r0 + rpw < nrows) ? r0 + rpw : nrows;
    const bf16_t* Y = (const bf16_t*)(F.ws + WS_BUFC); const short* SL = (const short*)(F.ws + WS_SLOT); bf16_t* U = (bf16_t*)(F.ws + WS_BUFA);
#define E5_HP(r) ((r) < NLAT ? F.out + (size_t)(r) * D : (float*)(F.ws + WS_HCTX) + (size_t)((r) - NLAT) * D)
    int cur = -1; Row16 Av, Bv, Cv;
    int slotN = -1; Row16 hN;
    if (r0 < r1) { slotN = (F.lane < 16) ? (int)SL[(size_t)r0 * 16 + F.lane] : -1; hN = ld_row_f32(E5_HP(r0), F.lane); }
    for (int row = r0; row < r1; ++row) {
        const int myslot = slotN; Row16 h = hN;
        Row16 f;
#pragma unroll
        for (int j = 0; j < 4; ++j) f.v[j] = (f32x4){0.f, 0.f, 0.f, 0.f};
        for (int e = 0; e < 16; ++e) { const int sl = __shfl(myslot, e);
            if (sl >= 0) { const Row16 y = ld_row_bf16(Y + ((size_t)e * EROWS + sl) * D, F.lane);
#pragma unroll
                for (int j = 0; j < 4; ++j) f.v[j] += y.v[j]; } }
        if (row + 1 < r1) { slotN = (F.lane < 16) ? (int)SL[(size_t)(row + 1) * 16 + F.lane] : -1; hN = ld_row_f32(E5_HP(row + 1), F.lane); }
        const int mr = tok_modrow(row);
        if (mr != cur) { cur = mr;
            Av = row_mul(ld_row_f32(INP(IN_GFFNPOST) + l * D, F.lane), ld_row_f32(mod_ptr(F, l, mr, 5), F.lane));
            if (l == 0) { Bv = row_mul1p(ld_row_f32(INP(IN_GMIXPRE) + D, F.lane), ld_row_f32(mod_ptr(F, 1, mr, 1), F.lane)); Cv = ld_row_f32(mod_ptr(F, 1, mr, 0), F.lane); } }
        { const float rstd = row_rstd(f);
#pragma unroll
          for (int j = 0; j < 4; ++j) h.v[j] = h.v[j] + Av.v[j] * (f.v[j] * rstd); }
        st_row_f32(E5_HP(row), F.lane, h);
        if (l == 0) { const float rstd = row_rstd(h); Row16 u;
#pragma unroll
            for (int j = 0; j < 4; ++j) u.v[j] = h.v[j] * rstd * Bv.v[j] + Cv.v[j];
            st_row_bf16(U + (size_t)row * D, F.lane, u); }
    }
#undef E5_HP
}

__device__ __forceinline__ void topk_unit(const Frame& F, int kind, int e, int b) {
    const int T = kind ? CTX : SEQ, cap = kind ? 32 : 512;
    const int row0 = kind ? NLAT + b * CTX : b * SEQ, base = kind ? 8192 + b * 32 : b * 512;
    LAS unsigned long long* key = (LAS unsigned long long*)F.lds;
    const float* AFF = (const float*)(F.ws + WS_AFF);
    for (int t = F.tid; t < T; t += NTHR) { const float a = AFF[(size_t)(row0 + t) * 16 + e]; key[t] = ((unsigned long long)__float_as_uint(a) << 32) | (unsigned)(0xFFFFFFFFu - (unsigned)t); }
    __syncthreads();
    for (int k = 2; k <= T; k <<= 1)
        for (int j = k >> 1; j > 0; j >>= 1) {
            for (int i = F.tid; i < T; i += NTHR) { const int x = i ^ j;
                if (x > i) { const unsigned long long a = key[i], c = key[x]; const bool desc = ((i & k) == 0);
                    if (desc ? (a < c) : (a > c)) { key[i] = c; key[x] = a; } } }
            __syncthreads();
        }
    int* RI = (int*)(F.ws + WS_ROWIDX); float* GT = (float*)(F.ws + WS_GATE); short* SL = (short*)(F.ws + WS_SLOT);
    for (int s = F.tid; s < T; s += NTHR) { const unsigned long long kk = key[s]; const int t = (int)(0xFFFFFFFFu - (unsigned)kk);
        if (s < cap) { RI[e * EROWS + base + s] = row0 + t; GT[e * EROWS + base + s] = __uint_as_float((unsigned)(kk >> 32)); SL[(size_t)(row0 + t) * 16 + e] = (short)(base + s); }
        else SL[(size_t)(row0 + t) * 16 + e] = (short)-1; }
    { const unsigned char* U8 = F.ws + WS_BUFA; unsigned char* AS = F.ws + WS_ASORT + ((size_t)e * EROWS + base) * D;
      for (int s = F.wave; s < cap; s += NWAVES) { const int t = (int)(0xFFFFFFFFu - (unsigned)key[s]);
          *(u32x4*)(AS + (size_t)s * D + 16 * F.lane) = *(const u32x4*)(U8 + (size_t)(row0 + t) * D + 16 * F.lane); } }
    __syncthreads();
}
__device__ __forceinline__ void topk_phase(const Frame& F, int l) {
    const int nunits = (l == 0) ? 512 : 256;
    for (int u = F.bid; u < nunits; u += F.G) { const int kind = u >> 8, e = (u & 255) >> 4, b = u & 15; topk_unit(F, kind, e, b); }
}
__device__ __forceinline__ void chunk_geom(int b, int c, int& rbase, int& t0, int& Tseg) {
    if (c < 2) { rbase = NLAT + b * CTX; t0 = c * 128; Tseg = CTX; } else { rbase = b * SEQ; t0 = (c - 2) * 128; Tseg = SEQ; }
}
__device__ __forceinline__ size_t st_index(int b, int c, int dir, int h) { return ((((size_t)b * NCH + c) * 2 + dir) * 6 + h) * 8192; }

__device__ __forceinline__ void dt_scan(const Frame& F, int l, const bf16_t* Pp, int row0, int dir, int h, float (&dt)[2], float (&incl)[2], float (&dA)[2], float& total) {
    const float bias = INP(IN_DTBIAS)[(l * 2 + dir) * 6 + h], a = -__expf(INP(IN_ALOG)[(l * 2 + dir) * 6 + h]);
#pragma unroll
    for (int q = 0; q < 2; ++q) { const float raw = bf2f(Pp[(size_t)(row0 + 2 * F.lane + q) * PW + PDT + dir * 6 + h]); dt[q] = softplusf(raw + bias); dA[q] = dt[q] * a; }
    float x = dA[0] + dA[1];
#pragma unroll
    for (int o = 1; o < 64; o <<= 1) { const float v = __shfl_up(x, o); if (F.lane >= o) x += v; }
    incl[1] = x; incl[0] = x - dA[1];
    total = __shfl(x, 63);
}

__device__ __forceinline__ void s1_unit(const Frame& F, int l, int b, int c, int g) {
    int rbase, t0, Tseg; chunk_geom(b, c, rbase, t0, Tseg);
    LAS bf16_t* Xs = (LAS bf16_t*)F.lds;
    LAS bf16_t* Bs = (LAS bf16_t*)(F.lds + 51200);
    LAS float* WF = (LAS float*)(F.lds + 86016);
    LAS float* WB = (LAS float*)(F.lds + 87552);
    const bf16_t* Pp = (const bf16_t*)(F.ws + WS_BUFB);
    bf16_t* XC = (bf16_t*)(F.ws + WS_BUFC + BC_XC);
    __syncthreads();
    if (F.tid < 448) {
        const int cg = F.tid % 56, run = F.tid / 56;
        const int ch = cg < 24 ? g * 192 + cg * 8 : (cg < 40 ? 384 + g * 128 + (cg - 24) * 8 : 640 + g * 128 + (cg - 40) * 8);
        float w[5][8], bias[8];
#pragma unroll
        for (int k = 0; k < 5; ++k) { const f32x4 a = *(const f32x4*)(INP(IN_CONVW) + (size_t)(l * 5 + k) * 896 + ch), bb = *(const f32x4*)(INP(IN_CONVW) + (size_t)(l * 5 + k) * 896 + ch + 4);
#pragma unroll
            for (int q = 0; q < 4; ++q) { w[k][q] = a[q]; w[k][4 + q] = bb[q]; } }
        { const f32x4 a = *(const f32x4*)(INP(IN_CONVB) + l * 896 + ch), bb = *(const f32x4*)(INP(IN_CONVB) + l * 896 + ch + 4);
#pragma unroll
          for (int q = 0; q < 4; ++q) { bias[q] = a[q]; bias[4 + q] = bb[q]; } }
        const int tt0 = 16 * run;
        u32x4 rows[20];
#pragma unroll
        for (int i = 0; i < 20; ++i) { const int t = t0 + tt0 + i - 2;
            rows[i] = (t >= 0 && t < Tseg) ? *(const u32x4*)(Pp + (size_t)(rbase + t) * PW + PX + ch) : (u32x4){0u, 0u, 0u, 0u}; }
#pragma unroll
        for (int i = 0; i < 16; ++i) {
            float o[8];
#pragma unroll
            for (int q = 0; q < 8; ++q) o[q] = bias[q];
#pragma unroll
            for (int k = 0; k < 5; ++k) { const u32x4 v = rows[i + k];
                o[0] += w[k][0] * lo2f(v.x); o[1] += w[k][1] * hi2f(v.x); o[2] += w[k][2] * lo2f(v.y); o[3] += w[k][3] * hi2f(v.y);
                o[4] += w[k][4] * lo2f(v.z); o[5] += w[k][5] * hi2f(v.z); o[6] += w[k][6] * lo2f(v.w); o[7] += w[k][7] * hi2f(v.w); }
#pragma unroll
            for (int q = 0; q < 8; ++q) o[q] = siluf(o[q]);
            u32x4 pk; pk.x = pk2(o[0], o[1]); pk.y = pk2(o[2], o[3]); pk.z = pk2(o[4], o[5]); pk.w = pk2(o[6], o[7]);
            *(u32x4*)(XC + (size_t)(rbase + t0 + tt0 + i) * 896 + ch) = pk;
            if (cg < 24) *(LAS u32x4*)(Xs + (tt0 + i) * 200 + cg * 8) = pk;
            else if (cg < 40) *(LAS u32x4*)(Bs + (tt0 + i) * 136 + (cg - 24) * 8) = pk;
        }
    }
    if (F.wave < 6) {
        const int dir = F.wave / 3, r = F.wave % 3, h = g * 3 + r;
        float dt[2], incl[2], dA[2], total;
        dt_scan(F, l, Pp, rbase + t0, dir, h, dt, incl, dA, total);
#pragma unroll
        for (int q = 0; q < 2; ++q) {
            const float wgt = dir == 0 ? dt[q] * __expf(total - incl[q]) : dt[q] * __expf(incl[q] - dA[q]);
            (dir == 0 ? WF : WB)[r * 128 + 2 * F.lane + q] = wgt; }
        if (F.lane == 0) ((float*)(F.ws + WS_DECAY))[((b * NCH + c) * 2 + dir) * 6 + h] = __expf(total);
    }
    __syncthreads();
    {
        const int li = F.lane & 15, gq = F.lane >> 4, pt = F.wave & 3, nh = F.wave >> 2;
        bf16x8 fn[4][4];
#pragma unroll
        for (int ks = 0; ks < 4; ++ks)
#pragma unroll
            for (int nt = 0; nt < 4; ++nt) fn[ks][nt] = frag_tr(Bs, 136, 32 * ks, 16 * (4 * nh + nt), li, gq);
        bf16_t* ST = (bf16_t*)(F.ws + WS_BUFC + BC_ST);
#pragma unroll 1
        for (int combo = 0; combo < 6; ++combo) {
            const int dir = combo / 3, r = combo % 3, h = g * 3 + r;
            const LAS float* W = (dir == 0 ? WF : WB) + r * 128;
            f32x4 acc[4];
#pragma unroll
            for (int nt = 0; nt < 4; ++nt) acc[nt] = (f32x4){0.f, 0.f, 0.f, 0.f};
#pragma unroll
            for (int ks = 0; ks < 4; ++ks) {
                const bf16x8 xr = frag_tr(Xs, 200, 32 * ks, r * 64 + 16 * pt, li, gq);
                const f32x4 w0 = *(const LAS f32x4*)(W + 32 * ks + 8 * gq), w1 = *(const LAS f32x4*)(W + 32 * ks + 8 * gq + 4);
                u32x4 pw;
                pw.x = pk2(bf2f((bf16_t)xr[0]) * w0[0], bf2f((bf16_t)xr[1]) * w0[1]); pw.y = pk2(bf2f((bf16_t)xr[2]) * w0[2], bf2f((bf16_t)xr[3]) * w0[3]);
                pw.z = pk2(bf2f((bf16_t)xr[4]) * w1[0], bf2f((bf16_t)xr[5]) * w1[1]); pw.w = pk2(bf2f((bf16_t)xr[6]) * w1[2], bf2f((bf16_t)xr[7]) * w1[3]);
                const bf16x8 xw = __builtin_bit_cast(bf16x8, pw);
#pragma unroll
                for (int nt = 0; nt < 4; ++nt) acc[nt] = mfma16(fn[ks][nt], xw, acc[nt]);
            }
            bf16_t* dst = ST + st_index(b, c, dir, h) + (size_t)(16 * pt + li) * 128;
#pragma unroll
            for (int nt = 0; nt < 4; ++nt) *(u32x2*)(dst + 16 * (4 * nh + nt) + 4 * gq) = pack4(acc[nt]);
        }
    }
}

__device__ __forceinline__ void s2_phase(const Frame& F) {
    bf16_t* ST = (bf16_t*)(F.ws + WS_BUFC + BC_ST); const float* DEC = (const float*)(F.ws + WS_DECAY);
    for (int it = F.bid * NTHR + F.tid; it < NB * 2 * 6 * 64 * 16; it += F.G * NTHR) {
        const int n8 = it & 15, p = (it >> 4) & 63, hh = (it >> 10) % 6, dir = ((it >> 10) / 6) & 1, b = (it >> 10) / 12;
        float hst[8];
#pragma unroll
        for (int q = 0; q < 8; ++q) hst[q] = 0.f;
#pragma unroll 2
        for (int s = 0; s < NCH; ++s) {
            const int c = dir == 0 ? s : (s < 2 ? 1 - s : NCH + 1 - s);
            bf16_t* ptr = ST + st_index(b, c, dir, hh) + p * 128 + n8 * 8;
            const u32x4 v = *(const u32x4*)ptr;
            const float d = DEC[((b * NCH + c) * 2 + dir) * 6 + hh];
            u32x4 o; o.x = pk2(hst[0], hst[1]); o.y = pk2(hst[2], hst[3]); o.z = pk2(hst[4], hst[5]); o.w = pk2(hst[6], hst[7]);
            *(u32x4*)ptr = o;
            hst[0] = hst[0] * d + lo2f(v.x); hst[1] = hst[1] * d + hi2f(v.x); hst[2] = hst[2] * d + lo2f(v.y); hst[3] = hst[3] * d + hi2f(v.y);
            hst[4] = hst[4] * d + lo2f(v.z); hst[5] = hst[5] * d + hi2f(v.z); hst[6] = hst[6] * d + lo2f(v.w); hst[7] = hst[7] * d + hi2f(v.w);
        }
    }
}

__device__ __forceinline__ void s3_unit(const Frame& F, int l, int b, int c) {
    int rbase, t0, Tseg; chunk_geom(b, c, rbase, t0, Tseg);
    LAS bf16_t* Bs = (LAS bf16_t*)F.lds;
    LAS bf16_t* Xs = (LAS bf16_t*)(F.lds + 34816);
    LAS bf16_t* SCR = (LAS bf16_t*)(F.lds + 86016 + F.wave * 4352);
    LAS float* DTF = (LAS float*)(F.lds + 120832);
    LAS float* DTB = DTF + 384; LAS float* ACF = DTF + 768; LAS float* ACB = DTF + 1152;
    const bf16_t* Pp = (const bf16_t*)(F.ws + WS_BUFB);
    const bf16_t* XC = (const bf16_t*)(F.ws + WS_BUFC + BC_XC);
    const bf16_t* ST = (const bf16_t*)(F.ws + WS_BUFC + BC_ST);
    bf16_t* MIX = (bf16_t*)(F.ws + WS_BUFA);
    const int li = F.lane & 15, gq = F.lane >> 4, w = F.wave;
    const int itok = 16 * w + li;
    const size_t grow = (size_t)(rbase + t0 + itok);
    float ss = 0.f;
#pragma unroll 1
    for (int g = 0; g < 2; ++g) {
        __syncthreads();
        for (int i = F.tid; i < 128 * 40; i += NTHR) { const int t = i / 40, cc = i % 40; const size_t rr = (size_t)(rbase + t0 + t) * 896;
            if (cc < 24) *(LAS u32x4*)(Xs + t * 200 + cc * 8) = *(const u32x4*)(XC + rr + g * 192 + cc * 8);
            else *(LAS u32x4*)(Bs + t * 136 + (cc - 24) * 8) = *(const u32x4*)(XC + rr + 384 + g * 128 + (cc - 24) * 8); }
        if (w < 6) {
            const int dir = w / 3, r = w % 3, h = g * 3 + r;
            float dt[2], incl[2], dA[2], total;
            dt_scan(F, l, Pp, rbase + t0, dir, h, dt, incl, dA, total);
#pragma unroll
            for (int q = 0; q < 2; ++q) { const int tt = 2 * F.lane + q;
                if (dir == 0) { DTF[r * 128 + tt] = dt[q]; ACF[r * 128 + tt] = incl[q]; }
                else { DTB[r * 128 + tt] = dt[q]; ACB[r * 128 + tt] = total - (incl[q] - dA[q]); } }
        }
        bf16x8 cf[4];
#pragma unroll
        for (int ks = 0; ks < 4; ++ks) cf[ks] = *(const bf16x8*)(XC + grow * 896 + 640 + g * 128 + 32 * ks + 8 * gq);
        __syncthreads();
        f32x4 cb[8];
#pragma unroll
        for (int jt = 0; jt < 8; ++jt) { cb[jt] = (f32x4){0.f, 0.f, 0.f, 0.f};
#pragma unroll
            for (int ks = 0; ks < 4; ++ks) cb[jt] = mfma16(frag_lds(Bs, 136, 16 * jt, 32 * ks, li, gq), cf[ks], cb[jt]); }
#pragma unroll 1
        for (int r = 0; r < 3; ++r) {
            const int h = g * 3 + r;
            int itk = itok; asm volatile("" : "+v"(itk));
            const float af_i = ACF[r * 128 + itok], ab_i = ACB[r * 128 + itok];
#pragma unroll
            for (int jt = 0; jt < 8; ++jt) { const int jv = 16 * jt + 4 * gq;
                const f32x4 acf = *(const LAS f32x4*)(ACF + r * 128 + jv), dtf = *(const LAS f32x4*)(DTF + r * 128 + jv), acb = *(const LAS f32x4*)(ACB + r * 128 + jv), dtb = *(const LAS f32x4*)(DTB + r * 128 + jv);
                f32x4 mv;
#pragma unroll
                for (int q = 0; q < 4; ++q) { const int j = jv + q;
                    const float mfw = (float)(((itk - j) >> 31) + 1), mbw = (float)(((j - itk) >> 31) + 1);
                    const float ef = mfw * __expf(fminf(af_i - acf[q], 0.f)) * dtf[q];
                    const float eb = mbw * __expf(fminf(ab_i - acb[q], 0.f)) * dtb[q];
                    mv[q] = cb[jt][q] * (ef + eb); }
                *(LAS u32x2*)(SCR + li * 136 + jv) = pack4(mv); }
            LDS_FENCE();
            bf16x8 mf[4];
#pragma unroll
            for (int ks = 0; ks < 4; ++ks) mf[ks] = frag_lds(SCR, 136, 0, 32 * ks, li, gq);
            const float ef_i = __expf(af_i), eb_i = __expf(ab_i), dsk = INP(IN_DSKIP)[l * 6 + h];
            const bf16_t* Hf = ST + st_index(b, c, 0, h); const bf16_t* Hb = ST + st_index(b, c, 1, h);
#pragma unroll
            for (int pt = 0; pt < 4; ++pt) {
                f32x4 ya = (f32x4){0.f, 0.f, 0.f, 0.f}, gf = ya, gb = ya;
#pragma unroll
                for (int ks = 0; ks < 4; ++ks) {
                    ya = mfma16(frag_tr(Xs, 200, 32 * ks, r * 64 + 16 * pt, li, gq), mf[ks], ya);
                    gf = mfma16(frag_glb(Hf, 128, 16 * pt, 32 * ks, li, gq), cf[ks], gf);
                    gb = mfma16(frag_glb(Hb, 128, 16 * pt, 32 * ks, li, gq), cf[ks], gb); }
                const u32x2 xw = *(const LAS u32x2*)(Xs + itok * 200 + r * 64 + 16 * pt + 4 * gq);
                const u32x2 zw = *(const u32x2*)(Pp + grow * PW + PZ + h * 64 + 16 * pt + 4 * gq);
                const float xs_[4] = {lo2f(xw.x), hi2f(xw.x), lo2f(xw.y), hi2f(xw.y)}, zs_[4] = {lo2f(zw.x), hi2f(zw.x), lo2f(zw.y), hi2f(zw.y)};
                f32x4 o;
#pragma unroll
                for (int q = 0; q < 4; ++q) { const float y = ya[q] + ef_i * gf[q] + eb_i * gb[q] + dsk * xs_[q]; o[q] = y * siluf(zs_[q]); ss += o[q] * o[q]; }
                *(u32x2*)(MIX + grow * D + 640 + h * 64 + 16 * pt + 4 * gq) = pack4(o);
            }
            LDS_FENCE();
        }
    }
    ss += __shfl_xor(ss, 16); ss += __shfl_xor(ss, 32);
    const float rstd = rsqrtf(ss * (1.f / 384.f) + EPS);
    asm volatile("s_waitcnt vmcnt(0)" ::: "memory");
#pragma unroll 2
    for (int hp = 0; hp < 24; ++hp) { const int col = (hp >> 2) * 64 + 16 * (hp & 3) + 4 * gq; const f32x4 gs = *(const f32x4*)(INP(IN_GSSD) + l * 384 + col);
        const u32x2 yw = *(const u32x2*)(MIX + grow * D + 640 + col);
#if defined(DBG_ZERO_S)
        const f32x4 o = (f32x4){0.f, 0.f, 0.f, 0.f} * (rstd * gs + lo2f(yw.x));
#else
        const f32x4 o = (f32x4){lo2f(yw.x), hi2f(yw.x), lo2f(yw.y), hi2f(yw.y)} * rstd * gs;
#endif
        *(u32x2*)(MIX + grow * D + 640 + col) = pack4(o); }
}

__device__ __forceinline__ void attn_unit(const Frame& F, int l, int b, int nb, int kvh, bool ctxq) {
    LAS float* ROPE = (LAS float*)F.lds;
    LAS bf16_t* Kt = (LAS bf16_t*)(F.lds + 8192);
    LAS bf16_t* Vt = (LAS bf16_t*)(F.lds + 26624);
    const bf16_t* Pp = (const bf16_t*)(F.ws + WS_BUFB);
    bf16_t* MIX = (bf16_t*)(F.ws + WS_BUFA);
    const int li = F.lane & 15, gq = F.lane >> 4, w = F.wave;
    __syncthreads();
    for (int i = F.tid; i < 2048; i += NTHR) ROPE[i] = ((const float*)(F.ws + WS_ROPE))[i];
    __syncthreads();
    const int qrow_base = ctxq ? NLAT + b * CTX + nb * 128 : b * SEQ + nb * 128;
    bf16x8 qf[3][2]; float m[3], lsum[3];
    f32x4 o[4][3];
#pragma unroll
    for (int qt = 0; qt < 3; ++qt) {
        const int R = 48 * w + 16 * qt, r = R >> 7, qi = (R & 127) + li, h = kvh * 3 + r;
        const bf16_t* qp = Pp + (size_t)(qrow_base + qi) * PW + PQ + h * 64;
        const int tq = nb * 128 + qi;
#pragma unroll
        for (int ks = 0; ks < 2; ++ks) {
            const int d0 = 32 * ks + 8 * gq;
            const u32x4 own = *(const u32x4*)(qp + d0);
            float ov[8] = {lo2f(own.x), hi2f(own.x), lo2f(own.y), hi2f(own.y), lo2f(own.z), hi2f(own.z), lo2f(own.w), hi2f(own.w)};
            if (!ctxq) {
                const u32x4 par = *(const u32x4*)(qp + (d0 ^ 16));
                const float pv[8] = {lo2f(par.x), hi2f(par.x), lo2f(par.y), hi2f(par.y), lo2f(par.z), hi2f(par.z), lo2f(par.w), hi2f(par.w)};
                const int pos = ks == 0 ? (tq >> 6) : (tq & 63), f0 = (8 * gq) & 15;
#pragma unroll
                for (int j = 0; j < 8; ++j) { const float cs = ROPE[(pos * 16 + f0 + j) * 2], sn = ROPE[(pos * 16 + f0 + j) * 2 + 1];
                    ov[j] = (gq < 2) ? (ov[j] * cs - pv[j] * sn) : (pv[j] * sn + ov[j] * cs); }
            }
            u32x4 pq; pq.x = pk2(ov[0] * 0.125f, ov[1] * 0.125f); pq.y = pk2(ov[2] * 0.125f, ov[3] * 0.125f); pq.z = pk2(ov[4] * 0.125f, ov[5] * 0.125f); pq.w = pk2(ov[6] * 0.125f, ov[7] * 0.125f);
            qf[qt][ks] = __builtin_bit_cast(bf16x8, pq);
        }
        m[qt] = INP(IN_SINK)[l * 6 + h]; lsum[qt] = (gq == 0) ? 1.f : 0.f;
#pragma unroll
        for (int dt = 0; dt < 4; ++dt) o[dt][qt] = (f32x4){0.f, 0.f, 0.f, 0.f};
    }
    const int ntile = ctxq ? 2 : 5;
#pragma unroll 1
    for (int ti = 0; ti < ntile; ++ti) {
        const bool local = (!ctxq) && ti < 3;
        const int kb = nb - 1 + ti;
        if (local && (kb < 0 || kb >= 32)) continue;
        const int ct = ctxq ? ti : ti - 3;
        const int krow0 = local ? b * SEQ + kb * 128 : NLAT + b * CTX + ct * 128;
        __syncthreads();
        {
            const int key = F.tid >> 2, part = F.tid & 3, c1 = part < 2 ? part : part + 2, c2 = c1 + 2;
            const bf16_t* kp = Pp + (size_t)(krow0 + key) * PW + PK + kvh * 64;
            const u32x4 a = *(const u32x4*)(kp + 8 * c1), bq = *(const u32x4*)(kp + 8 * c2);
            u32x4 oa = a, ob = bq;
            if (local) {
                const float v1[8] = {lo2f(a.x), hi2f(a.x), lo2f(a.y), hi2f(a.y), lo2f(a.z), hi2f(a.z), lo2f(a.w), hi2f(a.w)};
                const float v2[8] = {lo2f(bq.x), hi2f(bq.x), lo2f(bq.y), hi2f(bq.y), lo2f(bq.z), hi2f(bq.z), lo2f(bq.w), hi2f(bq.w)};
                const int tk = kb * 128 + key, pos = c1 < 4 ? (tk >> 6) : (tk & 63), f0 = (8 * c1) & 15;
                float r1[8], r2[8];
#pragma unroll
                for (int j = 0; j < 8; ++j) { const float cs = ROPE[(pos * 16 + f0 + j) * 2], sn = ROPE[(pos * 16 + f0 + j) * 2 + 1]; r1[j] = v1[j] * cs - v2[j] * sn; r2[j] = v1[j] * sn + v2[j] * cs; }
                oa.x = pk2(r1[0], r1[1]); oa.y = pk2(r1[2], r1[3]); oa.z = pk2(r1[4], r1[5]); oa.w = pk2(r1[6], r1[7]);
                ob.x = pk2(r2[0], r2[1]); ob.y = pk2(r2[2], r2[3]); ob.z = pk2(r2[4], r2[5]); ob.w = pk2(r2[6], r2[7]);
            }
            *(LAS u32x4*)(Kt + key * 72 + 8 * c1) = oa; *(LAS u32x4*)(Kt + key * 72 + 8 * c2) = ob;
#pragma unroll
            for (int q = 0; q < 2; ++q) { const int idx = F.tid + 512 * q, k2 = idx >> 3, chv = idx & 7;
                *(LAS u32x4*)(Vt + k2 * 72 + 8 * chv) = *(const u32x4*)(Pp + (size_t)(krow0 + k2) * PW + PV + kvh * 64 + 8 * chv); }
        }
        __syncthreads();
        const bool masked = local && (kb != nb);
#pragma unroll
        for (int qt = 0; qt < 3; ++qt) {
            __builtin_amdgcn_sched_barrier(0);
            const int qpos = nb * 128 + (((48 * w + 16 * qt) & 127) + li);
#pragma unroll 1
            for (int hf = 0; hf < 2; ++hf) {
                f32x4 s[4];
#pragma unroll
                for (int kt = 0; kt < 4; ++kt) { s[kt] = (f32x4){0.f, 0.f, 0.f, 0.f};
#pragma unroll
                    for (int ks = 0; ks < 2; ++ks) s[kt] = mfma16(frag_lds(Kt, 72, 64 * hf + 16 * kt, 32 * ks, li, gq), qf[qt][ks], s[kt]); }
                float tmax = -1e30f;
#pragma unroll
                for (int kt = 0; kt < 4; ++kt)
#pragma unroll
                    for (int q = 0; q < 4; ++q) {
                        if (masked) { const int kpos = kb * 128 + 64 * hf + 16 * kt + 4 * gq + q; const int dd = qpos - kpos; if (dd > 128 || dd < -128) s[kt][q] = -1e30f; }
                        tmax = fmaxf(tmax, s[kt][q]); }
                tmax = fmaxf(tmax, __shfl_xor(tmax, 16)); tmax = fmaxf(tmax, __shfl_xor(tmax, 32));
                const float mnew = fmaxf(m[qt], tmax), alpha = __expf(m[qt] - mnew);
                float ps = 0.f;
#pragma unroll
                for (int kt = 0; kt < 4; ++kt)
#pragma unroll
                    for (int q = 0; q < 4; ++q) { const float pe = __expf(s[kt][q] - mnew); s[kt][q] = pe; ps += pe; }
                lsum[qt] = lsum[qt] * alpha + ps; m[qt] = mnew;
#pragma unroll
                for (int dt = 0; dt < 4; ++dt) o[dt][qt] = o[dt][qt] * alpha;
#pragma unroll
                for (int k4 = 0; k4 < 2; ++k4) {
                    u32x4 pp; pp.x = pk2(s[2 * k4][0], s[2 * k4][1]); pp.y = pk2(s[2 * k4][2], s[2 * k4][3]); pp.z = pk2(s[2 * k4 + 1][0], s[2 * k4 + 1][1]); pp.w = pk2(s[2 * k4 + 1][2], s[2 * k4 + 1][3]);
                    const bf16x8 pf = __builtin_bit_cast(bf16x8, pp);
#pragma unroll
                    for (int dt = 0; dt < 4; ++dt) o[dt][qt] = mfma16(frag_tr_split(Vt, 72, 64 * hf + 32 * k4, 16 * dt, li, gq), pf, o[dt][qt]);
                }
            }
        }
    }
#pragma unroll
    for (int qt = 0; qt < 3; ++qt) {
        float lt = lsum[qt]; lt += __shfl_xor(lt, 16); lt += __shfl_xor(lt, 32);
        const float inv = 1.f / lt;
        const int R = 48 * w + 16 * qt;
        bf16_t* op = MIX + (size_t)(qrow_base + (R & 127) + li) * D + 256 + (kvh * 3 + (R >> 7)) * 64 + 4 * gq;
#pragma unroll
#if defined(DBG_ZERO_A)
        for (int dt = 0; dt < 4; ++dt) *(u32x2*)(op + 16 * dt) = pack4(o[dt][qt] * 0.f);
#else
        for (int dt = 0; dt < 4; ++dt) *(u32x2*)(op + 16 * dt) = pack4(o[dt][qt] * inv);
#endif
    }
}

#if defined(DBG_ZERO_F)
constexpr float FSCALE512 = 0.f, FSCALE128 = 0.f;
#else
constexpr float FSCALE512 = 1.f / 512.f, FSCALE128 = 1.f / 128.f;
#endif
constexpr int FO_CST = 0, FO_M2 = 18432, FO_Z = 53248, FO_CSB = 90112, FO_FST = 107520, FO_Z2 = 53248, FO_TAB = 126976;
__device__ __forceinline__ void fourier_consts_a(const Frame& F) {
    LAS bf16_t* CSt = (LAS bf16_t*)(F.lds + FO_CST); LAS bf16_t* M2 = (LAS bf16_t*)(F.lds + FO_M2);
    __syncthreads();
    for (int i = F.tid; i < 128 * 64; i += NTHR) { const int cp = i >> 6, c = i & 63; const int ph = (c * (cp & 63)) & 63; const float v = cp < 64 ? cospif(ph / 32.f) : sinpif(ph / 32.f);
        CSt[cp * 72 + c] = (bf16_t)(pk2(v, 0.f) & 0xffff); }
    for (int i = F.tid; i < 128 * 128; i += NTHR) { const int kp = i >> 7, kk = i & 127; const int ph = ((kp & 63) * (kk & 63)) & 63; const float cs = cospif(ph / 32.f), sn = sinpif(ph / 32.f);
        const float v = kp < 64 ? (kk < 64 ? cs : -sn) : (kk < 64 ? -sn : -cs);
        M2[kp * 136 + kk] = (bf16_t)(pk2(v, 0.f) & 0xffff); }
    __syncthreads();
}
__device__ __forceinline__ void fourier_consts_b(const Frame& F) {
    LAS bf16_t* CSb = (LAS bf16_t*)(F.lds + FO_CSB);
    __syncthreads();
    for (int i = F.tid; i < 64 * 128; i += NTHR) { const int k2 = i >> 7, kk = i & 127; const int ph = (k2 * (kk & 63)) & 63; const float v = kk < 64 ? cospif(ph / 32.f) : sinpif(ph / 32.f);
        CSb[k2 * 136 + kk] = (bf16_t)(pk2(v, 0.f) & 0xffff); }
    __syncthreads();
}
__device__ __forceinline__ void fa_unit(const Frame& F, int b, int g, int pr) {
    LAS bf16_t* CSt = (LAS bf16_t*)(F.lds + FO_CST); LAS bf16_t* M2 = (LAS bf16_t*)(F.lds + FO_M2);
    const bf16_t* Pp = (const bf16_t*)(F.ws + WS_BUFB); bf16_t* FA = (bf16_t*)(F.ws + WS_BUFC + BC_FA);
    const int li = F.lane & 15, gq = F.lane >> 4, w = F.wave;
    __syncthreads();
#pragma unroll
    for (int u2 = 0; u2 < 2; ++u2) {
        LAS bf16_t* Z = (LAS bf16_t*)(F.lds + FO_Z + u2 * 18432);
        const int n2 = 2 * pr + u2, n1 = 16 * (w & 3) + li;
        const bf16_t* up = Pp + (size_t)(b * SEQ + 64 * n1 + n2) * PW + PF + g * 64;
        bf16x8 uf[2];
#pragma unroll
        for (int ks = 0; ks < 2; ++ks) uf[ks] = *(const bf16x8*)(up + 32 * ks + 8 * gq);
#pragma unroll
        for (int ctl = 0; ctl < 4; ++ctl) { const int ct = 4 * (w >> 2) + ctl; f32x4 acc = (f32x4){0.f, 0.f, 0.f, 0.f};
#pragma unroll
            for (int ks = 0; ks < 2; ++ks) acc = mfma16(frag_lds(CSt, 72, 16 * ct, 32 * ks, li, gq), uf[ks], acc);
            const int cp = 16 * ct + 4 * gq;
            *(LAS u32x2*)(Z + ((cp < 64 ? 0 : 64) + n1) * 72 + (cp & 63)) = pack4(acc); }
    }
    __syncthreads();
#pragma unroll
    for (int u2 = 0; u2 < 2; ++u2) {
        LAS bf16_t* Z = (LAS bf16_t*)(F.lds + FO_Z + u2 * 18432);
        const int n2 = 2 * pr + u2, kt = w & 3, k1 = 16 * kt + li;
        const int ph = (n2 * k1) & 4095; const float cs = cospif(ph / 2048.f), sn = sinpif(ph / 2048.f);
#pragma unroll
        for (int ctl = 0; ctl < 2; ++ctl) { const int ct = 2 * (w >> 2) + ctl; f32x4 ar = (f32x4){0.f, 0.f, 0.f, 0.f}, ai = ar;
#pragma unroll
            for (int ks = 0; ks < 4; ++ks) { const bf16x8 zf = frag_tr(Z, 72, 32 * ks, 16 * ct, li, gq);
                ar = mfma16(zf, frag_lds(M2, 136, 16 * kt, 32 * ks, li, gq), ar);
                ai = mfma16(zf, frag_lds(M2, 136, 64 + 16 * kt, 32 * ks, li, gq), ai); }
            const f32x4 tr = ar * cs + ai * sn, tim = ai * cs - ar * sn;
            bf16_t* dst = FA + ((((size_t)(b * 4 + g) * 64 + k1) * 64 + n2) * 128) + 16 * ct + 4 * gq;
            *(u32x2*)dst = pack4(tr); *(u32x2*)(dst + 64) = pack4(tim); }
    }
}
__device__ __forceinline__ void fb_unit(const Frame& F, int b, int g, int kq) {
    LAS bf16_t* CSb = (LAS bf16_t*)(F.lds + FO_CSB); LAS bf16_t* Fst = (LAS bf16_t*)F.lds;
    const bf16_t* FA = (const bf16_t*)(F.ws + WS_BUFC + BC_FA) + (((size_t)(b * 4 + g) * 64 + 4 * kq) * 64) * 128;
    bf16_t* MIX = (bf16_t*)(F.ws + WS_BUFA);
    const int li = F.lane & 15, gq = F.lane >> 4, w = F.wave;
    u32x4 v[8];
#pragma unroll
    for (int q = 0; q < 8; ++q) v[q] = *(const u32x4*)(FA + (size_t)(F.tid + 512 * q) * 8);
    __syncthreads();
#pragma unroll
    for (int q = 0; q < 8; ++q) { const int idx = F.tid + 512 * q, kk1 = idx >> 10, n2 = (idx >> 4) & 63, ri = (idx >> 3) & 1, cc = idx & 7;
        *(LAS u32x4*)(Fst + kk1 * 9216 + (ri * 64 + n2) * 72 + 8 * cc) = v[q]; }
    __syncthreads();
    const int k2 = 16 * (w & 3) + li;
    bf16x8 cfr[4];
#pragma unroll
    for (int ks = 0; ks < 4; ++ks) cfr[ks] = frag_lds(CSb, 136, 16 * (w & 3), 32 * ks, li, gq);
#pragma unroll
    for (int kk1 = 0; kk1 < 4; ++kk1)
#pragma unroll
        for (int ctl = 0; ctl < 2; ++ctl) { const int ct = 2 * (w >> 2) + ctl; f32x4 acc = (f32x4){0.f, 0.f, 0.f, 0.f};
#pragma unroll
            for (int ks = 0; ks < 4; ++ks) acc = mfma16(frag_tr(Fst + kk1 * 9216, 72, 32 * ks, 16 * ct, li, gq), cfr[ks], acc);
            *(u32x2*)(MIX + (size_t)(b * SEQ + 64 * k2 + 4 * kq + kk1) * D + g * 64 + 16 * ct + 4 * gq) = pack4(acc * FSCALE512); }
}
__device__ __forceinline__ void fctx_unit(const Frame& F, int b, int g) {
    LAS bf16_t* CSt = (LAS bf16_t*)(F.lds + FO_CST); LAS bf16_t* Z2 = (LAS bf16_t*)(F.lds + FO_Z2);
    LAS bf16_t* TAB = (LAS bf16_t*)(F.lds + FO_TAB);
    const bf16_t* Pp = (const bf16_t*)(F.ws + WS_BUFB); bf16_t* MIX = (bf16_t*)(F.ws + WS_BUFA);
    const int li = F.lane & 15, gq = F.lane >> 4, w = F.wave;
    __syncthreads();
    if (F.tid < 256) { TAB[F.tid] = (bf16_t)(pk2(cospif(F.tid / 128.f), 0.f) & 0xffff); TAB[256 + F.tid] = (bf16_t)(pk2(-sinpif(F.tid / 128.f), 0.f) & 0xffff); }
    {
        bf16x8 cfr[2];
#pragma unroll
        for (int ks = 0; ks < 2; ++ks) cfr[ks] = frag_lds(CSt, 72, 16 * w, 32 * ks, li, gq);
#pragma unroll 4
        for (int nt = 0; nt < 16; ++nt) { const int n = 16 * nt + li; const bf16_t* up = Pp + (size_t)(NLAT + b * CTX + n) * PW + PF + g * 64;
            f32x4 acc = (f32x4){0.f, 0.f, 0.f, 0.f};
#pragma unroll
            for (int ks = 0; ks < 2; ++ks) acc = mfma16(cfr[ks], *(const bf16x8*)(up + 32 * ks + 8 * gq), acc);
            const int cp = 16 * w + 4 * gq;
            *(LAS u32x2*)(Z2 + ((cp < 64 ? 0 : 256) + n) * 72 + (cp & 63)) = pack4(acc); }
    }
    __syncthreads();
    f32x4 acc[2][4];
#pragma unroll
    for (int a = 0; a < 2; ++a)
#pragma unroll
        for (int ct = 0; ct < 4; ++ct) acc[a][ct] = (f32x4){0.f, 0.f, 0.f, 0.f};
#pragma unroll 1
    for (int ks = 0; ks < 16; ++ks) {
        bf16x8 zf[4];
#pragma unroll
        for (int ct = 0; ct < 4; ++ct) zf[ct] = frag_tr(Z2, 72, 32 * ks, 16 * ct, li, gq);
#pragma unroll
        for (int a = 0; a < 2; ++a) { const int k = 16 * (2 * w + a) + li; bf16x8 df;
#pragma unroll
            for (int j = 0; j < 8; ++j) { const int kk = 32 * ks + 8 * gq + j; df[j] = (short)TAB[(kk < 256 ? 0 : 256) + ((k * (kk & 255)) & 255)]; }
#pragma unroll
            for (int ct = 0; ct < 4; ++ct) acc[a][ct] = mfma16(zf[ct], df, acc[a][ct]); }
    }
#pragma unroll
    for (int a = 0; a < 2; ++a) { const int k = 16 * (2 * w + a) + li;
#pragma unroll
        for (int ct = 0; ct < 4; ++ct) *(u32x2*)(MIX + (size_t)(NLAT + b * CTX + k) * D + g * 64 + 16 * ct + 4 * gq) = pack4(acc[a][ct] * FSCALE128); }
}
__global__ void __launch_bounds__(NTHR, 2) hybrid_fwd(Params P) {
    extern __shared__ __attribute__((aligned(16))) unsigned char lds_raw[];
    Frame F;
    F.lds = (LAS unsigned char*)lds_raw;
    F.tid = threadIdx.x; F.lane = F.tid & 63; F.wave = __builtin_amdgcn_readfirstlane(F.tid >> 6);
    F.G = gridDim.x; F.bid = blockIdx.x;
    F.out = P.out; F.ws = P.ws;
    volatile LAS unsigned* MISC = (volatile LAS unsigned*)(F.lds + MISC_OFF);
    if (F.tid < 16) MISC[F.tid] = 0u;
    __syncthreads();
    XcdBarrier bar = xcd_barrier_post((unsigned*)(F.ws + WS_CTL), MISC);
#define PHASE_FENCE() do { asm volatile("" : "+v"(F.tid)); F.lane = F.tid & 63; F.wave = __builtin_amdgcn_readfirstlane(F.tid >> 6); \
        asm volatile("" : "+s"(F.ws), "+s"(F.out), "+s"(F.bid), "+s"(F.G)); } while (0)
#define GRID_BAR() do { xcd_barrier(bar); PHASE_FENCE(); } while (0)
#if defined(DBG_REP_K)
#define REPS(k, lay) (((k) == DBG_REP_K && (lay) == DBG_REP_L) ? 2 : 1)
#else
#define REPS(k, lay) 1
#endif

    for (int rep = 0; rep < REPS(0, 0); ++rep) { p0_prologue(F); GRID_BAR(); }
    for (int rep = 0; rep < REPS(1, 0); ++rep) { e1_phase(F); GRID_BAR(); }

#pragma unroll 1
    for (int l = 0; l < 2; ++l) {
        const bool first = (l == 0);
        PHASE_FENCE();
        for (int rep = 0; rep < REPS(2, l); ++rep) {
        {
            pg8::DenseProb pb{(const bf16_t*)(F.ws + WS_BUFA), (const bf16_t*)(F.ws + WS_WIN) + (size_t)l * PW * D, nullptr, D};
            pg8::GridOrder S; S.init(NT / 256, PW / 256, F.G, F.bid);
            pg8::EpiBf16 E{(bf16_t*)(F.ws + WS_BUFB), PW};
            pg8::gemm_phase(F.lds, F.tid, pb, S, E);
        }
        GRID_BAR();
        }
        for (int rep = 0; rep < REPS(3, l); ++rep) {
        {
            const int nAttL = NB * 32 * 2, nAttC = first ? NB * 2 * 2 : 0, nS1 = NB * NCH * 2, nFA = NB * 4 * 32;
            const int total = nAttL + nAttC + nS1 + nFA;
            bool fa_ready = false;
            for (int u = F.bid; u < total; u += F.G) {
                PHASE_FENCE();
                int v = u;
                if (v < nAttL) { const int b = v >> 6, nb = (v >> 1) & 31, kvh = v & 1; for (int r2 = 0; r2 < REPS(31, l); ++r2) attn_unit(F, l, b, nb, kvh, false); continue; } v -= nAttL;
                if (v < nAttC) { const int b = v >> 2, nb = (v >> 1) & 1, kvh = v & 1; attn_unit(F, l, b, nb, kvh, true); continue; } v -= nAttC;
                if (v < nS1) { const int g = v & 1, c = (v >> 1) % NCH, b = (v >> 1) / NCH; for (int r2 = 0; r2 < REPS(32, l); ++r2) s1_unit(F, l, b, c, g); continue; } v -= nS1;
                if (!fa_ready) { fourier_consts_a(F); fa_ready = true; }
                { const int pr = v & 31, g = (v >> 5) & 3, b = v >> 7; for (int r2 = 0; r2 < REPS(33, l); ++r2) fa_unit(F, b, g, pr); }
            }
        }
        GRID_BAR();
        }
        s2_phase(F);
        GRID_BAR();
        for (int rep = 0; rep < REPS(5, l); ++rep) {
        {
            const int c0 = first ? 0 : 2;
            const int nS3 = NB * (NCH - c0), nFC = first ? NB * 4 : 0, nFB = NB * 4 * 16;
            const int total = nS3 + nFC + nFB;
            bool fa_ready = false, fb_ready = false;
            for (int u = F.bid; u < total; u += F.G) {
                PHASE_FENCE();
                int v = u;
                if (v < nS3) { const int c = c0 + v % (NCH - c0), b = v / (NCH - c0); for (int r2 = 0; r2 < REPS(51, l); ++r2) s3_unit(F, l, b, c); continue; } v -= nS3;
                if (v < nFC) { if (!fa_ready) { fourier_consts_a(F); fa_ready = true; } fctx_unit(F, v >> 2, v & 3); fb_ready = false; continue; } v -= nFC;
                if (!fb_ready) { fourier_consts_b(F); fb_ready = true; }
                { const int kq = v & 15, g = (v >> 4) & 3, b = v >> 6; for (int r2 = 0; r2 < REPS(53, l); ++r2) fb_unit(F, b, g, kq); }
            }
            __syncthreads();
        }
        GRID_BAR();
        }
        for (int rep = 0; rep < REPS(6, l); ++rep) {
        {
            const int rows = first ? NT : NLAT;
            pg8::DenseProb pb{(const bf16_t*)(F.ws + WS_BUFA), (const bf16_t*)(F.ws + WS_WOUT) + (size_t)l * D * D, nullptr, D};
            pg8::GridOrder S; S.init(rows / 256, D / 256, F.G, F.bid);
            pg8::EpiBf16 E{(bf16_t*)(F.ws + WS_BUFB), D};
            pg8::gemm_phase(F.lds, F.tid, pb, S, E);
        }
        GRID_BAR();
        }
        for (int rep = 0; rep < REPS(7, l); ++rep) { e3_phase(F, l); GRID_BAR(); }
#if defined(DBG_STOP)
        if (DBG_STOP == 1 + 2 * l) return;
#endif
        for (int rep = 0; rep < REPS(8, l); ++rep) { topk_phase(F, l); GRID_BAR(); }
        {
            pg8::MoeMap mp{16, 0};
            const int nMv = first ? 16 * 34 : 16 * 32;
            for (int rep = 0; rep < REPS(9, l); ++rep) {
            {
                pg8::GuProb pb{(const void*)(F.ws + WS_ASORT), (const void*)(F.ws + WS_WGU), nullptr, D, mp};
                pg8::GridOrder S; S.init(nMv, 2 * FF / 256, F.G, F.bid);
                pg8::EpiGU E{F.ws + WS_BUFB, mp};
                pg8::gemm_phase(F.lds, F.tid, pb, S, E);
            }
            GRID_BAR();
            }
            for (int rep = 0; rep < REPS(10, l); ++rep) {
            {
                pg8::DownProb pb{(const void*)(F.ws + WS_BUFB), (const void*)(F.ws + WS_WD), nullptr, FF, mp};
                pg8::GridOrder S; S.init(nMv, D / 256, F.G, F.bid);
                pg8::EpiDown E{(bf16_t*)(F.ws + WS_BUFC), (const float*)(F.ws + WS_GATE), mp};
                pg8::gemm_phase(F.lds, F.tid, pb, S, E);
            }
            GRID_BAR();
            }
        }
        e5_phase(F, l);
        if (first) { __syncthreads(); convert_experts(F, 1); }
        GRID_BAR();
#if defined(DBG_STOP)
        if (DBG_STOP == 2 + 2 * l) return;
#endif
    }
}

extern "C" void kernel_launch(void* const* d_in, const int* in_sizes, int n_in, void* d_out, int out_size, void* d_ws, size_t ws_size, hipStream_t stream) {
    static int grid = 0;
    if (grid == 0) {
        if (n_in != 23 || out_size != NLAT * D || ws_size < WS_END) { fprintf(stderr, "kernel_launch: unexpected problem (n_in %d out %d ws %zu need %zu)\n", n_in, out_size, ws_size, (size_t)WS_END); grid = -1; return; }
        int dev = 0, cus = 0, per_cu = 0;
        if (hipGetDevice(&dev) != hipSuccess || hipDeviceGetAttribute(&cus, hipDeviceAttributeMultiprocessorCount, dev) != hipSuccess) { grid = -1; return; }
        if (hipFuncSetAttribute((const void*)hybrid_fwd, hipFuncAttributeMaxDynamicSharedMemorySize, LDS_BYTES) != hipSuccess) { fprintf(stderr, "kernel_launch: hipFuncSetAttribute failed\n"); grid = -1; return; }
        if (hipOccupancyMaxActiveBlocksPerMultiprocessor(&per_cu, (const void*)hybrid_fwd, NTHR, LDS_BYTES) != hipSuccess || per_cu < 1) { fprintf(stderr, "kernel_launch: occupancy query says %d\n", per_cu); (void)hipGetLastError(); grid = -1; return; }
        grid = cus;
    }
    if (grid < 0) return;
    (void)in_sizes;
    hipMemsetAsync((char*)d_ws + WS_CTL, 0, 65536, stream);
    Params p{};
    for (int i = 0; i < 23; ++i) p.in[i] = (const float*)d_in[i];
    p.out = (float*)d_out; p.ws = (unsigned char*)d_ws;
    hipLaunchKernelGGL(hybrid_fwd, dim3(grid), dim3(NTHR), LDS_BYTES, stream, p);
}
```

```cpp
#include <hip/hip_runtime.h>
#include <cstdio>
#include <cstdint>

#define LAS __attribute__((address_space(3)))
typedef unsigned short bf16_t;
typedef short bf16x8 __attribute__((ext_vector_type(8)));
typedef short bf16x4 __attribute__((ext_vector_type(4)));
typedef float f32x4 __attribute__((ext_vector_type(4)));
typedef float f32x2 __attribute__((ext_vector_type(2)));
typedef unsigned u32x4 __attribute__((ext_vector_type(4)));
typedef unsigned u32x2 __attribute__((ext_vector_type(2)));
typedef __bf16 bf16v2_t __attribute__((ext_vector_type(2)));

constexpr int D = 1024, NB = 16, SEQ = 4096, CTX = 256, NLAT = NB * SEQ, NCTX = NB * CTX, NT = NLAT + NCTX;
constexpr int PW = 2304;
constexpr int PF = 0, PQ = 256, PK = 640, PV = 768, PZ = 896, PX = 1280, PDT = 2176, INW = 2188;
constexpr int FF = 2816, NE = 16, EROWS = 8704;
constexpr int NCH = 34;
constexpr float EPS = 1e-6f;
constexpr int NWAVES = 8, NTHR = 512;

constexpr size_t al4k(size_t x) { return (x + 4095) & ~(size_t)4095; }
constexpr size_t WS_CTL = 0;
constexpr size_t WS_MOD = al4k(WS_CTL + 65536);
constexpr size_t WS_ROPE = al4k(WS_MOD + (size_t)2 * 17 * 6144 * 4);
constexpr size_t WS_HCTX = al4k(WS_ROPE + 64 * 16 * 2 * 4);
constexpr size_t WS_WIN = al4k(WS_HCTX + (size_t)NCTX * D * 4);
constexpr size_t WS_WOUT = al4k(WS_WIN + (size_t)2 * PW * D * 2);
constexpr size_t WS_WGU = al4k(WS_WOUT + (size_t)2 * D * D * 2);
constexpr size_t WS_WD = al4k(WS_WGU + (size_t)NE * 2 * FF * D * 2);
constexpr size_t WS_AFF = al4k(WS_WD + (size_t)NE * D * FF * 2);
constexpr size_t WS_ROWIDX = al4k(WS_AFF + (size_t)NT * 16 * 4);
constexpr size_t WS_GATE = al4k(WS_ROWIDX + (size_t)NE * EROWS * 4);
constexpr size_t WS_SLOT = al4k(WS_GATE + (size_t)NE * EROWS * 4);
constexpr size_t WS_DECAY = al4k(WS_SLOT + (size_t)NT * 16 * 2);
constexpr size_t WS_BUFA = al4k(WS_DECAY + (size_t)NB * NCH * 12 * 4);
constexpr size_t WS_BUFB = al4k(WS_BUFA + (size_t)NT * D * 2);
constexpr size_t WS_BUFC = al4k(WS_BUFB + (size_t)8 * EROWS * FF * 2);
constexpr size_t BC_XC = 0;
constexpr size_t BC_ST = al4k(BC_XC + (size_t)NT * 896 * 2);
constexpr size_t BC_FA = al4k(BC_ST + (size_t)NB * NCH * 12 * 8192 * 2);
constexpr size_t BC_END = al4k(BC_FA + (size_t)NB * 4 * 64 * 64 * 128 * 2);
static_assert(BC_END >= (size_t)NE * EROWS * D * 2, "y must fit the mixer-temporary region");
constexpr size_t WS_ASORT = WS_BUFC + BC_END;
constexpr size_t WS_END = al4k(WS_ASORT + (size_t)NE * EROWS * D);

constexpr int LDS_BYTES = 155648;
constexpr int MISC_OFF = 151552;

struct Params { const float* in[23]; float* out; unsigned char* ws; };

__device__ __forceinline__ float bf2f(bf16_t v) { return __uint_as_float((unsigned)v << 16); }
__device__ __forceinline__ unsigned pk2(float lo, float hi) { f32x2 v = {lo, hi}; bf16v2_t b = __builtin_convertvector(v, bf16v2_t); return __builtin_bit_cast(unsigned, b); }
__device__ __forceinline__ float lo2f(unsigned w) { return __uint_as_float(w << 16); }
__device__ __forceinline__ float hi2f(unsigned w) { return __uint_as_float(w & 0xffff0000u); }
#define DPP_F(v, ctrl) __builtin_bit_cast(float, __builtin_amdgcn_update_dpp(0, __builtin_bit_cast(int, (v)), (ctrl), 0xF, 0xF, false))
__device__ __forceinline__ float row_sum16(float v) { v += DPP_F(v, 0xB1); v += DPP_F(v, 0x4E); v += DPP_F(v, 0x141); v += DPP_F(v, 0x140); return v; }
__device__ __forceinline__ float row_max16(float v) { v = fmaxf(v, DPP_F(v, 0xB1)); v = fmaxf(v, DPP_F(v, 0x4E)); v = fmaxf(v, DPP_F(v, 0x141)); v = fmaxf(v, DPP_F(v, 0x140)); return v; }
__device__ __forceinline__ float rdlane(float v, int lane) { return __builtin_bit_cast(float, __builtin_amdgcn_readlane(__builtin_bit_cast(int, v), lane)); }
__device__ __forceinline__ float wave_sum(float v) { v = row_sum16(v); return (rdlane(v, 0) + rdlane(v, 16)) + (rdlane(v, 32) + rdlane(v, 48)); }
__device__ __forceinline__ float siluf(float x) { return x / (1.f + __expf(-x)); }
__device__ __forceinline__ float softplusf(float x) { return fmaxf(x, 0.f) + log1pf(__expf(-fabsf(x))); }
__device__ __forceinline__ f32x4 mfma16(bf16x8 a, bf16x8 b, f32x4 c) { return __builtin_amdgcn_mfma_f32_16x16x32_bf16(a, b, c, 0, 0, 0); }
__device__ __forceinline__ bf16x8 frag_lds(const LAS bf16_t* base, int stride, int r0, int k0, int li, int gq) {
    return *(const LAS bf16x8*)(base + (r0 + li) * stride + k0 + 8 * gq);
}
__device__ __forceinline__ bf16x8 frag_glb(const bf16_t* base, size_t stride, int r0, int k0, int li, int gq) {
    return *(const bf16x8*)(base + (size_t)(r0 + li) * stride + k0 + 8 * gq);
}
__device__ __forceinline__ bf16x8 frag_tr(const LAS bf16_t* S, int stride, int k0, int n0, int li, int gq) {
    const LAS bf16_t* p = S + (k0 + 8 * gq + (li >> 2)) * stride + n0 + 4 * (li & 3);
    bf16x4 a = __builtin_amdgcn_ds_read_tr16_b64_v4i16((LAS bf16x4*)p);
    bf16x4 b = __builtin_amdgcn_ds_read_tr16_b64_v4i16((LAS bf16x4*)(p + 4 * stride));
    return (bf16x8){a[0], a[1], a[2], a[3], b[0], b[1], b[2], b[3]};
}
__device__ __forceinline__ bf16x8 frag_tr_split(const LAS bf16_t* S, int stride, int k0, int n0, int li, int gq) {
    const LAS bf16_t* p = S + (k0 + 4 * gq + (li >> 2)) * stride + n0 + 4 * (li & 3);
    bf16x4 a = __builtin_amdgcn_ds_read_tr16_b64_v4i16((LAS bf16x4*)p);
    bf16x4 b = __builtin_amdgcn_ds_read_tr16_b64_v4i16((LAS bf16x4*)(p + 16 * stride));
    return (bf16x8){a[0], a[1], a[2], a[3], b[0], b[1], b[2], b[3]};
}
__device__ __forceinline__ u32x2 pack4(f32x4 v) { u32x2 r; r.x = pk2(v[0], v[1]); r.y = pk2(v[2], v[3]); return r; }
#define LDS_FENCE() asm volatile("s_waitcnt lgkmcnt(0)" ::: "memory")

#define XB_TMO      128
#define XB_XCNT(j)  (256  + 64 * (j))
#define XB_XSUB(j)  (1280 + 64 * (j))
#define XB_XGEN(j)  (2304 + 64 * (j))
#define XB_TOP      3328
#define XB_TOPGEN   3392
#define XCD_BAR_WORDS 3456
#define XB_SPIN_CAP (1u << 22)
__device__ __forceinline__ unsigned xb_ld(unsigned* p)              { return __hip_atomic_load(p, __ATOMIC_RELAXED, __HIP_MEMORY_SCOPE_AGENT); }
__device__ __forceinline__ unsigned xb_add(unsigned* p, unsigned v) { return __hip_atomic_fetch_add(p, v, __ATOMIC_RELAXED, __HIP_MEMORY_SCOPE_AGENT); }
__device__ __forceinline__ unsigned xb_xcc_id() { return (unsigned)__builtin_amdgcn_s_getreg((3 << 11) | 20) & 0xFu; }
#define XB_SPIN(cond, bar) do { unsigned _sp = 0; while (cond) { __builtin_amdgcn_s_sleep(1); \
    if ((++_sp & 255u) == 0u) { if (xb_ld(&(bar)[XB_TMO])) break; if (_sp > XB_SPIN_CAP) { atomicAdd(&(bar)[XB_TMO], 1u); break; } } } } while (0)
struct XcdBarrier { unsigned* bar; unsigned x; volatile LAS unsigned* st; };
__device__ __forceinline__ XcdBarrier xcd_barrier_post(unsigned* bar, volatile LAS unsigned* st) {
    XcdBarrier b; b.bar = bar; b.x = xb_xcc_id(); b.st = st;
    if (threadIdx.x == 0) (void)xb_add(&bar[XB_XCNT(b.x)], 1u);
    return b;
}
__device__ __forceinline__ void xcd_barrier_complete(unsigned* bar, unsigned x, unsigned& nloc, unsigned& nx) {
    const unsigned G = gridDim.x * gridDim.y * gridDim.z;
    unsigned sum, cnt, mine, sp = 0u;
    for (;;) {
        sum = 0u; cnt = 0u; mine = 0u;
#pragma unroll
        for (unsigned j = 0; j < 16; ++j) { const unsigned c = xb_ld(&bar[XB_XCNT(j)]); sum += c; cnt += (c > 0u) ? 1u : 0u; mine = (j == x) ? c : mine; }
        if (sum == G) break;
        __builtin_amdgcn_s_sleep(1);
        if ((++sp & 255u) == 0u) { if (xb_ld(&bar[XB_TMO])) break; if (sp > XB_SPIN_CAP) { atomicAdd(&bar[XB_TMO], 1u); break; } }
    }
    nloc = mine > 0u ? mine : 1u; nx = cnt > 0u ? cnt : 1u;
}
__device__ __noinline__ void xcd_barrier_impl(unsigned* bar_, unsigned x_, volatile LAS unsigned* st_) {
    XcdBarrier b; b.bar = bar_; b.x = x_; b.st = st_;
    asm volatile("s_waitcnt vmcnt(0)" ::: "memory");
    __syncthreads();
    if (threadIdx.x == 0) {
        unsigned* bar = b.bar;
        __builtin_amdgcn_s_waitcnt(0);
        unsigned nloc = b.st[0], nx = b.st[1];
        if (nloc == 0u) { xcd_barrier_complete(bar, b.x, nloc, nx); b.st[0] = nloc; b.st[1] = nx; }
        const unsigned old = xb_add(&bar[XB_XSUB(b.x)], 1u);
        const unsigned gen = old / nloc;
        if (old + 1u == (gen + 1u) * nloc) {
            __builtin_amdgcn_fence(__ATOMIC_RELEASE, "agent");
            asm volatile("s_waitcnt vmcnt(0)" ::: "memory");
            const unsigned og = xb_add(&bar[XB_TOP], 1u);
            const unsigned tg = og / nx;
            if (og + 1u == (tg + 1u) * nx) xb_add(&bar[XB_TOPGEN], 1u);
            else XB_SPIN(xb_ld(&bar[XB_TOPGEN]) == tg, bar);
            __builtin_amdgcn_fence(__ATOMIC_ACQUIRE, "agent");
            xb_add(&bar[XB_XGEN(b.x)], 1u);
            asm volatile("s_waitcnt vmcnt(0)" ::: "memory");
        } else {
            XB_SPIN(xb_ld(&bar[XB_XGEN(b.x)]) == gen, bar);
            __builtin_amdgcn_fence(__ATOMIC_ACQUIRE, "agent");
            asm volatile("s_waitcnt vmcnt(0)" ::: "memory");
        }
    }
    __syncthreads();
}
__device__ __forceinline__ void xcd_barrier(const XcdBarrier& b) { xcd_barrier_impl(b.bar, b.x, b.st); }
namespace pg8 {
constexpr int BM = 256, BK = 64, HALF = 128, HTB = HALF * BK * 2, STAGE_BYTES = 8 * HTB, NXCD = 8, WGM = 8;
__host__ __device__ __forceinline__ int lds_byte(int r, int c) { const int st = (r >> 4) * 2 + (c >> 5), rr = r & 15, cc = c & 31, ob = rr * 64 + cc * 2; return st * 1024 + (ob ^ (((ob >> 9) & 1) << 5)); }
__host__ __device__ __forceinline__ void stage_rc(int b, int& R, int& C) { const int st = b / 1024, sb = b % 1024, swz = sb ^ (((sb >> 9) & 1) << 5); R = (st >> 1) * 16 + swz / 64; C = (st & 1) * 32 + (swz % 64) / 2; }
__host__ __device__ __forceinline__ int perm32(int rho) { const int n = rho >> 4, i = rho & 15; return 8 * (i >> 2) + 4 * n + (i & 3); }

struct Unit { int pm, pn; };
typedef int i32x4 __attribute__((ext_vector_type(4)));
typedef int i32x8 __attribute__((ext_vector_type(8)));
__device__ __forceinline__ bf16x8 lo8(i32x8 a) { return __builtin_bit_cast(bf16x8, (i32x4)__builtin_shufflevector(a, a, 0, 1, 2, 3)); }
__device__ __forceinline__ bf16x8 hi8(i32x8 a) { return __builtin_bit_cast(bf16x8, (i32x4)__builtin_shufflevector(a, a, 4, 5, 6, 7)); }
struct GridOrder {
    int nM, nN, nwg, G, c;
    __device__ __forceinline__ void init(int nM_, int nN_, int G_, int c_) { nM = nM_; nN = nN_; nwg = nM * nN; G = G_; c = c_; }
    __device__ __forceinline__ bool next(int i, Unit& u) const {
        const long L = (long)i * G + c; if (L >= nwg) return false;
        int wgid = (int)L; { const int q = nwg / NXCD, r = nwg % NXCD, xcd = wgid % NXCD, off = wgid / NXCD; wgid = (xcd < r ? xcd * (q + 1) : r * (q + 1) + (xcd - r) * q) + off; }
        const int nig = WGM * nN, gid = wgid / nig, fm = gid * WGM, gsz = (nM - fm) < WGM ? (nM - fm) : WGM;
        u.pm = fm + ((wgid % nig) % gsz); u.pn = (wgid % nig) / gsz; return true;
    }
};

template <class Prob, class Epi>
__device__ __forceinline__ void gemm_phase(LAS unsigned char* lds, const int tid, const Prob& Pb, const GridOrder& S, const Epi& E) {
    const int wid = __builtin_amdgcn_readfirstlane(tid >> 6), lane = tid & 63, wr = wid >> 2, wc = wid & 3, fr = lane & 15, fq = lane >> 4;
    constexpr int ES = Prob::ES;
    const int K = Pb.K, nt = K * ES / 128;
    unsigned voffA[2], voffB[2];
#pragma unroll
    for (int i = 0; i < 2; ++i) { int R, C; stage_rc(tid * 16 + i * 8192, R, C); const int Rb = Epi::PERM ? ((R & ~31) + perm32(R & 31)) : R;
        voffA[i] = (unsigned)(R * K * ES + C * 2); voffB[i] = (unsigned)(Rb * K * ES + C * 2); }
    const size_t kstep = (size_t)(BK * 2);
    const size_t hstep = (size_t)HALF * K * ES;
    const unsigned ldsw = (unsigned)wid * 1024u;
    const int aoff = lds_byte(wr * 64 + fr, fq * 8), boff = lds_byte(wc * 32 + fr, fq * 8);
#define PG8_SA(b, h) (((b) * 2 + (h)) * HTB)
#define PG8_SB(b, h) ((4 + (b) * 2 + (h)) * HTB)
#define PG8_STAGE(bufoff, gbase, voff) do { _Pragma("unroll") for (int _i = 0; _i < 2; ++_i) \
        __builtin_amdgcn_global_load_lds((const unsigned*)((const char*)(gbase) + (voff)[_i]), (LAS unsigned*)(lds + (bufoff) + ldsw + _i * 8192), 16, 0, 0); } while (0)
#define PG8_LDA(dst, b, h) do { _Pragma("unroll") for (int m = 0; m < 4; ++m) { const i32x4 _l0 = *(const LAS i32x4*)(lds + PG8_SA(b, h) + aoff + m * 2048), _l1 = *(const LAS i32x4*)(lds + PG8_SA(b, h) + aoff + m * 2048 + 1024); \
        dst[m] = __builtin_shufflevector(_l0, _l1, 0, 1, 2, 3, 4, 5, 6, 7); } } while (0)
#define PG8_LDB(dst, b, h) do { _Pragma("unroll") for (int n = 0; n < 2; ++n) { const i32x4 _l0 = *(const LAS i32x4*)(lds + PG8_SB(b, h) + boff + n * 2048), _l1 = *(const LAS i32x4*)(lds + PG8_SB(b, h) + boff + n * 2048 + 1024); \
        dst[n] = __builtin_shufflevector(_l0, _l1, 0, 1, 2, 3, 4, 5, 6, 7); } } while (0)
#define PG8_MMA(ai, bj, At, Bt) do { __builtin_amdgcn_s_setprio(1); _Pragma("unroll") for (int m = 0; m < 4; ++m) _Pragma("unroll") for (int n = 0; n < 2; ++n) { \
        if (ES == 2) { acc[ai][bj][m][n] = __builtin_amdgcn_mfma_f32_16x16x32_bf16(lo8(Bt[n]), lo8(At[m]), acc[ai][bj][m][n], 0, 0, 0); \
                       acc[ai][bj][m][n] = __builtin_amdgcn_mfma_f32_16x16x32_bf16(hi8(Bt[n]), hi8(At[m]), acc[ai][bj][m][n], 0, 0, 0); } \
        else { asm volatile("v_mfma_scale_f32_16x16x128_f8f6f4 %0, %1, %2, %0, %3, %3 op_sel_hi:[0,0,0]" : "+v"(acc[ai][bj][m][n]) : "v"(Bt[n]), "v"(At[m]), "v"(sc127)); DBG_EXTRA_MFMA(Bt[n], At[m]); } } \
        __builtin_amdgcn_s_setprio(0); } while (0)
#define PG8_WAIT_V(n) asm volatile("s_waitcnt vmcnt(" #n ")" ::: "memory")
#define PG8_WAIT_L(n) asm volatile("s_waitcnt lgkmcnt(" #n ")" ::: "memory")
#define PG8_BAR __builtin_amdgcn_s_barrier()
#define PG8_SCHED __builtin_amdgcn_sched_barrier(0)
    Unit cur, nxt; int ui = 0;
    if (!S.next(0, cur)) return;
#if defined(DBG_MFMA2)
    f32x4 dummy = {0.f, 0.f, 0.f, 0.f};
#define DBG_EXTRA_MFMA(b, a) asm volatile("v_mfma_scale_f32_16x16x128_f8f6f4 %0, %1, %2, %0, %3, %3 op_sel_hi:[0,0,0]" : "+v"(dummy) : "v"(b), "v"(a), "v"(sc127))
#else
#define DBG_EXTRA_MFMA(b, a) do {} while (0)
#endif
    int sc127 = 127; asm volatile("" : "+v"(sc127));
    f32x4 acc[2][2][4][2];
#pragma unroll
    for (int a = 0; a < 2; ++a)
#pragma unroll
        for (int b = 0; b < 2; ++b)
#pragma unroll
            for (int m = 0; m < 4; ++m)
#pragma unroll
                for (int n = 0; n < 2; ++n) acc[a][b][m][n] = (f32x4){0.f, 0.f, 0.f, 0.f};
    i32x8 At[4], B0[2], B1[2];
    const char* cA = (const char*)Pb.Abase + (size_t)Pb.a_row0(cur) * K * ES; const char* cB = (const char*)Pb.Btbase + (size_t)Pb.b_row0(cur) * K * ES;
    PG8_STAGE(PG8_SB(0, 0), cB, voffB); PG8_STAGE(PG8_SA(0, 0), cA, voffA); PG8_STAGE(PG8_SB(0, 1), cB + hstep, voffB); PG8_STAGE(PG8_SA(0, 1), cA + hstep, voffA);
    if (wr == 1) PG8_BAR;
    PG8_WAIT_V(4); PG8_BAR;
    PG8_STAGE(PG8_SB(1, 0), cB + kstep, voffB); PG8_STAGE(PG8_SA(1, 0), cA + kstep, voffA); PG8_STAGE(PG8_SB(1, 1), cB + hstep + kstep, voffB);
    PG8_WAIT_V(6); PG8_BAR;
    for (;;) {
        const bool has_next = S.next(ui + 1, nxt);
        const char* nA = has_next ? (const char*)Pb.Abase + (size_t)Pb.a_row0(nxt) * K * ES : cA; const char* nB = has_next ? (const char*)Pb.Btbase + (size_t)Pb.b_row0(nxt) * K * ES : cB;
        for (int t = 0; t < nt; t += 2) {
            const bool last = (t == nt - 2);
            const char* a1 = cA + (size_t)(t + 1) * kstep;
            const char* a2 = last ? nA : cA + (size_t)(t + 2) * kstep; const char* b2 = last ? nB : cB + (size_t)(t + 2) * kstep;
            const char* a3 = a2 + kstep; const char* b3 = b2 + kstep;
            PG8_LDB(B0, 0, 0); PG8_SCHED; PG8_LDA(At, 0, 0); PG8_STAGE(PG8_SA(1, 1), a1 + hstep, voffA);
            PG8_WAIT_L(8); PG8_BAR; PG8_WAIT_L(0); PG8_MMA(0, 0, At, B0); PG8_BAR; PG8_SCHED;
            PG8_LDB(B1, 0, 1); PG8_STAGE(PG8_SB(0, 0), b2, voffB);
            PG8_BAR; PG8_WAIT_L(0); PG8_MMA(0, 1, At, B1); PG8_BAR;
            PG8_LDA(At, 0, 1); PG8_STAGE(PG8_SA(0, 0), a2, voffA);
            PG8_BAR; PG8_WAIT_L(0); PG8_MMA(1, 0, At, B0); PG8_BAR; PG8_SCHED;
            PG8_STAGE(PG8_SB(0, 1), b2 + hstep, voffB);
            PG8_WAIT_V(6); PG8_BAR; PG8_MMA(1, 1, At, B1); PG8_BAR;
            PG8_LDB(B0, 1, 0); PG8_SCHED; PG8_LDA(At, 1, 0); PG8_STAGE(PG8_SA(0, 1), a2 + hstep, voffA);
            PG8_WAIT_L(8); PG8_BAR; PG8_WAIT_L(0); PG8_MMA(0, 0, At, B0); PG8_BAR; PG8_SCHED;
            PG8_LDB(B1, 1, 1); PG8_STAGE(PG8_SB(1, 0), b3, voffB);
            PG8_BAR; PG8_WAIT_L(0); PG8_MMA(0, 1, At, B1); PG8_BAR;
            PG8_LDA(At, 1, 1); PG8_STAGE(PG8_SA(1, 0), a3, voffA);
            PG8_BAR; PG8_WAIT_L(0); PG8_MMA(1, 0, At, B0); PG8_BAR; PG8_SCHED;
            PG8_STAGE(PG8_SB(1, 1), b3 + hstep, voffB);
            PG8_WAIT_V(6); PG8_BAR; PG8_MMA(1, 1, At, B1); PG8_BAR;
        }
        if (ES == 1) asm volatile("s_nop 15\n\ts_nop 15" ::: "memory");
        E(acc, cur, wr, wc, fr, fq);
        if (!has_next) break;
#pragma unroll
        for (int a = 0; a < 2; ++a)
#pragma unroll
            for (int b = 0; b < 2; ++b)
#pragma unroll
                for (int m = 0; m < 4; ++m)
#pragma unroll
                    for (int n = 0; n < 2; ++n) acc[a][b][m][n] = (f32x4){0.f, 0.f, 0.f, 0.f};
        cur = nxt; cA = nA; cB = nB; ++ui;
    }
    PG8_WAIT_V(0);
    if (wr == 0) PG8_BAR;
    PG8_BAR;
#undef PG8_SA
#undef PG8_SB
#undef PG8_STAGE
#undef PG8_LDA
#undef PG8_LDB
#undef PG8_MMA
#undef PG8_WAIT_V
#undef PG8_WAIT_L
#undef PG8_BAR
#undef PG8_SCHED
}
__device__ __forceinline__ unsigned cvt_pk_bf16(float lo, float hi) { unsigned r; asm volatile("v_cvt_pk_bf16_f32 %0, %1, %2" : "=v"(r) : "v"(lo), "v"(hi)); return r; }

struct DenseProb {
    static constexpr bool GATHER = false; static constexpr int ES = 2;
    const bf16_t* Abase; const bf16_t* Btbase; const int* rowidx; int K;
    __device__ __forceinline__ int a_row0(const Unit& u) const { return u.pm * BM; }
    __device__ __forceinline__ int b_row0(const Unit& u) const { return u.pn * BM; }
};
struct Dense8Prob {
    static constexpr bool GATHER = false; static constexpr int ES = 1;
    const void* Abase; const void* Btbase; const int* rowidx; int K;
    __device__ __forceinline__ int a_row0(const Unit& u) const { return u.pm * BM; }
    __device__ __forceinline__ int b_row0(const Unit& u) const { return u.pn * BM; }
};
struct EpiBf16 {
    static constexpr bool PERM = true;
    bf16_t* O; int ldc; float scale;
    __device__ __forceinline__ void operator()(const f32x4 (&acc)[2][2][4][2], const Unit& u, int wr, int wc, int fr, int fq) const {
        const int row0 = u.pm * BM + wr * 64 + fr, col0 = u.pn * BM + wc * 32 + 8 * fq;
#pragma unroll
        for (int ai = 0; ai < 2; ++ai)
#pragma unroll
            for (int m = 0; m < 4; ++m) { bf16_t* rowp = O + (size_t)(row0 + ai * HALF + m * 16) * ldc + col0;
#pragma unroll
                for (int bj = 0; bj < 2; ++bj) { const f32x4 v0 = acc[ai][bj][m][0] * scale, v1 = acc[ai][bj][m][1] * scale;
                    u32x4 w; w.x = cvt_pk_bf16(v0[0], v0[1]); w.y = cvt_pk_bf16(v0[2], v0[3]); w.z = cvt_pk_bf16(v1[0], v1[1]); w.w = cvt_pk_bf16(v1[2], v1[3]);
                    *(u32x4*)(rowp + bj * HALF) = w; } }
    }
};
struct MoeMap { int EG, e0;
    __device__ __forceinline__ void split(int pm, int& el, int& mt) const { if (pm < EG * 32) { el = pm >> 5; mt = pm & 31; } else { const int q = pm - EG * 32; el = q >> 1; mt = 32 + (q & 1); } }
};
__device__ __forceinline__ unsigned pk4_fp8(float a, float b, float c, float d) {
    a = fminf(fmaxf(a, -448.f), 448.f); b = fminf(fmaxf(b, -448.f), 448.f); c = fminf(fmaxf(c, -448.f), 448.f); d = fminf(fmaxf(d, -448.f), 448.f);
    int w = 0; w = __builtin_amdgcn_cvt_pk_fp8_f32(a, b, w, false); w = __builtin_amdgcn_cvt_pk_fp8_f32(c, d, w, true); return (unsigned)w; }
struct GuProb {
    static constexpr bool GATHER = false; static constexpr int ES = 1;
    const void* Abase; const void* Btbase; const int* rowidx; int K; MoeMap mp;
    __device__ __forceinline__ int a_row0(const Unit& u) const { int el, mt; mp.split(u.pm, el, mt); return (mp.e0 + el) * EROWS + mt * BM; }
    __device__ __forceinline__ int b_row0(const Unit& u) const { int el, mt; mp.split(u.pm, el, mt); return (mp.e0 + el) * (2 * FF) + u.pn * BM; }
};
struct EpiGU {
    static constexpr bool PERM = true;
    unsigned char* he; MoeMap mp;
    __device__ __forceinline__ void operator()(const f32x4 (&acc)[2][2][4][2], const Unit& u, int wr, int wc, int fr, int fq) const {
        int el, mt; mp.split(u.pm, el, mt);
        const int row0 = el * EROWS + mt * BM + wr * 64 + fr, col0 = u.pn * HALF + wc * 32 + 8 * fq;
#pragma unroll
        for (int ai = 0; ai < 2; ++ai)
#pragma unroll
            for (int m = 0; m < 4; ++m) { unsigned char* rowp = he + (size_t)(row0 + ai * HALF + m * 16) * FF + col0;
                float o[8];
#pragma unroll
                for (int n = 0; n < 2; ++n)
#pragma unroll
                    for (int j = 0; j < 4; ++j) { const float g = acc[ai][0][m][n][j] * (1.f / 128.f), up = acc[ai][1][m][n][j] * (1.f / 128.f); o[n * 4 + j] = g / (1.f + __expf(-g)) * up * 8.f; }
                u32x2 w; w.x = pk4_fp8(o[0], o[1], o[2], o[3]); w.y = pk4_fp8(o[4], o[5], o[6], o[7]);
                *(u32x2*)rowp = w; }
    }
};
struct DownProb {
    static constexpr bool GATHER = false; static constexpr int ES = 1;
    const void* Abase; const void* Btbase; const int* rowidx; int K; MoeMap mp;
    __device__ __forceinline__ int a_row0(const Unit& u) const { int el, mt; mp.split(u.pm, el, mt); return el * EROWS + mt * BM; }
    __device__ __forceinline__ int b_row0(const Unit& u) const { int el, mt; mp.split(u.pm, el, mt); return (mp.e0 + el) * D + u.pn * BM; }
};
struct EpiDown {
    static constexpr bool PERM = true;
    bf16_t* y; const float* gate; MoeMap mp;
    __device__ __forceinline__ void operator()(const f32x4 (&acc)[2][2][4][2], const Unit& u, int wr, int wc, int fr, int fq) const {
        int el, mt; mp.split(u.pm, el, mt);
        const int row0 = (mp.e0 + el) * EROWS + mt * BM + wr * 64 + fr, col0 = u.pn * BM + wc * 32 + 8 * fq;
#pragma unroll
        for (int ai = 0; ai < 2; ++ai)
#pragma unroll
            for (int m = 0; m < 4; ++m) { const int row = row0 + ai * HALF + m * 16; const float g = gate[row] * (1.f / 2048.f); bf16_t* rowp = y + (size_t)row * D + col0;
#pragma unroll
                for (int bj = 0; bj < 2; ++bj) { const f32x4 v0 = acc[ai][bj][m][0] * g, v1 = acc[ai][bj][m][1] * g;
                    u32x4 w; w.x = cvt_pk_bf16(v0[0], v0[1]); w.y = cvt_pk_bf16(v0[2], v0[3]); w.z = cvt_pk_bf16(v1[0], v1[1]); w.w = cvt_pk_bf16(v1[2], v1[3]);
                    *(u32x4*)(rowp + bj * HALF) = w; } }
    }
};
}
struct Frame {
    LAS unsigned char* lds;
    int tid, lane, wave, G, bid;
    float* out; unsigned char* ws;
};
__device__ __forceinline__ const float* INP(int i) {
    const __attribute__((address_space(4))) char* k = (const __attribute__((address_space(4))) char*)__builtin_amdgcn_kernarg_segment_ptr();
    asm volatile("" : "+s"(k));
    return *(const float* const __attribute__((address_space(4)))*)(k + 8 * i);
}
#define IN_X 0
#define IN_C 1
#define IN_CTX 2
#define IN_CCTX 3
#define IN_WADA 4
#define IN_BADA 5
#define IN_GMIXPRE 6
#define IN_GMIXPOST 7
#define IN_GFFNPRE 8
#define IN_GFFNPOST 9
#define IN_WIN 10
#define IN_CONVW 11
#define IN_CONVB 12
#define IN_DTBIAS 13
#define IN_ALOG 14
#define IN_DSKIP 15
#define IN_GSSD 16
#define IN_SINK 17
#define IN_WOUT 18
#define IN_WROUTER 19
#define IN_WGATE 20
#define IN_WUP 21
#define IN_WDOWN 22

__device__ __forceinline__ const float* mod_ptr(const Frame& F, int l, int row  , int part  ) {
    return (const float*)(F.ws + WS_MOD) + ((size_t)(l * 17 + row) * 6144 + part * 1024);
}
__device__ __forceinline__ int tok_modrow(int row) { return row < NLAT ? (row >> 12) : 16; }

template <class RowMap>
__device__ __forceinline__ void transpose_item(const float* W, int K, int N, bf16_t* WT, RowMap rm, LAS float* scr, int kb, int nb, int lane) {
    const int k0 = 64 * kb, n0 = 32 * nb;
    const int nn = n0 + (lane & 31);
#pragma unroll 8
    for (int i = 0; i < 32; ++i) { const int kk = 2 * i + (lane >> 5); scr[kk * 33 + (lane & 31)] = (nn < N) ? W[(size_t)(k0 + kk) * N + nn] : 0.f; }
    LDS_FENCE();
    const int c = lane & 7;
#pragma unroll
    for (int j = 0; j < 4; ++j) { const int n = (lane >> 3) + 8 * j; const LAS float* s = scr + (8 * c) * 33 + n;
        u32x4 o; o.x = pk2(s[0 * 33], s[1 * 33]); o.y = pk2(s[2 * 33], s[3 * 33]); o.z = pk2(s[4 * 33], s[5 * 33]); o.w = pk2(s[6 * 33], s[7 * 33]);
        *(u32x4*)(WT + (size_t)rm(n0 + n) * K + k0 + 8 * c) = o; }
    LDS_FENCE();
}
struct RmId { __device__ __forceinline__ int operator()(int n) const { return n; } };
struct RmGU { int s; __device__ __forceinline__ int operator()(int n) const { return 256 * (n >> 7) + 128 * s + (n & 127); } };
template <class RowMap>
__device__ __forceinline__ void transpose_item_fp8(const float* W, int K, int N, unsigned char* WT, RowMap rm, float scale, LAS float* scr, int kb, int nb, int lane) {
    const int k0 = 64 * kb, n0 = 32 * nb;
    const int nn = n0 + (lane & 31);
#pragma unroll 8
    for (int i = 0; i < 32; ++i) { const int kk = 2 * i + (lane >> 5); scr[kk * 33 + (lane & 31)] = (nn < N) ? W[(size_t)(k0 + kk) * N + nn] * scale : 0.f; }
    LDS_FENCE();
    const int c = lane & 7;
#pragma unroll
    for (int j = 0; j < 4; ++j) { const int n = (lane >> 3) + 8 * j; const LAS float* s = scr + (8 * c) * 33 + n;
        u32x2 o; o.x = pg8::pk4_fp8(s[0 * 33], s[1 * 33], s[2 * 33], s[3 * 33]); o.y = pg8::pk4_fp8(s[4 * 33], s[5 * 33], s[6 * 33], s[7 * 33]);
        *(u32x2*)(WT + (size_t)rm(n0 + n) * K + k0 + 8 * c) = o; }
    LDS_FENCE();
}

__device__ __forceinline__ void convert_experts(const Frame& F, int l) {
    LAS float* scr = (LAS float*)(F.lds + F.wave * 16384);
    const int gw = F.bid * NWAVES + F.wave, NGW = F.G * NWAVES;
    constexpr int I_G = 16 * 88, I_D = 44 * 32;
    constexpr int PER_E = 2 * I_G + I_D;
    unsigned char* Wgu = F.ws + WS_WGU; unsigned char* Wd = F.ws + WS_WD;
    for (int it = gw; it < NE * PER_E; it += NGW) {
        const int e = it / PER_E; int r = it % PER_E;
        if (r < I_G) { transpose_item_fp8(INP(IN_WGATE) + (size_t)(l * NE + e) * D * FF, D, FF, Wgu + (size_t)e * 2 * FF * D, RmGU{0}, 128.f, scr, r / 88, r % 88, F.lane); continue; } r -= I_G;
        if (r < I_G) { transpose_item_fp8(INP(IN_WUP) + (size_t)(l * NE + e) * D * FF, D, FF, Wgu + (size_t)e * 2 * FF * D, RmGU{1}, 128.f, scr, r / 88, r % 88, F.lane); continue; } r -= I_G;
        transpose_item_fp8(INP(IN_WDOWN) + (size_t)(l * NE + e) * FF * D, FF, D, Wd + (size_t)e * D * FF, RmId{}, 256.f, scr, r / 32, r % 32, F.lane);
    }
}

__device__ __forceinline__ void p0_prologue(const Frame& F) {
    if (F.bid < 192) {
        LAS float* sc = (LAS float*)F.lds;
        LAS float* red = (LAS float*)(F.lds + 17 * 1024 * 4);
        for (int i = F.tid; i < 17 * 1024; i += NTHR) { const int r = i >> 10, k = i & 1023; const float v = r < 16 ? INP(IN_C)[r * 1024 + k] : INP(IN_CCTX)[k]; sc[i] = siluf(v); }
        __syncthreads();
        const int l = F.bid / 96, n0 = (F.bid % 96) * 64;
        const float* W = INP(IN_WADA) + (size_t)l * D * 6144 + n0 + F.lane;
        float acc[17];
#pragma unroll
        for (int r = 0; r < 17; ++r) acc[r] = 0.f;
        for (int k = F.wave; k < 1024; k += 8) { const float w = W[(size_t)k * 6144];
#pragma unroll
            for (int r = 0; r < 17; ++r) acc[r] += sc[r * 1024 + k] * w; }
#pragma unroll
        for (int r = 0; r < 17; ++r) red[(F.wave * 17 + r) * 64 + F.lane] = acc[r];
        __syncthreads();
        for (int i = F.tid; i < 17 * 64; i += NTHR) { const int r = i >> 6, c = i & 63; float s = 0.f;
#pragma unroll
            for (int w = 0; w < 8; ++w) s += red[(w * 17 + r) * 64 + c];
            ((float*)(F.ws + WS_MOD))[(size_t)(l * 17 + r) * 6144 + n0 + c] = s + INP(IN_BADA)[l * 6144 + n0 + c]; }
        __syncthreads();
    }
    if (F.bid == 255) {
        for (int i = F.tid; i < 1024; i += NTHR) { const int pos = i >> 4, f = i & 15; const float inv = powf(10000.f, -(float)f / 16.f); const float ang = (float)pos * inv;
            ((float*)(F.ws + WS_ROPE))[2 * i] = cosf(ang); ((float*)(F.ws + WS_ROPE))[2 * i + 1] = sinf(ang); }
    }
    {
        LAS float* scr = (LAS float*)(F.lds + F.wave * 16384);
        const int gw = F.bid * NWAVES + F.wave, NGW = F.G * NWAVES;
        constexpr int I_IN = 16 * 72, I_OUT = 16 * 32;
        for (int it = gw; it < 2 * (I_IN + I_OUT); it += NGW) {
            const int l = it / (I_IN + I_OUT); int r = it % (I_IN + I_OUT);
            if (r < I_IN) { transpose_item(INP(IN_WIN) + (size_t)l * D * INW, D, INW, (bf16_t*)(F.ws + WS_WIN) + (size_t)l * PW * D, RmId{}, scr, r / 72, r % 72, F.lane); continue; } r -= I_IN;
            transpose_item(INP(IN_WOUT) + (size_t)l * D * D, D, D, (bf16_t*)(F.ws + WS_WOUT) + (size_t)l * D * D, RmId{}, scr, r / 32, r % 32, F.lane);
        }
    }
    convert_experts(F, 0);
}

struct Row16 { f32x4 v[4]; };
__device__ __forceinline__ Row16 ld_row_f32(const float* p, int lane) { Row16 r; const f32x4* q = (const f32x4*)p + lane;
#pragma unroll
    for (int j = 0; j < 4; ++j) r.v[j] = q[64 * j];
    return r; }
__device__ __forceinline__ void st_row_f32(float* p, int lane, const Row16& r) { f32x4* q = (f32x4*)p + lane;
#pragma unroll
    for (int j = 0; j < 4; ++j) q[64 * j] = r.v[j]; }
__device__ __forceinline__ Row16 ld_row_bf16(const bf16_t* p, int lane) { Row16 r; const u32x2* q = (const u32x2*)p + lane;
#pragma unroll
    for (int j = 0; j < 4; ++j) { const u32x2 w = q[64 * j]; r.v[j] = (f32x4){lo2f(w.x), hi2f(w.x), lo2f(w.y), hi2f(w.y)}; }
    return r; }
__device__ __forceinline__ void st_row_bf16(bf16_t* p, int lane, const Row16& r) { u32x2* q = (u32x2*)p + lane;
#pragma unroll
    for (int j = 0; j < 4; ++j) { u32x2 w; w.x = pk2(r.v[j][0], r.v[j][1]); w.y = pk2(r.v[j][2], r.v[j][3]); q[64 * j] = w; } }
__device__ __forceinline__ float row_rstd(const Row16& r) { float s = 0.f;
#pragma unroll
    for (int j = 0; j < 4; ++j) s += (r.v[j][0] * r.v[j][0] + r.v[j][1] * r.v[j][1]) + (r.v[j][2] * r.v[j][2] + r.v[j][3] * r.v[j][3]);
    return rsqrtf(wave_sum(s) * (1.f / D) + EPS); }
__device__ __forceinline__ Row16 norm_mod(const Row16& h, const float* g, const float* sh, const float* sc, int lane) {
    const float rstd = row_rstd(h); const Row16 G = ld_row_f32(g, lane), SH = ld_row_f32(sh, lane), SC = ld_row_f32(sc, lane); Row16 u;
#pragma unroll
    for (int j = 0; j < 4; ++j) u.v[j] = (h.v[j] * rstd * G.v[j]) * (SC.v[j] + 1.f) + SH.v[j];
    return u; }

struct RawRow8 { u32x2 w[4]; };
__device__ __forceinline__ RawRow8 ld_raw_bf16(const bf16_t* p, int lane) { RawRow8 r; const u32x2* q = (const u32x2*)p + lane;
#pragma unroll
    for (int j = 0; j < 4; ++j) r.w[j] = q[64 * j];
    return r; }
__device__ __forceinline__ Row16 cvt_raw(const RawRow8& r) { Row16 o;
#pragma unroll
    for (int j = 0; j < 4; ++j) o.v[j] = (f32x4){lo2f(r.w[j].x), hi2f(r.w[j].x), lo2f(r.w[j].y), hi2f(r.w[j].y)};
    return o; }
__device__ __forceinline__ Row16 row_mul(const Row16& a, const Row16& b) { Row16 o;
#pragma unroll
    for (int j = 0; j < 4; ++j) o.v[j] = a.v[j] * b.v[j];
    return o; }
__device__ __forceinline__ Row16 row_mul1p(const Row16& a, const Row16& b) { Row16 o;
#pragma unroll
    for (int j = 0; j < 4; ++j) o.v[j] = a.v[j] * (b.v[j] + 1.f);
    return o; }

__device__ __forceinline__ void e1_phase(const Frame& F) {
    const int gw = F.bid * NWAVES + F.wave, NGW = F.G * NWAVES, rpw = (NT + NGW - 1) / NGW;
    const int r0 = gw * rpw, r1 = (r0 + rpw < NT) ? r0 + rpw : NT;
    bf16_t* U = (bf16_t*)(F.ws + WS_BUFA);
    int cur = -1; Row16 Bv, Cv;
#define E1_SRC(r) ((r) < NLAT ? INP(IN_X) + (size_t)(r) * D : INP(IN_CTX) + (size_t)((r) - NLAT) * D)
    Row16 hN; if (r0 < r1) hN = ld_row_f32(E1_SRC(r0), F.lane);
    for (int row = r0; row < r1; ++row) {
        const Row16 h = hN;
        if (row + 1 < r1) hN = ld_row_f32(E1_SRC(row + 1), F.lane);
        const int mr = tok_modrow(row);
        if (mr != cur) { cur = mr; Bv = row_mul1p(ld_row_f32(INP(IN_GMIXPRE), F.lane), ld_row_f32(mod_ptr(F, 0, mr, 1), F.lane)); Cv = ld_row_f32(mod_ptr(F, 0, mr, 0), F.lane); }
        const float rstd = row_rstd(h); Row16 u;
#pragma unroll
        for (int j = 0; j < 4; ++j) u.v[j] = h.v[j] * rstd * Bv.v[j] + Cv.v[j];
        st_row_bf16(U + (size_t)row * D, F.lane, u);
    }
#undef E1_SRC
}

__device__ __forceinline__ void e3_phase(const Frame& F, int l) {
    const int nrows = (l == 0) ? NT : NLAT;
    LAS float* wr = (LAS float*)F.lds;
    for (int i = F.tid; i < 1024 * 16; i += NTHR) wr[(i & 15) * 1024 + (i >> 4)] = INP(IN_WROUTER)[(size_t)l * D * 16 + i];
    __syncthreads();
    LAS float* rbuf = (LAS float*)(F.lds + 65536 + F.wave * 4352);
    const int gw = F.bid * NWAVES + F.wave, NGW = F.G * NWAVES, rpw = (nrows + NGW - 1) / NGW;
    const int r0 = gw * rpw, r1 = (r0 + rpw < nrows) ? r0 + rpw : nrows;
    const bf16_t* M = (const bf16_t*)(F.ws + WS_BUFB); unsigned char* U2 = F.ws + WS_BUFA; float* AFF = (float*)(F.ws + WS_AFF);
    const float* xin = INP(IN_X); const float* cin = INP(IN_CTX);
#define E3_HSRC(r) ((r) < NLAT ? ((l == 0) ? xin + (size_t)(r) * D : F.out + (size_t)(r) * D) : cin + (size_t)((r) - NLAT) * D)
    int cur = -1; Row16 Av, Bv, Cv;
    RawRow8 mN; Row16 hN;
    if (r0 < r1) { mN = ld_raw_bf16(M + (size_t)r0 * D, F.lane); hN = ld_row_f32(E3_HSRC(r0), F.lane); }
    for (int row = r0; row < r1; ++row) {
        const Row16 m = cvt_raw(mN); Row16 h = hN;
        if (row + 1 < r1) { mN = ld_raw_bf16(M + (size_t)(row + 1) * D, F.lane); hN = ld_row_f32(E3_HSRC(row + 1), F.lane); }
        const int mr = tok_modrow(row);
        if (mr != cur) { cur = mr;
            Av = row_mul(ld_row_f32(INP(IN_GMIXPOST) + l * D, F.lane), ld_row_f32(mod_ptr(F, l, mr, 2), F.lane));
            Bv = row_mul1p(ld_row_f32(INP(IN_GFFNPRE) + l * D, F.lane), ld_row_f32(mod_ptr(F, l, mr, 4), F.lane));
            Cv = ld_row_f32(mod_ptr(F, l, mr, 3), F.lane); }
        float* hdst = row < NLAT ? F.out + (size_t)row * D : (float*)(F.ws + WS_HCTX) + (size_t)(row - NLAT) * D;
        { const float rstd = row_rstd(m);
#pragma unroll
          for (int j = 0; j < 4; ++j) h.v[j] = h.v[j] + Av.v[j] * (m.v[j] * rstd); }
        st_row_f32(hdst, F.lane, h);
        Row16 u;
        { const float rstd = row_rstd(h);
#pragma unroll
          for (int j = 0; j < 4; ++j) u.v[j] = h.v[j] * rstd * Bv.v[j] + Cv.v[j]; }
        { unsigned* q8 = (unsigned*)(U2 + (size_t)row * D) + F.lane;
#pragma unroll
          for (int j = 0; j < 4; ++j) q8[64 * j] = pg8::pk4_fp8(u.v[j][0], u.v[j][1], u.v[j][2], u.v[j][3]); }
        float lg[16];
#pragma unroll
        for (int e = 0; e < 16; ++e) { float s = 0.f;
#pragma unroll
            for (int j = 0; j < 4; ++j) { const f32x4 w = *(const LAS f32x4*)(wr + e * 1024 + 4 * F.lane + 256 * j); s += u.v[j][0] * w[0] + u.v[j][1] * w[1] + u.v[j][2] * w[2] + u.v[j][3] * w[3]; }
            lg[e] = s; if ((e & 3) == 3) __builtin_amdgcn_sched_barrier(0); }
        {
#pragma unroll
            for (int e = 0; e < 16; ++e) rbuf[e * 68 + F.lane] = lg[e];
            LDS_FENCE();
            const int e = F.lane & 15, part = F.lane >> 4; float v = 0.f;
#pragma unroll
            for (int q = 0; q < 4; ++q) { const f32x4 t = *(const LAS f32x4*)(rbuf + e * 68 + part * 16 + 4 * q); v += (t[0] + t[1]) + (t[2] + t[3]); }
            LDS_FENCE();
            v += __shfl_xor(v, 16); v += __shfl_xor(v, 32);
            const float mx = row_max16(v), ex = __expf(v - mx), sm = row_sum16(ex);
            if (part == 0) AFF[(size_t)row * 16 + e] = ex / sm;
        }
    }
#undef E3_HSRC
}

__device__ __forceinline__ void e5_phase(const Frame& F, int l) {
    const int nrows = (l == 0) ? NT : NLAT;
    const int gw = F.bid * NWAVES + F.wave, NGW = F.G * NWAVES, rpw = (nrows + NGW - 1) / NGW;
    const int r0 = gw * rpw, r1 = (r0 + rpw < nrows) ? r0 + rpw : nrows;
    const bf16_t* Y = (const bf16_t*)(F.ws + WS_BUFC); const short* SL = (const short*)(F.ws + WS_SLOT); bf16_t* U = (bf16_t*)(F.ws + WS_BUFA);
#define E5_HP(r) ((r) < NLAT ? F.out + (size_t)(r) * D : (float*)(F.ws + WS_HCTX) + (size_t)((r) - NLAT) * D)
    int cur = -1; Row16 Av, Bv, Cv;
    int slotN = -1; Row16 hN;
    if (r0 < r1) { slotN = (F.lane < 16) ? (int)SL[(size_t)r0 * 16 + F.lane] : -1; hN = ld_row_f32(E5_HP(r0), F.lane); }
    for (int row = r0; row < r1; ++row) {
        const int myslot = slotN; Row16 h = hN;
        Row16 f;
#pragma unroll
        for (int j = 0; j < 4; ++j) f.v[j] = (f32x4){0.f, 0.f, 0.f, 0.f};
        for (int e = 0; e < 16; ++e) { const int sl = __shfl(myslot, e);
            if (sl >= 0) { const Row16 y = ld_row_bf16(Y + ((size_t)e * EROWS + sl) * D, F.lane);
#pragma unroll
                for (int j = 0; j < 4; ++j) f.v[j] += y.v[j]; } }
        if (row + 1 < r1) { slotN = (F.lane < 16) ? (int)SL[(size_t)(row + 1) * 16 + F.lane] : -1; hN = ld_row_f32(E5_HP(row + 1), F.lane); }
        const int mr = tok_modrow(row);
        if (mr != cur) { cur = mr;
            Av = row_mul(ld_row_f32(INP(IN_GFFNPOST) + l * D, F.lane), ld_row_f32(mod_ptr(F, l, mr, 5), F.lane));
            if (l == 0) { Bv = row_mul1p(ld_row_f32(INP(IN_GMIXPRE) + D, F.lane), ld_row_f32(mod_ptr(F, 1, mr, 1), F.lane)); Cv = ld_row_f32(mod_ptr(F, 1, mr, 0), F.lane); } }
        { const float rstd = row_rstd(f);
#pragma unroll
          for (int j = 0; j < 4; ++j) h.v[j] = h.v[j] + Av.v[j] * (f.v[j] * rstd); }
        st_row_f32(E5_HP(row), F.lane, h);
        if (l == 0) { const float rstd = row_rstd(h); Row16 u;
#pragma unroll
            for (int j = 0; j < 4; ++j) u.v[j] = h.v[j] * rstd * Bv.v[j] + Cv.v[j];
            st_row_bf16(U + (size_t)row * D, F.lane, u); }
    }
#undef E5_HP
}

__device__ __forceinline__ int block_excl_scan(const Frame& F, int val, LAS int* wsum, int& total) {
    int x = val;
#pragma unroll
    for (int o = 1; o < 64; o <<= 1) { const int y = __shfl_up(x, o); if (F.lane >= o) x += y; }
    __syncthreads();
    if (F.lane == 63) wsum[F.wave] = x;
    __syncthreads();
    int off = 0, tot = 0;
#pragma unroll
    for (int w = 0; w < NWAVES; ++w) { const int s = wsum[w]; off += (w < F.wave) ? s : 0; tot += s; }
    total = tot;
    return x - val + off;
}
__device__ __forceinline__ void topk_unit(const Frame& F, int kind, int e, int b) {
    const int T = kind ? CTX : SEQ, cap = kind ? 32 : 512;
    const int row0 = kind ? NLAT + b * CTX : b * SEQ, base = kind ? 8192 + b * 32 : b * 512;
    LAS unsigned* hist = (LAS unsigned*)F.lds;
    LAS int* wsum = (LAS int*)(F.lds + 8192);
    LAS int* bc = (LAS int*)(F.lds + 8256);
    LAS int* selt = (LAS int*)(F.lds + 8320);
    const float* AFF = (const float*)(F.ws + WS_AFF);
    const int nown = kind ? (F.tid < 256 ? 1 : 0) : 8, t0 = kind ? F.tid : F.tid * 8;
    unsigned v[8];
#pragma unroll
    for (int k = 0; k < 8; ++k) v[k] = (k < nown) ? __float_as_uint(AFF[(size_t)(row0 + t0 + k) * 16 + e]) : 0u;
    unsigned prefix = 0u, mask = 0u; int need = cap;
#pragma unroll 1
    for (int pass = 0; pass < 3; ++pass) {
        const int shift = pass == 0 ? 21 : (pass == 1 ? 10 : 0), nbins = pass == 2 ? 1024 : 2048, per = nbins >> 9;
        __syncthreads();
        for (int i = F.tid; i < nbins; i += NTHR) hist[i] = 0u;
        __syncthreads();
#pragma unroll
        for (int k = 0; k < 8; ++k) if (k < nown && (v[k] & mask) == prefix) __hip_atomic_fetch_add(&hist[(v[k] >> shift) & (unsigned)(nbins - 1)], 1u, __ATOMIC_RELAXED, __HIP_MEMORY_SCOPE_WORKGROUP);
        __syncthreads();
        int c[4], cs = 0;
#pragma unroll
        for (int q = 0; q < 4; ++q) { c[q] = (q < per) ? (int)hist[F.tid * per + q] : 0; cs += c[q]; }
        int total; const int excl = block_excl_scan(F, cs, wsum, total);
        const int above = total - (excl + cs);
        if (above < need && need <= above + cs) {
            int acc = above, bin = -1, nn = 0;
#pragma unroll
            for (int q = 3; q >= 0; --q) if (q < per && bin < 0) { if (need <= acc + c[q]) { bin = F.tid * per + q; nn = need - acc; } else acc += c[q]; }
            bc[0] = bin; bc[1] = nn;
        }
        __syncthreads();
        const int bin = bc[0]; need = bc[1];
        prefix |= (unsigned)bin << shift; mask |= (unsigned)(nbins - 1) << shift;
    }
    const unsigned vstar = prefix;
    int ceq = 0;
#pragma unroll
    for (int k = 0; k < 8; ++k) ceq += (k < nown && v[k] == vstar) ? 1 : 0;
    int tot; int eqrank = block_excl_scan(F, ceq, wsum, tot);
    bool sel[8]; int csel = 0;
#pragma unroll
    for (int k = 0; k < 8; ++k) { const bool eq = (k < nown) && v[k] == vstar; sel[k] = (k < nown) && (v[k] > vstar || (eq && eqrank < need)); eqrank += eq ? 1 : 0; csel += sel[k] ? 1 : 0; }
    int slot = block_excl_scan(F, csel, wsum, tot);
    int* RI = (int*)(F.ws + WS_ROWIDX); float* GT = (float*)(F.ws + WS_GATE); short* SL = (short*)(F.ws + WS_SLOT);
#pragma unroll
    for (int k = 0; k < 8; ++k) if (k < nown) { const int t = t0 + k;
        if (sel[k]) { RI[e * EROWS + base + slot] = row0 + t; GT[e * EROWS + base + slot] = __uint_as_float(v[k]); SL[(size_t)(row0 + t) * 16 + e] = (short)(base + slot); selt[slot] = t; ++slot; }
        else SL[(size_t)(row0 + t) * 16 + e] = (short)-1; }
    __syncthreads();
    { const unsigned char* U8 = F.ws + WS_BUFA; unsigned char* AS = F.ws + WS_ASORT + ((size_t)e * EROWS + base) * D;
      for (int s0 = F.wave * 8; s0 < cap; s0 += NWAVES * 8) { u32x4 r[8];
#pragma unroll
          for (int q = 0; q < 8; ++q) r[q] = *(const u32x4*)(U8 + (size_t)(row0 + selt[s0 + q]) * D + 16 * F.lane);
#pragma unroll
          for (int q = 0; q < 8; ++q) *(u32x4*)(AS + (size_t)(s0 + q) * D + 16 * F.lane) = r[q]; } }
    __syncthreads();
}
__device__ __forceinline__ void topk_phase(const Frame& F, int l) {
    const int nunits = (l == 0) ? 512 : 256;
    for (int u = F.bid; u < nunits; u += F.G) { const int kind = u >> 8, e = (u & 255) >> 4, b = u & 15; topk_unit(F, kind, e, b); }
}
__device__ __forceinline__ void chunk_geom(int b, int c, int& rbase, int& t0, int& Tseg) {
    if (c < 2) { rbase = NLAT + b * CTX; t0 = c * 128; Tseg = CTX; } else { rbase = b * SEQ; t0 = (c - 2) * 128; Tseg = SEQ; }
}
__device__ __forceinline__ size_t st_index(int b, int c, int dir, int h) { return ((((size_t)b * NCH + c) * 2 + dir) * 6 + h) * 8192; }

__device__ __forceinline__ void dt_scan(const Frame& F, int l, const bf16_t* Pp, int row0, int dir, int h, float (&dt)[2], float (&incl)[2], float (&dA)[2], float& total) {
    const float bias = INP(IN_DTBIAS)[(l * 2 + dir) * 6 + h], a = -__expf(INP(IN_ALOG)[(l * 2 + dir) * 6 + h]);
#pragma unroll
    for (int q = 0; q < 2; ++q) { const float raw = bf2f(Pp[(size_t)(row0 + 2 * F.lane + q) * PW + PDT + dir * 6 + h]); dt[q] = softplusf(raw + bias); dA[q] = dt[q] * a; }
    float x = dA[0] + dA[1];
#pragma unroll
    for (int o = 1; o < 64; o <<= 1) { const float v = __shfl_up(x, o); if (F.lane >= o) x += v; }
    incl[1] = x; incl[0] = x - dA[1];
    total = __shfl(x, 63);
}

__device__ __forceinline__ void s1_unit(const Frame& F, int l, int b, int c, int g) {
    int rbase, t0, Tseg; chunk_geom(b, c, rbase, t0, Tseg);
    LAS bf16_t* Xs = (LAS bf16_t*)F.lds;
    LAS bf16_t* Bs = (LAS bf16_t*)(F.lds + 51200);
    LAS float* WF = (LAS float*)(F.lds + 86016);
    LAS float* WB = (LAS float*)(F.lds + 87552);
    const bf16_t* Pp = (const bf16_t*)(F.ws + WS_BUFB);
    bf16_t* XC = (bf16_t*)(F.ws + WS_BUFC + BC_XC);
    __syncthreads();
    if (F.tid < 448) {
        const int cg = F.tid % 56, run = F.tid / 56;
        const int ch = cg < 24 ? g * 192 + cg * 8 : (cg < 40 ? 384 + g * 128 + (cg - 24) * 8 : 640 + g * 128 + (cg - 40) * 8);
        float w[5][8], bias[8];
#pragma unroll
        for (int k = 0; k < 5; ++k) { const f32x4 a = *(const f32x4*)(INP(IN_CONVW) + (size_t)(l * 5 + k) * 896 + ch), bb = *(const f32x4*)(INP(IN_CONVW) + (size_t)(l * 5 + k) * 896 + ch + 4);
#pragma unroll
            for (int q = 0; q < 4; ++q) { w[k][q] = a[q]; w[k][4 + q] = bb[q]; } }
        { const f32x4 a = *(const f32x4*)(INP(IN_CONVB) + l * 896 + ch), bb = *(const f32x4*)(INP(IN_CONVB) + l * 896 + ch + 4);
#pragma unroll
          for (int q = 0; q < 4; ++q) { bias[q] = a[q]; bias[4 + q] = bb[q]; } }
        const int tt0 = 16 * run;
        u32x4 rows[20];
#pragma unroll
        for (int i = 0; i < 20; ++i) { const int t = t0 + tt0 + i - 2;
            rows[i] = (t >= 0 && t < Tseg) ? *(const u32x4*)(Pp + (size_t)(rbase + t) * PW + PX + ch) : (u32x4){0u, 0u, 0u, 0u}; }
#pragma unroll
        for (int i = 0; i < 16; ++i) {
            float o[8];
#pragma unroll
            for (int q = 0; q < 8; ++q) o[q] = bias[q];
#pragma unroll
            for (int k = 0; k < 5; ++k) { const u32x4 v = rows[i + k];
                o[0] += w[k][0] * lo2f(v.x); o[1] += w[k][1] * hi2f(v.x); o[2] += w[k][2] * lo2f(v.y); o[3] += w[k][3] * hi2f(v.y);
                o[4] += w[k][4] * lo2f(v.z); o[5] += w[k][5] * hi2f(v.z); o[6] += w[k][6] * lo2f(v.w); o[7] += w[k][7] * hi2f(v.w); }
#pragma unroll
            for (int q = 0; q < 8; ++q) o[q] = siluf(o[q]);
            u32x4 pk; pk.x = pk2(o[0], o[1]); pk.y = pk2(o[2], o[3]); pk.z = pk2(o[4], o[5]); pk.w = pk2(o[6], o[7]);
            *(u32x4*)(XC + (size_t)(rbase + t0 + tt0 + i) * 896 + ch) = pk;
            if (cg < 24) *(LAS u32x4*)(Xs + (tt0 + i) * 200 + cg * 8) = pk;
            else if (cg < 40) *(LAS u32x4*)(Bs + (tt0 + i) * 136 + (cg - 24) * 8) = pk;
        }
    }
    if (F.wave < 6) {
        const int dir = F.wave / 3, r = F.wave % 3, h = g * 3 + r;
        float dt[2], incl[2], dA[2], total;
        dt_scan(F, l, Pp, rbase + t0, dir, h, dt, incl, dA, total);
#pragma unroll
        for (int q = 0; q < 2; ++q) {
            const float wgt = dir == 0 ? dt[q] * __expf(total - incl[q]) : dt[q] * __expf(incl[q] - dA[q]);
            (dir == 0 ? WF : WB)[r * 128 + 2 * F.lane + q] = wgt; }
        if (F.lane == 0) ((float*)(F.ws + WS_DECAY))[((b * NCH + c) * 2 + dir) * 6 + h] = __expf(total);
    }
    __syncthreads();
    {
        const int li = F.lane & 15, gq = F.lane >> 4, pt = F.wave & 3, nh = F.wave >> 2;
        bf16x8 fn[4][4];
#pragma unroll
        for (int ks = 0; ks < 4; ++ks)
#pragma unroll
            for (int nt = 0; nt < 4; ++nt) fn[ks][nt] = frag_tr(Bs, 136, 32 * ks, 16 * (4 * nh + nt), li, gq);
        bf16_t* ST = (bf16_t*)(F.ws + WS_BUFC + BC_ST);
#pragma unroll 1
        for (int combo = 0; combo < 6; ++combo) {
            const int dir = combo / 3, r = combo % 3, h = g * 3 + r;
            const LAS float* W = (dir == 0 ? WF : WB) + r * 128;
            f32x4 acc[4];
#pragma unroll
            for (int nt = 0; nt < 4; ++nt) acc[nt] = (f32x4){0.f, 0.f, 0.f, 0.f};
#pragma unroll
            for (int ks = 0; ks < 4; ++ks) {
                const bf16x8 xr = frag_tr(Xs, 200, 32 * ks, r * 64 + 16 * pt, li, gq);
                const f32x4 w0 = *(const LAS f32x4*)(W + 32 * ks + 8 * gq), w1 = *(const LAS f32x4*)(W + 32 * ks + 8 * gq + 4);
                u32x4 pw;
                pw.x = pk2(bf2f((bf16_t)xr[0]) * w0[0], bf2f((bf16_t)xr[1]) * w0[1]); pw.y = pk2(bf2f((bf16_t)xr[2]) * w0[2], bf2f((bf16_t)xr[3]) * w0[3]);
                pw.z = pk2(bf2f((bf16_t)xr[4]) * w1[0], bf2f((bf16_t)xr[5]) * w1[1]); pw.w = pk2(bf2f((bf16_t)xr[6]) * w1[2], bf2f((bf16_t)xr[7]) * w1[3]);
                const bf16x8 xw = __builtin_bit_cast(bf16x8, pw);
#pragma unroll
                for (int nt = 0; nt < 4; ++nt) acc[nt] = mfma16(fn[ks][nt], xw, acc[nt]);
            }
            bf16_t* dst = ST + st_index(b, c, dir, h) + (size_t)(16 * pt + li) * 128;
#pragma unroll
            for (int nt = 0; nt < 4; ++nt) *(u32x2*)(dst + 16 * (4 * nh + nt) + 4 * gq) = pack4(acc[nt]);
        }
    }
}

__device__ __forceinline__ void s2_phase(const Frame& F) {
    bf16_t* ST = (bf16_t*)(F.ws + WS_BUFC + BC_ST); const float* DEC = (const float*)(F.ws + WS_DECAY);
    for (int it = F.bid * NTHR + F.tid; it < NB * 2 * 6 * 64 * 16; it += F.G * NTHR) {
        const int n8 = it & 15, p = (it >> 4) & 63, hh = (it >> 10) % 6, dir = ((it >> 10) / 6) & 1, b = (it >> 10) / 12;
        float hst[8];
#pragma unroll
        for (int q = 0; q < 8; ++q) hst[q] = 0.f;
#pragma unroll 2
        for (int s = 0; s < NCH; ++s) {
            const int c = dir == 0 ? s : (s < 2 ? 1 - s : NCH + 1 - s);
            bf16_t* ptr = ST + st_index(b, c, dir, hh) + p * 128 + n8 * 8;
            const u32x4 v = *(const u32x4*)ptr;
            const float d = DEC[((b * NCH + c) * 2 + dir) * 6 + hh];
            u32x4 o; o.x = pk2(hst[0], hst[1]); o.y = pk2(hst[2], hst[3]); o.z = pk2(hst[4], hst[5]); o.w = pk2(hst[6], hst[7]);
            *(u32x4*)ptr = o;
            hst[0] = hst[0] * d + lo2f(v.x); hst[1] = hst[1] * d + hi2f(v.x); hst[2] = hst[2] * d + lo2f(v.y); hst[3] = hst[3] * d + hi2f(v.y);
            hst[4] = hst[4] * d + lo2f(v.z); hst[5] = hst[5] * d + hi2f(v.z); hst[6] = hst[6] * d + lo2f(v.w); hst[7] = hst[7] * d + hi2f(v.w);
        }
    }
}

__device__ __forceinline__ void s3_unit(const Frame& F, int l, int b, int c) {
    int rbase, t0, Tseg; chunk_geom(b, c, rbase, t0, Tseg);
    LAS bf16_t* Bs = (LAS bf16_t*)F.lds;
    LAS bf16_t* Xh = (LAS bf16_t*)(F.lds + 34816);
    LAS bf16_t* Hf = (LAS bf16_t*)(F.lds + 53248);
    LAS bf16_t* Hb = (LAS bf16_t*)(F.lds + 70656);
    LAS bf16_t* SCR = (LAS bf16_t*)(F.lds + 88064 + F.wave * 4352);
    LAS float* DTF = (LAS float*)(F.lds + 122880);
    LAS float* DTB = DTF + 384; LAS float* ACF = DTF + 768; LAS float* ACB = DTF + 1152;
    const bf16_t* Pp = (const bf16_t*)(F.ws + WS_BUFB);
    const bf16_t* XC = (const bf16_t*)(F.ws + WS_BUFC + BC_XC);
    const bf16_t* ST = (const bf16_t*)(F.ws + WS_BUFC + BC_ST);
    bf16_t* MIX = (bf16_t*)(F.ws + WS_BUFA);
    const int li = F.lane & 15, gq = F.lane >> 4, w = F.wave;
    const int itok = 16 * w + li;
    const size_t grow = (size_t)(rbase + t0 + itok);
    float ss = 0.f;
    const int xt = F.tid >> 3, xc8 = F.tid & 7, hr = F.tid >> 4, hc = F.tid & 15;
    u32x4 px0, px1, pf0, pf1, pb0, pb1;
#define S3_LOADHEAD(hh) do { const bf16_t* _x = XC + (size_t)(rbase + t0) * 896 + (hh) * 64 + 8 * xc8; px0 = *(const u32x4*)(_x + (size_t)xt * 896); px1 = *(const u32x4*)(_x + (size_t)(xt + 64) * 896); \
        const bf16_t* _f = ST + st_index(b, c, 0, (hh)) + 8 * hc; const bf16_t* _b = ST + st_index(b, c, 1, (hh)) + 8 * hc; \
        pf0 = *(const u32x4*)(_f + hr * 128); pf1 = *(const u32x4*)(_f + (hr + 32) * 128); pb0 = *(const u32x4*)(_b + hr * 128); pb1 = *(const u32x4*)(_b + (hr + 32) * 128); } while (0)
#pragma unroll 1
    for (int g = 0; g < 2; ++g) {
        __syncthreads();
        for (int i = F.tid; i < 128 * 16; i += NTHR) { const int t = i >> 4, cc = i & 15;
            *(LAS u32x4*)(Bs + t * 136 + cc * 8) = *(const u32x4*)(XC + (size_t)(rbase + t0 + t) * 896 + 384 + g * 128 + cc * 8); }
        if (w < 6) {
            const int dir = w / 3, r = w % 3, h = g * 3 + r;
            float dt[2], incl[2], dA[2], total;
            dt_scan(F, l, Pp, rbase + t0, dir, h, dt, incl, dA, total);
#pragma unroll
            for (int q = 0; q < 2; ++q) { const int tt = 2 * F.lane + q;
                if (dir == 0) { DTF[r * 128 + tt] = dt[q]; ACF[r * 128 + tt] = incl[q]; }
                else { DTB[r * 128 + tt] = dt[q]; ACB[r * 128 + tt] = total - (incl[q] - dA[q]); } }
        }
        bf16x8 cf[4];
#pragma unroll
        for (int ks = 0; ks < 4; ++ks) cf[ks] = *(const bf16x8*)(XC + grow * 896 + 640 + g * 128 + 32 * ks + 8 * gq);
        S3_LOADHEAD(g * 3);
        __syncthreads();
        f32x4 cb[8];
#pragma unroll
        for (int jt = 0; jt < 8; ++jt) { cb[jt] = (f32x4){0.f, 0.f, 0.f, 0.f};
#pragma unroll
            for (int ks = 0; ks < 4; ++ks) cb[jt] = mfma16(frag_lds(Bs, 136, 16 * jt, 32 * ks, li, gq), cf[ks], cb[jt]); }
#pragma unroll 1
        for (int r = 0; r < 3; ++r) {
            const int h = g * 3 + r;
            __syncthreads();
            *(LAS u32x4*)(Xh + xt * 72 + 8 * xc8) = px0; *(LAS u32x4*)(Xh + (xt + 64) * 72 + 8 * xc8) = px1;
            *(LAS u32x4*)(Hf + hr * 136 + 8 * hc) = pf0; *(LAS u32x4*)(Hf + (hr + 32) * 136 + 8 * hc) = pf1;
            *(LAS u32x4*)(Hb + hr * 136 + 8 * hc) = pb0; *(LAS u32x4*)(Hb + (hr + 32) * 136 + 8 * hc) = pb1;
            if (r < 2) S3_LOADHEAD(h + 1);
            int itk = itok; asm volatile("" : "+v"(itk));
            const float af_i = ACF[r * 128 + itok], ab_i = ACB[r * 128 + itok];
#pragma unroll
            for (int jt = 0; jt < 8; ++jt) { const int jv = 16 * jt + 4 * gq;
                const f32x4 acf = *(const LAS f32x4*)(ACF + r * 128 + jv), dtf = *(const LAS f32x4*)(DTF + r * 128 + jv), acb = *(const LAS f32x4*)(ACB + r * 128 + jv), dtb = *(const LAS f32x4*)(DTB + r * 128 + jv);
                f32x4 mv;
#pragma unroll
                for (int q = 0; q < 4; ++q) { const int j = jv + q;
                    const float mfw = (float)(((itk - j) >> 31) + 1), mbw = (float)(((j - itk) >> 31) + 1);
                    const float ef = mfw * __expf(fminf(af_i - acf[q], 0.f)) * dtf[q];
                    const float eb = mbw * __expf(fminf(ab_i - acb[q], 0.f)) * dtb[q];
                    mv[q] = cb[jt][q] * (ef + eb); }
                *(LAS u32x2*)(SCR + li * 136 + jv) = pack4(mv); }
            __syncthreads();
            bf16x8 mf[4];
#pragma unroll
            for (int ks = 0; ks < 4; ++ks) mf[ks] = frag_lds(SCR, 136, 0, 32 * ks, li, gq);
            const float ef_i = __expf(af_i), eb_i = __expf(ab_i), dsk = INP(IN_DSKIP)[l * 6 + h];
#pragma unroll
            for (int pt = 0; pt < 4; ++pt) {
                f32x4 ya = (f32x4){0.f, 0.f, 0.f, 0.f}, gf = ya, gb = ya;
#pragma unroll
                for (int ks = 0; ks < 4; ++ks) {
                    ya = mfma16(frag_tr(Xh, 72, 32 * ks, 16 * pt, li, gq), mf[ks], ya);
                    gf = mfma16(frag_lds(Hf, 136, 16 * pt, 32 * ks, li, gq), cf[ks], gf);
                    gb = mfma16(frag_lds(Hb, 136, 16 * pt, 32 * ks, li, gq), cf[ks], gb); }
                const u32x2 xw = *(const LAS u32x2*)(Xh + itok * 72 + 16 * pt + 4 * gq);
                const u32x2 zw = *(const u32x2*)(Pp + grow * PW + PZ + h * 64 + 16 * pt + 4 * gq);
                const float xs_[4] = {lo2f(xw.x), hi2f(xw.x), lo2f(xw.y), hi2f(xw.y)}, zs_[4] = {lo2f(zw.x), hi2f(zw.x), lo2f(zw.y), hi2f(zw.y)};
                f32x4 o;
#pragma unroll
                for (int q = 0; q < 4; ++q) { const float y = ya[q] + ef_i * gf[q] + eb_i * gb[q] + dsk * xs_[q]; o[q] = y * siluf(zs_[q]); ss += o[q] * o[q]; }
                *(u32x2*)(MIX + grow * D + 640 + h * 64 + 16 * pt + 4 * gq) = pack4(o);
            }
        }
    }
#undef S3_LOADHEAD
    ss += __shfl_xor(ss, 16); ss += __shfl_xor(ss, 32);
    const float rstd = rsqrtf(ss * (1.f / 384.f) + EPS);
    asm volatile("s_waitcnt vmcnt(0)" ::: "memory");
#pragma unroll 2
    for (int hp = 0; hp < 24; ++hp) { const int col = (hp >> 2) * 64 + 16 * (hp & 3) + 4 * gq; const f32x4 gs = *(const f32x4*)(INP(IN_GSSD) + l * 384 + col);
        const u32x2 yw = *(const u32x2*)(MIX + grow * D + 640 + col);
#if defined(DBG_ZERO_S)
        const f32x4 o = (f32x4){0.f, 0.f, 0.f, 0.f} * (rstd * gs + lo2f(yw.x));
#else
        const f32x4 o = (f32x4){lo2f(yw.x), hi2f(yw.x), lo2f(yw.y), hi2f(yw.y)} * rstd * gs;
#endif
        *(u32x2*)(MIX + grow * D + 640 + col) = pack4(o); }
}

__device__ __forceinline__ void attn_unit(const Frame& F, int l, int b, int nb, int kvh, bool ctxq) {
    LAS float* ROPE = (LAS float*)F.lds;
    LAS bf16_t* Kt = (LAS bf16_t*)(F.lds + 8192);
    LAS bf16_t* Vt = (LAS bf16_t*)(F.lds + 26624);
    const bf16_t* Pp = (const bf16_t*)(F.ws + WS_BUFB);
    bf16_t* MIX = (bf16_t*)(F.ws + WS_BUFA);
    const int li = F.lane & 15, gq = F.lane >> 4, w = F.wave;
    __syncthreads();
    for (int i = F.tid; i < 2048; i += NTHR) ROPE[i] = ((const float*)(F.ws + WS_ROPE))[i];
    __syncthreads();
    const int qrow_base = ctxq ? NLAT + b * CTX + nb * 128 : b * SEQ + nb * 128;
    bf16x8 qf[3][2]; float m[3], lsum[3];
    f32x4 o[4][3];
#pragma unroll
    for (int qt = 0; qt < 3; ++qt) {
        const int R = 48 * w + 16 * qt, r = R >> 7, qi = (R & 127) + li, h = kvh * 3 + r;
        const bf16_t* qp = Pp + (size_t)(qrow_base + qi) * PW + PQ + h * 64;
        const int tq = nb * 128 + qi;
#pragma unroll
        for (int ks = 0; ks < 2; ++ks) {
            const int d0 = 32 * ks + 8 * gq;
            const u32x4 own = *(const u32x4*)(qp + d0);
            float ov[8] = {lo2f(own.x), hi2f(own.x), lo2f(own.y), hi2f(own.y), lo2f(own.z), hi2f(own.z), lo2f(own.w), hi2f(own.w)};
            if (!ctxq) {
                const u32x4 par = *(const u32x4*)(qp + (d0 ^ 16));
                const float pv[8] = {lo2f(par.x), hi2f(par.x), lo2f(par.y), hi2f(par.y), lo2f(par.z), hi2f(par.z), lo2f(par.w), hi2f(par.w)};
                const int pos = ks == 0 ? (tq >> 6) : (tq & 63), f0 = (8 * gq) & 15;
#pragma unroll
                for (int j = 0; j < 8; ++j) { const float cs = ROPE[(pos * 16 + f0 + j) * 2], sn = ROPE[(pos * 16 + f0 + j) * 2 + 1];
                    ov[j] = (gq < 2) ? (ov[j] * cs - pv[j] * sn) : (pv[j] * sn + ov[j] * cs); }
            }
            u32x4 pq; pq.x = pk2(ov[0] * 0.125f, ov[1] * 0.125f); pq.y = pk2(ov[2] * 0.125f, ov[3] * 0.125f); pq.z = pk2(ov[4] * 0.125f, ov[5] * 0.125f); pq.w = pk2(ov[6] * 0.125f, ov[7] * 0.125f);
            qf[qt][ks] = __builtin_bit_cast(bf16x8, pq);
        }
        m[qt] = INP(IN_SINK)[l * 6 + h]; lsum[qt] = (gq == 0) ? 1.f : 0.f;
#pragma unroll
        for (int dt = 0; dt < 4; ++dt) o[dt][qt] = (f32x4){0.f, 0.f, 0.f, 0.f};
    }
    const int ntile = ctxq ? 2 : 5;
    const int skey = F.tid >> 2, spart = F.tid & 3, sc1 = spart < 2 ? spart : spart + 2, sc2 = sc1 + 2;
#define ATT_VALID(t) (ctxq || (t) >= 3 || ((nb - 1 + (t)) >= 0 && (nb - 1 + (t)) < 32))
#define ATT_KROW0(t) ((!ctxq && (t) < 3) ? b * SEQ + (nb - 1 + (t)) * 128 : NLAT + b * CTX + (ctxq ? (t) : (t) - 3) * 128)
#define ATT_LOAD(t) do { const int _kr = ATT_KROW0(t); const bf16_t* _kp = Pp + (size_t)(_kr + skey) * PW + PK + kvh * 64; \
        pka = *(const u32x4*)(_kp + 8 * sc1); pkb = *(const u32x4*)(_kp + 8 * sc2); \
        pv0 = *(const u32x4*)(Pp + (size_t)(_kr + (F.tid >> 3)) * PW + PV + kvh * 64 + 8 * (F.tid & 7)); \
        pv1 = *(const u32x4*)(Pp + (size_t)(_kr + 64 + (F.tid >> 3)) * PW + PV + kvh * 64 + 8 * (F.tid & 7)); } while (0)
    u32x4 pka, pkb, pv0, pv1;
    int ti = 0; while (!ATT_VALID(ti)) ++ti;
    ATT_LOAD(ti);
#pragma unroll 1
    for (; ti < ntile; ) {
        const bool local = (!ctxq) && ti < 3;
        const int kb = nb - 1 + ti;
        __syncthreads();
        {
            u32x4 oa = pka, ob = pkb;
            if (local) {
                const float v1[8] = {lo2f(pka.x), hi2f(pka.x), lo2f(pka.y), hi2f(pka.y), lo2f(pka.z), hi2f(pka.z), lo2f(pka.w), hi2f(pka.w)};
                const float v2[8] = {lo2f(pkb.x), hi2f(pkb.x), lo2f(pkb.y), hi2f(pkb.y), lo2f(pkb.z), hi2f(pkb.z), lo2f(pkb.w), hi2f(pkb.w)};
                const int tk = kb * 128 + skey, pos = sc1 < 4 ? (tk >> 6) : (tk & 63), f0 = (8 * sc1) & 15;
                float r1[8], r2[8];
#pragma unroll
                for (int j = 0; j < 8; ++j) { const float cs = ROPE[(pos * 16 + f0 + j) * 2], sn = ROPE[(pos * 16 + f0 + j) * 2 + 1]; r1[j] = v1[j] * cs - v2[j] * sn; r2[j] = v1[j] * sn + v2[j] * cs; }
                oa.x = pk2(r1[0], r1[1]); oa.y = pk2(r1[2], r1[3]); oa.z = pk2(r1[4], r1[5]); oa.w = pk2(r1[6], r1[7]);
                ob.x = pk2(r2[0], r2[1]); ob.y = pk2(r2[2], r2[3]); ob.z = pk2(r2[4], r2[5]); ob.w = pk2(r2[6], r2[7]);
            }
            *(LAS u32x4*)(Kt + skey * 72 + 8 * sc1) = oa; *(LAS u32x4*)(Kt + skey * 72 + 8 * sc2) = ob;
            *(LAS u32x4*)(Vt + (F.tid >> 3) * 72 + 8 * (F.tid & 7)) = pv0; *(LAS u32x4*)(Vt + (64 + (F.tid >> 3)) * 72 + 8 * (F.tid & 7)) = pv1;
        }
        int tn = ti + 1; while (tn < ntile && !ATT_VALID(tn)) ++tn;
        if (tn < ntile) ATT_LOAD(tn);
        __syncthreads();
        const bool masked = local && (kb != nb);
#pragma unroll
        for (int qt = 0; qt < 3; ++qt) {
            __builtin_amdgcn_sched_barrier(0);
            const int qpos = nb * 128 + (((48 * w + 16 * qt) & 127) + li);
#pragma unroll 1
            for (int hf = 0; hf < 2; ++hf) {
                f32x4 s[4];
#pragma unroll
                for (int kt = 0; kt < 4; ++kt) { s[kt] = (f32x4){0.f, 0.f, 0.f, 0.f};
#pragma unroll
                    for (int ks = 0; ks < 2; ++ks) s[kt] = mfma16(frag_lds(Kt, 72, 64 * hf + 16 * kt, 32 * ks, li, gq), qf[qt][ks], s[kt]); }
                float tmax = -1e30f;
#pragma unroll
                for (int kt = 0; kt < 4; ++kt)
#pragma unroll
                    for (int q = 0; q < 4; ++q) {
                        if (masked) { const int kpos = kb * 128 + 64 * hf + 16 * kt + 4 * gq + q; const int dd = qpos - kpos; if (dd > 128 || dd < -128) s[kt][q] = -1e30f; }
                        tmax = fmaxf(tmax, s[kt][q]); }
                tmax = fmaxf(tmax, __shfl_xor(tmax, 16)); tmax = fmaxf(tmax, __shfl_xor(tmax, 32));
                const float mnew = fmaxf(m[qt], tmax), alpha = __expf(m[qt] - mnew);
                float ps = 0.f;
#pragma unroll
                for (int kt = 0; kt < 4; ++kt)
#pragma unroll
                    for (int q = 0; q < 4; ++q) { const float pe = __expf(s[kt][q] - mnew); s[kt][q] = pe; ps += pe; }
                lsum[qt] = lsum[qt] * alpha + ps; m[qt] = mnew;
#pragma unroll
                for (int dt = 0; dt < 4; ++dt) o[dt][qt] = o[dt][qt] * alpha;
#pragma unroll
                for (int k4 = 0; k4 < 2; ++k4) {
                    u32x4 pp; pp.x = pk2(s[2 * k4][0], s[2 * k4][1]); pp.y = pk2(s[2 * k4][2], s[2 * k4][3]); pp.z = pk2(s[2 * k4 + 1][0], s[2 * k4 + 1][1]); pp.w = pk2(s[2 * k4 + 1][2], s[2 * k4 + 1][3]);
                    const bf16x8 pf = __builtin_bit_cast(bf16x8, pp);
#pragma unroll
                    for (int dt = 0; dt < 4; ++dt) o[dt][qt] = mfma16(frag_tr_split(Vt, 72, 64 * hf + 32 * k4, 16 * dt, li, gq), pf, o[dt][qt]);
                }
            }
        }
        ti = tn;
    }
#undef ATT_VALID
#undef ATT_KROW0
#undef ATT_LOAD
#pragma unroll
    for (int qt = 0; qt < 3; ++qt) {
        float lt = lsum[qt]; lt += __shfl_xor(lt, 16); lt += __shfl_xor(lt, 32);
        const float inv = 1.f / lt;
        const int R = 48 * w + 16 * qt;
        bf16_t* op = MIX + (size_t)(qrow_base + (R & 127) + li) * D + 256 + (kvh * 3 + (R >> 7)) * 64 + 4 * gq;
#pragma unroll
#if defined(DBG_ZERO_A)
        for (int dt = 0; dt < 4; ++dt) *(u32x2*)(op + 16 * dt) = pack4(o[dt][qt] * 0.f);
#else
        for (int dt = 0; dt < 4; ++dt) *(u32x2*)(op + 16 * dt) = pack4(o[dt][qt] * inv);
#endif
    }
}

#if defined(DBG_ZERO_F)
constexpr float FSCALE512 = 0.f, FSCALE128 = 0.f;
#else
constexpr float FSCALE512 = 1.f / 512.f, FSCALE128 = 1.f / 128.f;
#endif
constexpr int FO_CST = 0, FO_M2 = 18432, FO_Z = 53248, FO_CSB = 90112, FO_FST = 107520, FO_Z2 = 53248, FO_TAB = 126976;
__device__ __forceinline__ void fourier_consts_a(const Frame& F) {
    LAS bf16_t* CSt = (LAS bf16_t*)(F.lds + FO_CST); LAS bf16_t* M2 = (LAS bf16_t*)(F.lds + FO_M2);
    __syncthreads();
    for (int i = F.tid; i < 128 * 64; i += NTHR) { const int cp = i >> 6, c = i & 63; const int ph = (c * (cp & 63)) & 63; const float v = cp < 64 ? cospif(ph / 32.f) : sinpif(ph / 32.f);
        CSt[cp * 72 + c] = (bf16_t)(pk2(v, 0.f) & 0xffff); }
    for (int i = F.tid; i < 128 * 128; i += NTHR) { const int kp = i >> 7, kk = i & 127; const int ph = ((kp & 63) * (kk & 63)) & 63; const float cs = cospif(ph / 32.f), sn = sinpif(ph / 32.f);
        const float v = kp < 64 ? (kk < 64 ? cs : -sn) : (kk < 64 ? -sn : -cs);
        M2[kp * 136 + kk] = (bf16_t)(pk2(v, 0.f) & 0xffff); }
    __syncthreads();
}
__device__ __forceinline__ void fourier_consts_b(const Frame& F) {
    LAS bf16_t* CSb = (LAS bf16_t*)(F.lds + FO_CSB);
    __syncthreads();
    for (int i = F.tid; i < 64 * 128; i += NTHR) { const int k2 = i >> 7, kk = i & 127; const int ph = (k2 * (kk & 63)) & 63; const float v = kk < 64 ? cospif(ph / 32.f) : sinpif(ph / 32.f);
        CSb[k2 * 136 + kk] = (bf16_t)(pk2(v, 0.f) & 0xffff); }
    __syncthreads();
}
__device__ __forceinline__ void fa_unit(const Frame& F, int b, int g, int pr) {
    LAS bf16_t* CSt = (LAS bf16_t*)(F.lds + FO_CST); LAS bf16_t* M2 = (LAS bf16_t*)(F.lds + FO_M2);
    const bf16_t* Pp = (const bf16_t*)(F.ws + WS_BUFB); bf16_t* FA = (bf16_t*)(F.ws + WS_BUFC + BC_FA);
    const int li = F.lane & 15, gq = F.lane >> 4, w = F.wave;
    __syncthreads();
#pragma unroll
    for (int u2 = 0; u2 < 2; ++u2) {
        LAS bf16_t* Z = (LAS bf16_t*)(F.lds + FO_Z + u2 * 18432);
        const int n2 = 2 * pr + u2, n1 = 16 * (w & 3) + li;
        const bf16_t* up = Pp + (size_t)(b * SEQ + 64 * n1 + n2) * PW + PF + g * 64;
        bf16x8 uf[2];
#pragma unroll
        for (int ks = 0; ks < 2; ++ks) uf[ks] = *(const bf16x8*)(up + 32 * ks + 8 * gq);
#pragma unroll
        for (int ctl = 0; ctl < 4; ++ctl) { const int ct = 4 * (w >> 2) + ctl; f32x4 acc = (f32x4){0.f, 0.f, 0.f, 0.f};
#pragma unroll
            for (int ks = 0; ks < 2; ++ks) acc = mfma16(frag_lds(CSt, 72, 16 * ct, 32 * ks, li, gq), uf[ks], acc);
            const int cp = 16 * ct + 4 * gq;
            *(LAS u32x2*)(Z + ((cp < 64 ? 0 : 64) + n1) * 72 + (cp & 63)) = pack4(acc); }
    }
    __syncthreads();
#pragma unroll
    for (int u2 = 0; u2 < 2; ++u2) {
        LAS bf16_t* Z = (LAS bf16_t*)(F.lds + FO_Z + u2 * 18432);
        const int n2 = 2 * pr + u2, kt = w & 3, k1 = 16 * kt + li;
        const int ph = (n2 * k1) & 4095; const float cs = cospif(ph / 2048.f), sn = sinpif(ph / 2048.f);
#pragma unroll
        for (int ctl = 0; ctl < 2; ++ctl) { const int ct = 2 * (w >> 2) + ctl; f32x4 ar = (f32x4){0.f, 0.f, 0.f, 0.f}, ai = ar;
#pragma unroll
            for (int ks = 0; ks < 4; ++ks) { const bf16x8 zf = frag_tr(Z, 72, 32 * ks, 16 * ct, li, gq);
                ar = mfma16(zf, frag_lds(M2, 136, 16 * kt, 32 * ks, li, gq), ar);
                ai = mfma16(zf, frag_lds(M2, 136, 64 + 16 * kt, 32 * ks, li, gq), ai); }
            const f32x4 tr = ar * cs + ai * sn, tim = ai * cs - ar * sn;
            bf16_t* dst = FA + ((((size_t)(b * 4 + g) * 64 + k1) * 64 + n2) * 128) + 16 * ct + 4 * gq;
            *(u32x2*)dst = pack4(tr); *(u32x2*)(dst + 64) = pack4(tim); }
    }
}
__device__ __forceinline__ void fb_unit(const Frame& F, int b, int g, int kq) {
    LAS bf16_t* CSb = (LAS bf16_t*)(F.lds + FO_CSB); LAS bf16_t* Fst = (LAS bf16_t*)F.lds;
    const bf16_t* FA = (const bf16_t*)(F.ws + WS_BUFC + BC_FA) + (((size_t)(b * 4 + g) * 64 + 4 * kq) * 64) * 128;
    bf16_t* MIX = (bf16_t*)(F.ws + WS_BUFA);
    const int li = F.lane & 15, gq = F.lane >> 4, w = F.wave;
    u32x4 v[8];
#pragma unroll
    for (int q = 0; q < 8; ++q) v[q] = *(const u32x4*)(FA + (size_t)(F.tid + 512 * q) * 8);
    __syncthreads();
#pragma unroll
    for (int q = 0; q < 8; ++q) { const int idx = F.tid + 512 * q, kk1 = idx >> 10, n2 = (idx >> 4) & 63, ri = (idx >> 3) & 1, cc = idx & 7;
        *(LAS u32x4*)(Fst + kk1 * 9216 + (ri * 64 + n2) * 72 + 8 * cc) = v[q]; }
    __syncthreads();
    const int k2 = 16 * (w & 3) + li;
    bf16x8 cfr[4];
#pragma unroll
    for (int ks = 0; ks < 4; ++ks) cfr[ks] = frag_lds(CSb, 136, 16 * (w & 3), 32 * ks, li, gq);
#pragma unroll
    for (int kk1 = 0; kk1 < 4; ++kk1)
#pragma unroll
        for (int ctl = 0; ctl < 2; ++ctl) { const int ct = 2 * (w >> 2) + ctl; f32x4 acc = (f32x4){0.f, 0.f, 0.f, 0.f};
#pragma unroll
            for (int ks = 0; ks < 4; ++ks) acc = mfma16(frag_tr(Fst + kk1 * 9216, 72, 32 * ks, 16 * ct, li, gq), cfr[ks], acc);
            *(u32x2*)(MIX + (size_t)(b * SEQ + 64 * k2 + 4 * kq + kk1) * D + g * 64 + 16 * ct + 4 * gq) = pack4(acc * FSCALE512); }
}
__device__ __forceinline__ void fctx_unit(const Frame& F, int b, int g) {
    LAS bf16_t* CSt = (LAS bf16_t*)(F.lds + FO_CST); LAS bf16_t* Z2 = (LAS bf16_t*)(F.lds + FO_Z2);
    LAS bf16_t* TAB = (LAS bf16_t*)(F.lds + FO_TAB);
    const bf16_t* Pp = (const bf16_t*)(F.ws + WS_BUFB); bf16_t* MIX = (bf16_t*)(F.ws + WS_BUFA);
    const int li = F.lane & 15, gq = F.lane >> 4, w = F.wave;
    __syncthreads();
    if (F.tid < 256) { TAB[F.tid] = (bf16_t)(pk2(cospif(F.tid / 128.f), 0.f) & 0xffff); TAB[256 + F.tid] = (bf16_t)(pk2(-sinpif(F.tid / 128.f), 0.f) & 0xffff); }
    {
        bf16x8 cfr[2];
#pragma unroll
        for (int ks = 0; ks < 2; ++ks) cfr[ks] = frag_lds(CSt, 72, 16 * w, 32 * ks, li, gq);
#pragma unroll 4
        for (int nt = 0; nt < 16; ++nt) { const int n = 16 * nt + li; const bf16_t* up = Pp + (size_t)(NLAT + b * CTX + n) * PW + PF + g * 64;
            f32x4 acc = (f32x4){0.f, 0.f, 0.f, 0.f};
#pragma unroll
            for (int ks = 0; ks < 2; ++ks) acc = mfma16(cfr[ks], *(const bf16x8*)(up + 32 * ks + 8 * gq), acc);
            const int cp = 16 * w + 4 * gq;
            *(LAS u32x2*)(Z2 + ((cp < 64 ? 0 : 256) + n) * 72 + (cp & 63)) = pack4(acc); }
    }
    __syncthreads();
    f32x4 acc[2][4];
#pragma unroll
    for (int a = 0; a < 2; ++a)
#pragma unroll
        for (int ct = 0; ct < 4; ++ct) acc[a][ct] = (f32x4){0.f, 0.f, 0.f, 0.f};
#pragma unroll 1
    for (int ks = 0; ks < 16; ++ks) {
        bf16x8 zf[4];
#pragma unroll
        for (int ct = 0; ct < 4; ++ct) zf[ct] = frag_tr(Z2, 72, 32 * ks, 16 * ct, li, gq);
#pragma unroll
        for (int a = 0; a < 2; ++a) { const int k = 16 * (2 * w + a) + li; bf16x8 df;
#pragma unroll
            for (int j = 0; j < 8; ++j) { const int kk = 32 * ks + 8 * gq + j; df[j] = (short)TAB[(kk < 256 ? 0 : 256) + ((k * (kk & 255)) & 255)]; }
#pragma unroll
            for (int ct = 0; ct < 4; ++ct) acc[a][ct] = mfma16(zf[ct], df, acc[a][ct]); }
    }
#pragma unroll
    for (int a = 0; a < 2; ++a) { const int k = 16 * (2 * w + a) + li;
#pragma unroll
        for (int ct = 0; ct < 4; ++ct) *(u32x2*)(MIX + (size_t)(NLAT + b * CTX + k) * D + g * 64 + 16 * ct + 4 * gq) = pack4(acc[a][ct] * FSCALE128); }
}
__global__ void __launch_bounds__(NTHR, 2) hybrid_fwd(Params P) {
    extern __shared__ __attribute__((aligned(16))) unsigned char lds_raw[];
    Frame F;
    F.lds = (LAS unsigned char*)lds_raw;
    F.tid = threadIdx.x; F.lane = F.tid & 63; F.wave = __builtin_amdgcn_readfirstlane(F.tid >> 6);
    F.G = gridDim.x; F.bid = blockIdx.x;
    F.out = P.out; F.ws = P.ws;
    volatile LAS unsigned* MISC = (volatile LAS unsigned*)(F.lds + MISC_OFF);
    if (F.tid < 16) MISC[F.tid] = 0u;
    __syncthreads();
    XcdBarrier bar = xcd_barrier_post((unsigned*)(F.ws + WS_CTL), MISC);
#define PHASE_FENCE() do { asm volatile("" : "+v"(F.tid)); F.lane = F.tid & 63; F.wave = __builtin_amdgcn_readfirstlane(F.tid >> 6); \
        asm volatile("" : "+s"(F.ws), "+s"(F.out), "+s"(F.bid), "+s"(F.G)); } while (0)
#define GRID_BAR() do { xcd_barrier(bar); PHASE_FENCE(); } while (0)
#if defined(DBG_REP_K)
#define REPS(k, lay) (((k) == DBG_REP_K && (lay) == DBG_REP_L) ? 2 : 1)
#else
#define REPS(k, lay) 1
#endif

    for (int rep = 0; rep < REPS(0, 0); ++rep) { p0_prologue(F); GRID_BAR(); }
    for (int rep = 0; rep < REPS(1, 0); ++rep) { e1_phase(F); GRID_BAR(); }

#pragma unroll 1
    for (int l = 0; l < 2; ++l) {
        const bool first = (l == 0);
        PHASE_FENCE();
        for (int rep = 0; rep < REPS(2, l); ++rep) {
        {
            pg8::DenseProb pb{(const bf16_t*)(F.ws + WS_BUFA), (const bf16_t*)(F.ws + WS_WIN) + (size_t)l * PW * D, nullptr, D};
            pg8::GridOrder S; S.init(NT / 256, PW / 256, F.G, F.bid);
            pg8::EpiBf16 E{(bf16_t*)(F.ws + WS_BUFB), PW, 1.f};
            pg8::gemm_phase(F.lds, F.tid, pb, S, E);
        }
        GRID_BAR();
        }
        for (int rep = 0; rep < REPS(3, l); ++rep) {
        {
            const int nAttL = NB * 32 * 2, nAttC = first ? NB * 2 * 2 : 0, nS1 = NB * NCH * 2, nFA = NB * 4 * 32;
            const int total = nAttL + nAttC + nS1 + nFA;
            bool fa_ready = false;
            for (int u = F.bid; u < total; u += F.G) {
                PHASE_FENCE();
                int v = u;
                if (v < nAttL) { const int b = v >> 6, nb = (v >> 1) & 31, kvh = v & 1; for (int r2 = 0; r2 < REPS(31, l); ++r2) attn_unit(F, l, b, nb, kvh, false); continue; } v -= nAttL;
                if (v < nAttC) { const int b = v >> 2, nb = (v >> 1) & 1, kvh = v & 1; attn_unit(F, l, b, nb, kvh, true); continue; } v -= nAttC;
                if (v < nS1) { const int g = v & 1, c = (v >> 1) % NCH, b = (v >> 1) / NCH; for (int r2 = 0; r2 < REPS(32, l); ++r2) s1_unit(F, l, b, c, g); continue; } v -= nS1;
                if (!fa_ready) { fourier_consts_a(F); fa_ready = true; }
                { const int pr = v & 31, g = (v >> 5) & 3, b = v >> 7; for (int r2 = 0; r2 < REPS(33, l); ++r2) fa_unit(F, b, g, pr); }
            }
        }
        GRID_BAR();
        }
        s2_phase(F);
        GRID_BAR();
        for (int rep = 0; rep < REPS(5, l); ++rep) {
        {
            const int c0 = first ? 0 : 2;
            const int nS3 = NB * (NCH - c0), nFC = first ? NB * 4 : 0, nFB = NB * 4 * 16;
            const int total = nS3 + nFC + nFB;
            bool fa_ready = false, fb_ready = false;
            for (int u = F.bid; u < total; u += F.G) {
                PHASE_FENCE();
                int v = u;
                if (v < nS3) { const int c = c0 + v % (NCH - c0), b = v / (NCH - c0); for (int r2 = 0; r2 < REPS(51, l); ++r2) s3_unit(F, l, b, c); continue; } v -= nS3;
                if (v < nFC) { if (!fa_ready) { fourier_consts_a(F); fa_ready = true; } fctx_unit(F, v >> 2, v & 3); fb_ready = false; continue; } v -= nFC;
                if (!fb_ready) { fourier_consts_b(F); fb_ready = true; }
                { const int kq = v & 15, g = (v >> 4) & 3, b = v >> 6; for (int r2 = 0; r2 < REPS(53, l); ++r2) fb_unit(F, b, g, kq); }
            }
            __syncthreads();
        }
        GRID_BAR();
        }
        for (int rep = 0; rep < REPS(6, l); ++rep) {
        {
            const int rows = first ? NT : NLAT;
            pg8::DenseProb pb{(const bf16_t*)(F.ws + WS_BUFA), (const bf16_t*)(F.ws + WS_WOUT) + (size_t)l * D * D, nullptr, D};
            pg8::GridOrder S; S.init(rows / 256, D / 256, F.G, F.bid);
            pg8::EpiBf16 E{(bf16_t*)(F.ws + WS_BUFB), D, 1.f};
            pg8::gemm_phase(F.lds, F.tid, pb, S, E);
        }
        GRID_BAR();
        }
        for (int rep = 0; rep < REPS(7, l); ++rep) { e3_phase(F, l); GRID_BAR(); }
#if defined(DBG_STOP)
        if (DBG_STOP == 1 + 2 * l) return;
#endif
        for (int rep = 0; rep < REPS(8, l); ++rep) { topk_phase(F, l); GRID_BAR(); }
        {
            pg8::MoeMap mp{16, 0};
            const int nMv = first ? 16 * 34 : 16 * 32;
            for (int rep = 0; rep < REPS(9, l); ++rep) {
            {
                pg8::GuProb pb{(const void*)(F.ws + WS_ASORT), (const void*)(F.ws + WS_WGU), nullptr, D, mp};
                pg8::GridOrder S; S.init(nMv, 2 * FF / 256, F.G, F.bid);
                pg8::EpiGU E{F.ws + WS_BUFB, mp};
                pg8::gemm_phase(F.lds, F.tid, pb, S, E);
            }
            GRID_BAR();
            }
            for (int rep = 0; rep < REPS(10, l); ++rep) {
            {
                pg8::DownProb pb{(const void*)(F.ws + WS_BUFB), (const void*)(F.ws + WS_WD), nullptr, FF, mp};
                pg8::GridOrder S; S.init(nMv, D / 256, F.G, F.bid);
                pg8::EpiDown E{(bf16_t*)(F.ws + WS_BUFC), (const float*)(F.ws + WS_GATE), mp};
                pg8::gemm_phase(F.lds, F.tid, pb, S, E);
            }
            GRID_BAR();
            }
        }
        e5_phase(F, l);
        if (first) { __syncthreads(); convert_experts(F, 1); }
        GRID_BAR();
#if defined(DBG_STOP)
        if (DBG_STOP == 2 + 2 * l) return;
#endif
    }
}

extern "C" void kernel_launch(void* const* d_in, const int* in_sizes, int n_in, void* d_out, int out_size, void* d_ws, size_t ws_size, hipStream_t stream) {
    static int grid = 0;
    if (grid == 0) {
        if (n_in != 23 || out_size != NLAT * D || ws_size < WS_END) { fprintf(stderr, "kernel_launch: unexpected problem (n_in %d out %d ws %zu need %zu)\n", n_in, out_size, ws_size, (size_t)WS_END); grid = -1; return; }
        int dev = 0, cus = 0, per_cu = 0;
        if (hipGetDevice(&dev) != hipSuccess || hipDeviceGetAttribute(&cus, hipDeviceAttributeMultiprocessorCount, dev) != hipSuccess) { grid = -1; return; }
        if (hipFuncSetAttribute((const void*)hybrid_fwd, hipFuncAttributeMaxDynamicSharedMemorySize, LDS_BYTES) != hipSuccess) { fprintf(stderr, "kernel_launch: hipFuncSetAttribute failed\n"); grid = -1; return; }
        if (hipOccupancyMaxActiveBlocksPerMultiprocessor(&per_cu, (const void*)hybrid_fwd, NTHR, LDS_BYTES) != hipSuccess || per_cu < 1) { fprintf(stderr, "kernel_launch: occupancy query says %d\n", per_cu); (void)hipGetLastError(); grid = -1; return; }
        grid = cus;
    }
    if (grid < 0) return;
    (void)in_sizes;
    hipMemsetAsync((char*)d_ws + WS_CTL, 0, 65536, stream);
    Params p{};
    for (int i = 0; i < 23; ++i) p.in[i] = (const float*)d_in[i];
    p.out = (float*)d_out; p.ws = (unsigned char*)d_ws;
    hipLaunchKernelGGL(hybrid_fwd, dim3(grid), dim3(NTHR), LDS_BYTES, stream, p);
}
```
